# Optimizing an MI355X kernel written in HIP

```python
import math
import jax, jax.numpy as jnp
from jax import lax
import numpy as np

D_MODEL = 2048
BATCH = 4
SEQ = 2048
DEPTH = 1

HEAD_DIM = 64
N_Q_HEADS = 16
N_KV_HEADS = 4
Q_PER_KV = N_Q_HEADS // N_KV_HEADS
ATTN_WIDTH = N_Q_HEADS * HEAD_DIM
KV_WIDTH = N_KV_HEADS * HEAD_DIM
WINDOW = 128
BLOCK = 128
NUM_BUCKETS = 32
MAX_EXACT = NUM_BUCKETS // 2
MAX_DISTANCE = 128
CONV_CHANNELS = D_MODEL // 2
CONV_WIDTH = 31
D_FF = ((8 * D_MODEL + 3 * 256 - 1) // (3 * 256)) * 256
EPS = 1e-6
IN_SIZES = [ATTN_WIDTH, KV_WIDTH, KV_WIDTH, CONV_CHANNELS, CONV_CHANNELS, D_MODEL, D_MODEL]
IN_WIDTH = sum(IN_SIZES)
IN_SPLITS = [int(s) for s in np.cumsum(IN_SIZES)[:-1]]
N_MOD = 6

kernel_name = "hybrid_swa_sink_conformer_conv_gated_block"


def rms_norm(x, g):
    xf = x.astype(jnp.float32)
    y = xf * lax.rsqrt(jnp.mean(xf * xf, axis=-1, keepdims=True) + EPS)
    return (y * g.astype(jnp.float32)).astype(x.dtype)


def layer_norm(x, g, b):
    xf = x.astype(jnp.float32)
    mu = jnp.mean(xf, axis=-1, keepdims=True)
    var = jnp.mean(jnp.square(xf - mu), axis=-1, keepdims=True)
    y = (xf - mu) * lax.rsqrt(var + EPS)
    return (y * g.astype(jnp.float32) + b.astype(jnp.float32)).astype(x.dtype)


def t5_causal_bucket(dist):
    n = jnp.maximum(dist, 0)
    nf = jnp.maximum(n, 1).astype(jnp.float32)
    large = MAX_EXACT + (jnp.log(nf / MAX_EXACT) / math.log(MAX_DISTANCE / MAX_EXACT)
                         * (NUM_BUCKETS - MAX_EXACT)).astype(jnp.int32)
    large = jnp.minimum(large, NUM_BUCKETS - 1)
    return jnp.where(n < MAX_EXACT, n, large)


def sliding_window_attention(q, k, v, rel_bias, sinks, q_g, k_g):
    b_sz, s_len = q.shape[0], q.shape[1]
    nb = s_len // BLOCK
    q = rms_norm(q, q_g)
    k = rms_norm(k, k_g)
    qb = q.reshape(b_sz, nb, BLOCK, N_KV_HEADS, Q_PER_KV, HEAD_DIM)

    def band(t):
        tb = t.reshape(b_sz, nb, BLOCK, N_KV_HEADS, HEAD_DIM)
        prev = jnp.concatenate([jnp.zeros_like(tb[:, :1]), tb[:, :-1]], axis=1)
        return jnp.concatenate([prev, tb], axis=2)

    kw, vw = band(k), band(v)
    logits = jnp.einsum('bnqhgd,bnkhd->bnhgqk', qb, kw).astype(jnp.float32) * (HEAD_DIM ** -0.5)

    q_off = jnp.arange(BLOCK)
    k_off = jnp.arange(2 * BLOCK)
    dist = q_off[:, None] + BLOCK - k_off[None, :]
    bias = rel_bias.astype(jnp.float32)[t5_causal_bucket(dist)]
    bias = jnp.transpose(bias, (2, 0, 1)).reshape(N_KV_HEADS, Q_PER_KV, BLOCK, 2 * BLOCK)
    allowed = (dist >= 0) & (dist < WINDOW)
    real_key = (jnp.arange(nb)[:, None, None] > 0) | (k_off[None, None, :] >= BLOCK)
    mask = allowed[None] & real_key

    logits = jnp.where(mask[None, :, None, None], logits + bias, -jnp.inf)
    sink = sinks.astype(jnp.float32).reshape(N_KV_HEADS, Q_PER_KV)[None, None, :, :, None, None]
    m = jnp.maximum(jnp.max(logits, axis=-1, keepdims=True), sink)
    p = jnp.exp(logits - m)
    probs = p / (jnp.sum(p, axis=-1, keepdims=True) + jnp.exp(sink - m))
    out = jnp.einsum('bnhgqk,bnkhd->bnqhgd', probs.astype(v.dtype), vw)
    return out.reshape(b_sz, s_len, ATTN_WIDTH)


def conformer_conv(a, gate, conv_w, conv_b, ln_g, ln_b, w_out):
    u = a * jax.nn.sigmoid(gate)
    u = lax.conv_general_dilated(
        u, conv_w[:, None, :].astype(u.dtype), window_strides=(1,),
        padding=[(CONV_WIDTH - 1, 0)], dimension_numbers=('NWC', 'WIO', 'NWC'),
        feature_group_count=CONV_CHANNELS) + conv_b
    u = jax.nn.silu(layer_norm(u, ln_g, ln_b))
    return u @ w_out


def setup_inputs(seed: int = 0) -> dict:
    key = jax.random.key(seed)
    ks = jax.random.split(key, 24)
    nrm = lambda k, shape, s: jax.random.normal(k, shape, jnp.float32) * s
    d = D_MODEL
    return {
        "x": nrm(ks[0], (BATCH, SEQ, d), 1.0),
        "c": nrm(ks[1], (BATCH, d), 1.0),
        "w_ada": nrm(ks[2], (DEPTH, d, N_MOD * d), 0.5 * d ** -0.5),
        "b_ada": nrm(ks[3], (DEPTH, N_MOD * d), 0.02),
        "norm_mix_g": 1.0 + nrm(ks[4], (DEPTH, d), 0.02),
        "w_in": nrm(ks[5], (DEPTH, d, IN_WIDTH), d ** -0.5),
        "q_norm_g": 1.0 + nrm(ks[6], (DEPTH, HEAD_DIM), 0.02),
        "k_norm_g": 1.0 + nrm(ks[7], (DEPTH, HEAD_DIM), 0.02),
        "attn_sinks": nrm(ks[8], (DEPTH, N_Q_HEADS), 0.5),
        "rel_bias": nrm(ks[9], (NUM_BUCKETS, N_Q_HEADS), 0.5),
        "w_attn_out": nrm(ks[10], (DEPTH, ATTN_WIDTH, d), ATTN_WIDTH ** -0.5),
        "conv_w": nrm(ks[11], (DEPTH, CONV_WIDTH, CONV_CHANNELS), CONV_WIDTH ** -0.5),
        "conv_b": nrm(ks[12], (DEPTH, CONV_CHANNELS), 0.02),
        "conv_ln_g": 1.0 + nrm(ks[13], (DEPTH, CONV_CHANNELS), 0.02),
        "conv_ln_b": nrm(ks[14], (DEPTH, CONV_CHANNELS), 0.02),
        "w_conv_out": nrm(ks[15], (DEPTH, CONV_CHANNELS, d), CONV_CHANNELS ** -0.5),
        "w_mix_out": nrm(ks[16], (DEPTH, d, d), d ** -0.5),
        "norm_ffn_g": 1.0 + nrm(ks[17], (DEPTH, d), 0.02),
        "w_ffn_in": nrm(ks[18], (DEPTH, d, 2 * D_FF), d ** -0.5),
        "w_ffn_out": nrm(ks[19], (DEPTH, D_FF, d), D_FF ** -0.5),
    }


def reference(x, c, w_ada, b_ada, norm_mix_g, w_in, q_norm_g, k_norm_g, attn_sinks, rel_bias,
              w_attn_out, conv_w, conv_b, conv_ln_g, conv_ln_b, w_conv_out, w_mix_out,
              norm_ffn_g, w_ffn_in, w_ffn_out):
    b_sz, s_len = x.shape[0], x.shape[1]
    c_act = jax.nn.silu(c)
    for l in range(DEPTH):
        mod = (c_act @ w_ada[l] + b_ada[l])[:, None, :]
        sh_m, sc_m, gt_m, sh_f, sc_f, gt_f = jnp.split(mod, N_MOD, axis=-1)

        h = rms_norm(x, norm_mix_g[l]) * (1.0 + sc_m) + sh_m
        q, k, v, ca, cb, g_attn, g_conv = jnp.split(h @ w_in[l], IN_SPLITS, axis=-1)
        q = q.reshape(b_sz, s_len, N_Q_HEADS, HEAD_DIM)
        k = k.reshape(b_sz, s_len, N_KV_HEADS, HEAD_DIM)
        v = v.reshape(b_sz, s_len, N_KV_HEADS, HEAD_DIM)
        y_attn = sliding_window_attention(q, k, v, rel_bias, attn_sinks[l],
                                          q_norm_g[l], k_norm_g[l]) @ w_attn_out[l]
        y_conv = conformer_conv(ca, cb, conv_w[l], conv_b[l], conv_ln_g[l], conv_ln_b[l],
                                w_conv_out[l])
        merged = jax.nn.sigmoid(g_attn) * y_attn + jax.nn.sigmoid(g_conv) * y_conv
        x = x + gt_m * (merged @ w_mix_out[l])

        h = rms_norm(x, norm_ffn_g[l]) * (1.0 + sc_f) + sh_f
        f_gate, f_up = jnp.split(h @ w_ffn_in[l], 2, axis=-1)
        x = x + gt_f * ((jax.nn.silu(f_gate) * f_up) @ w_ffn_out[l])
    return x
```

```cpp
#include <hip/hip_runtime.h>
#include <hip/hip_cooperative_groups.h>
#include <cstdio>
#include <cstdint>
namespace cg = cooperative_groups;

#ifndef MK_PER_PHASE
#define MK_PER_PHASE 0
#endif
#ifndef MK_CG_SYNC
#define MK_CG_SYNC 1
#endif

namespace pg8 {
#define PG8_LAS __attribute__((address_space(3)))
typedef unsigned short bf16_t;
typedef short bf16x8 __attribute__((ext_vector_type(8)));
typedef float f32x4 __attribute__((ext_vector_type(4)));
typedef unsigned u32x4 __attribute__((ext_vector_type(4)));
constexpr int BM = 256, BK = 64, HALF = 128, HTB = HALF * BK * 2  , STAGE_BYTES = 8 * HTB, NXCD = 8, WGM = 8;

__host__ __device__ __forceinline__ int lds_byte(int r, int c) { const int st = (r >> 4) * 2 + (c >> 5), rr = r & 15, cc = c & 31, ob = rr * 64 + cc * 2; return st * 1024 + (ob ^ (((ob >> 9) & 1) << 5)); }
__host__ __device__ __forceinline__ void stage_rc(int b, int& R, int& C) { const int st = b / 1024, sb = b % 1024, swz = sb ^ (((sb >> 9) & 1) << 5); R = (st >> 1) * 16 + swz / 64; C = (st & 1) * 32 + (swz % 64) / 2; }
__host__ __device__ __forceinline__ int perm32(int rho) { const int n = rho >> 4, i = rho & 15; return 8 * (i >> 2) + 4 * n + (i & 3); }

struct Unit { int pm, pn; };
struct Gemm { const bf16_t* A; const bf16_t* Bt; int M, N, K; };

struct StaticOrder {
    int nM, nN, nwg, G, c;
    __host__ __device__ void init(int M, int N, int G_, int c_) { nM = M / BM; nN = N / BM; nwg = nM * nN; G = G_; c = c_; }
    __host__ __device__ bool next(int i, Unit& u) const {
        const long L = (long)i * G + c; if (L >= nwg) return false;
        int wgid = (int)L; { const int q = nwg / NXCD, r = nwg % NXCD, xcd = wgid % NXCD, off = wgid / NXCD; wgid = (xcd < r ? xcd * (q + 1) : r * (q + 1) + (xcd - r) * q) + off; }
        const int nig = WGM * nN, gid = wgid / nig, fm = gid * WGM, gsz = (nM - fm) < WGM ? (nM - fm) : WGM;
        u.pm = fm + ((wgid % nig) % gsz); u.pn = (wgid % nig) / gsz; return true;
    }
    __device__ __forceinline__ void a_ready(const Unit&) const {}
    __device__ __forceinline__ void done(const Unit&) const {}
};


__device__ __forceinline__ unsigned cvt_pk_bf16(float lo, float hi) { unsigned r; asm volatile("v_cvt_pk_bf16_f32 %0, %1, %2" : "=v"(r) : "v"(lo), "v"(hi)); return r; }
__device__ __forceinline__ float sigm(float x) { return __builtin_amdgcn_rcpf(1.0f + __builtin_amdgcn_exp2f(-1.4426950408889634f * x)); }
__device__ __forceinline__ u32x4 pack8(const f32x4& v0, const f32x4& v1) { u32x4 w; w.x = cvt_pk_bf16(v0[0], v0[1]); w.y = cvt_pk_bf16(v0[2], v0[3]); w.z = cvt_pk_bf16(v1[0], v1[1]); w.w = cvt_pk_bf16(v1[2], v1[3]); return w; }
__device__ __forceinline__ void unpack8(const u32x4& w, f32x4& v0, f32x4& v1) {
    v0[0] = __uint_as_float(w.x << 16); v0[1] = __uint_as_float(w.x & 0xffff0000u); v0[2] = __uint_as_float(w.y << 16); v0[3] = __uint_as_float(w.y & 0xffff0000u);
    v1[0] = __uint_as_float(w.z << 16); v1[1] = __uint_as_float(w.z & 0xffff0000u); v1[2] = __uint_as_float(w.w << 16); v1[3] = __uint_as_float(w.w & 0xffff0000u); }

struct Epi1 {
    static constexpr bool PERM = true, AFTER_DRAIN = false, MID = false;
    bf16_t *Q, *U, *R, *GC;
    __device__ __forceinline__ void mid(f32x4 (&)[2][2][4][2], const Unit&, int, int, int, int) const {}
    __device__ __forceinline__ void operator()(const f32x4 (&acc)[2][2][4][2], const Unit& u, int wr, int wc, int fr, int fq) const {
        const int row0 = u.pm * BM + wr * 64 + fr, cl = wc * 32 + 8 * fq;
        if (u.pn < 6) {
            const size_t boff = u.pn < 4 ? (size_t)0 : (u.pn == 4 ? (size_t)8388608 : (size_t)10485760);
            bf16_t* base = Q + boff; const int ld = u.pn < 4 ? 1024 : 256, c0 = u.pn < 4 ? u.pn * 256 : 0;
#pragma unroll
            for (int ai = 0; ai < 2; ++ai)
#pragma unroll
                for (int m = 0; m < 4; ++m) { bf16_t* rowp = base + (size_t)(row0 + ai * HALF + m * 16) * ld + c0 + cl;
#pragma unroll
                    for (int bj = 0; bj < 2; ++bj) *(u32x4*)(rowp + bj * HALF) = pack8(acc[ai][bj][m][0], acc[ai][bj][m][1]); }
        } else if (u.pn < 14) {
            const int c0 = (u.pn - 6) * 128 + cl;
#pragma unroll
            for (int ai = 0; ai < 2; ++ai)
#pragma unroll
                for (int m = 0; m < 4; ++m) { f32x4 o[2];
#pragma unroll
                    for (int n = 0; n < 2; ++n)
#pragma unroll
                        for (int e = 0; e < 4; ++e) o[n][e] = acc[ai][0][m][n][e] * sigm(acc[ai][1][m][n][e]);
                    *(u32x4*)(U + (size_t)(row0 + ai * HALF + m * 16) * 1024 + c0) = pack8(o[0], o[1]); }
        } else {
            const int c0 = (u.pn - 14) * 128 + cl;
#pragma unroll
            for (int ai = 0; ai < 2; ++ai)
#pragma unroll
                for (int m = 0; m < 4; ++m) { f32x4 r[2], g[2];
#pragma unroll
                    for (int n = 0; n < 2; ++n)
#pragma unroll
                        for (int e = 0; e < 4; ++e) { const float ea = __builtin_amdgcn_exp2f(-1.4426950408889634f * acc[ai][0][m][n][e]), ec = __builtin_amdgcn_exp2f(-1.4426950408889634f * acc[ai][1][m][n][e]);
                            g[n][e] = __builtin_amdgcn_rcpf(1.0f + ec); r[n][e] = (1.0f + ec) * __builtin_amdgcn_rcpf(1.0f + ea); }
                    const size_t off = (size_t)(row0 + ai * HALF + m * 16) * 2048 + c0;
                    *(u32x4*)(R + off) = pack8(r[0], r[1]); *(u32x4*)(GC + off) = pack8(g[0], g[1]); }
        }
    }
};
struct Epi2 {
    static constexpr bool PERM = true, AFTER_DRAIN = false, MID = true;
    const bf16_t *R, *GC; bf16_t* O;
    __device__ __forceinline__ void mid(f32x4 (&acc)[2][2][4][2], const Unit& u, int wr, int wc, int fr, int fq) const {
        asm volatile("" : "+v"(fr), "+v"(fq));
        const int row0 = u.pm * BM + wr * 64 + fr, col0 = u.pn * BM + wc * 32 + 8 * fq;
#pragma unroll
        for (int ai = 0; ai < 2; ++ai)
#pragma unroll
            for (int m = 0; m < 4; ++m) { const bf16_t* rowp = R + (size_t)(row0 + ai * HALF + m * 16) * 2048 + col0;
#pragma unroll
                for (int bj = 0; bj < 2; ++bj) { const u32x4 w = *(const u32x4*)(rowp + bj * HALF); f32x4 s0, s1; unpack8(w, s0, s1); acc[ai][bj][m][0] *= s0; acc[ai][bj][m][1] *= s1; }
                if (m & 1) asm volatile("" ::: "memory"); }
    }
    __device__ __forceinline__ void operator()(const f32x4 (&acc)[2][2][4][2], const Unit& u, int wr, int wc, int fr, int fq) const {
        const int row0 = u.pm * BM + wr * 64 + fr, col0 = u.pn * BM + wc * 32 + 8 * fq;
#pragma unroll
        for (int ai = 0; ai < 2; ++ai)
#pragma unroll
            for (int m = 0; m < 4; ++m) { const size_t off = (size_t)(row0 + ai * HALF + m * 16) * 2048 + col0;
#pragma unroll
                for (int bj = 0; bj < 2; ++bj) { const u32x4 w = *(const u32x4*)(GC + off + bj * HALF); f32x4 s0, s1; unpack8(w, s0, s1);
                    *(u32x4*)(O + off + bj * HALF) = pack8(acc[ai][bj][m][0] * s0, acc[ai][bj][m][1] * s1); }
                if (m & 1) asm volatile("" ::: "memory"); }
    }
};
struct EpiRes {
    static constexpr bool PERM = false, AFTER_DRAIN = false, MID = false;
    const float* base; float* out; const float* gate;
    __device__ __forceinline__ void mid(f32x4 (&)[2][2][4][2], const Unit&, int, int, int, int) const {}
    __device__ __forceinline__ void operator()(const f32x4 (&acc)[2][2][4][2], const Unit& u, int wr, int wc, int fr, int fq) const {
        const int row0 = u.pm * BM + wr * 64 + fr, col0 = u.pn * BM + wc * 32 + 4 * fq;
        const float* gp = gate + (size_t)(u.pm >> 3) * 12288 + col0;
        f32x4 gv[2][2];
#pragma unroll
        for (int bj = 0; bj < 2; ++bj)
#pragma unroll
            for (int n = 0; n < 2; ++n) gv[bj][n] = *(const f32x4*)(gp + bj * HALF + n * 16);
#pragma unroll
        for (int ai = 0; ai < 2; ++ai)
#pragma unroll
            for (int m = 0; m < 4; ++m) { const size_t off = (size_t)(row0 + ai * HALF + m * 16) * 2048 + col0;
#pragma unroll
                for (int bj = 0; bj < 2; ++bj)
#pragma unroll
                    for (int n = 0; n < 2; ++n) { const f32x4 b = *(const f32x4*)(base + off + bj * HALF + n * 16); *(f32x4*)(out + off + bj * HALF + n * 16) = b + gv[bj][n] * acc[ai][bj][m][n]; } }
    }
};
struct Epi4 {
    static constexpr bool PERM = true, AFTER_DRAIN = false, MID = false;
    bf16_t* HF;
    __device__ __forceinline__ void mid(f32x4 (&)[2][2][4][2], const Unit&, int, int, int, int) const {}
    __device__ __forceinline__ void operator()(const f32x4 (&acc)[2][2][4][2], const Unit& u, int wr, int wc, int fr, int fq) const {
        const int row0 = u.pm * BM + wr * 64 + fr, c0 = u.pn * 128 + wc * 32 + 8 * fq;
#pragma unroll
        for (int ai = 0; ai < 2; ++ai)
#pragma unroll
            for (int m = 0; m < 4; ++m) { f32x4 o[2];
#pragma unroll
                for (int n = 0; n < 2; ++n)
#pragma unroll
                    for (int e = 0; e < 4; ++e) { const float g = acc[ai][0][m][n][e]; o[n][e] = g * sigm(g) * acc[ai][1][m][n][e]; }
                *(u32x4*)(HF + (size_t)(row0 + ai * HALF + m * 16) * 5632 + c0) = pack8(o[0], o[1]); }
    }
};

template <class Epi, class Sched, bool ALIGN_EPI = false, bool SP2 = false>
__device__ __forceinline__ void gemm_phase(PG8_LAS unsigned char* lds, const Gemm g, const Sched& S, const Epi& E) {
    const int tid = threadIdx.x, wid = __builtin_amdgcn_readfirstlane(tid >> 6), lane = tid & 63, wr = wid >> 2, wc = wid & 3, fr = lane & 15, fq = lane >> 4;
    const int K = g.K, nt = K / BK;
    unsigned voffA[2], voffB[2];
#pragma unroll
    for (int i = 0; i < 2; ++i) { int R, C; stage_rc(tid * 16 + i * 8192, R, C); const int Rb = Epi::PERM ? ((R & ~31) + perm32(R & 31)) : R;
        voffA[i] = (unsigned)(R * K + C) * 2u; voffB[i] = (unsigned)(Rb * K + C) * 2u; }
    const size_t kstep = (size_t)(BK * 2);
    const size_t hstep = (size_t)HALF * K * 2;
    const size_t tstep = 2 * hstep;
    const unsigned ldsw = (unsigned)wid * 1024u;
    const int aoff = lds_byte(wr * 64 + fr, fq * 8), boff = lds_byte(wc * 32 + fr, fq * 8);
#define PG8_SA(b, h) (((b) * 2 + (h)) * HTB)
#define PG8_SB(b, h) ((4 + (b) * 2 + (h)) * HTB)
#define PG8_STAGE(bufoff, gbase, voff) do { _Pragma("unroll") for (int _i = 0; _i < 2; ++_i) \
        __builtin_amdgcn_global_load_lds((const unsigned*)((const char*)(gbase) + (voff)[_i]), (PG8_LAS unsigned*)(lds + (bufoff) + ldsw + _i * 8192), 16, 0, 0); } while (0)
#define PG8_LDA(dst, b, h) do { _Pragma("unroll") for (int m = 0; m < 4; ++m) _Pragma("unroll") for (int k = 0; k < 2; ++k) dst[m][k] = *(const PG8_LAS bf16x8*)(lds + PG8_SA(b, h) + aoff + m * 2048 + k * 1024); } while (0)
#define PG8_LDB(dst, b, h) do { _Pragma("unroll") for (int n = 0; n < 2; ++n) _Pragma("unroll") for (int k = 0; k < 2; ++k) dst[n][k] = *(const PG8_LAS bf16x8*)(lds + PG8_SB(b, h) + boff + n * 2048 + k * 1024); } while (0)
#define PG8_MMA(ai, bj, At, Bt) do { __builtin_amdgcn_s_setprio(1); _Pragma("unroll") for (int m = 0; m < 4; ++m) _Pragma("unroll") for (int n = 0; n < 2; ++n) _Pragma("unroll") for (int k = 0; k < 2; ++k) \
        acc[ai][bj][m][n] = __builtin_amdgcn_mfma_f32_16x16x32_bf16(Bt[n][k], At[m][k], acc[ai][bj][m][n], 0, 0, 0); __builtin_amdgcn_s_setprio(0); } while (0)
#define PG8_WAIT_V(n) asm volatile("s_waitcnt vmcnt(" #n ")" ::: "memory")
#define PG8_WAIT_L(n) asm volatile("s_waitcnt lgkmcnt(" #n ")" ::: "memory")
#define PG8_BAR __builtin_amdgcn_s_barrier()
#define PG8_SCHED __builtin_amdgcn_sched_barrier(0)
    Unit cur, nxt; int ui = 0;
    if (!S.next(0, cur)) return;
    f32x4 acc[2][2][4][2];
#pragma unroll
    for (int a = 0; a < 2; ++a)
#pragma unroll
        for (int b = 0; b < 2; ++b)
#pragma unroll
            for (int m = 0; m < 4; ++m)
#pragma unroll
                for (int n = 0; n < 2; ++n) acc[a][b][m][n] = (f32x4){0.f, 0.f, 0.f, 0.f};
    bf16x8 At[4][2], B0[2][2], B1[2][2];
    const char* cA = (const char*)g.A + (size_t)cur.pm * tstep; const char* cB = (const char*)g.Bt + (size_t)cur.pn * tstep;
    S.a_ready(cur);
    if constexpr (SP2) {
        PG8_STAGE(PG8_SB(0, 0), cB, voffB); PG8_STAGE(PG8_SB(0, 1), cB + hstep, voffB); PG8_STAGE(PG8_SA(0, 0), cA, voffA); PG8_STAGE(PG8_SA(0, 1), cA + hstep, voffA);
        if (wr == 1) PG8_BAR;
        PG8_WAIT_V(2); PG8_BAR;
        PG8_STAGE(PG8_SB(1, 0), cB + kstep, voffB); PG8_STAGE(PG8_SA(1, 0), cA + kstep, voffA); PG8_STAGE(PG8_SB(1, 1), cB + hstep + kstep, voffB);
        PG8_WAIT_V(6); PG8_BAR;
    } else {
        PG8_STAGE(PG8_SB(0, 0), cB, voffB); PG8_STAGE(PG8_SA(0, 0), cA, voffA); PG8_STAGE(PG8_SB(0, 1), cB + hstep, voffB); PG8_STAGE(PG8_SA(0, 1), cA + hstep, voffA);
        if (wr == 1) PG8_BAR;
        PG8_WAIT_V(4); PG8_BAR;
        PG8_STAGE(PG8_SB(1, 0), cB + kstep, voffB); PG8_STAGE(PG8_SA(1, 0), cA + kstep, voffA); PG8_STAGE(PG8_SB(1, 1), cB + hstep + kstep, voffB);
        PG8_WAIT_V(6); PG8_BAR;
    }
    for (;;) {
        const bool has_next = S.next(ui + 1, nxt);
        const char* nA = has_next ? (const char*)g.A + (size_t)nxt.pm * tstep : cA; const char* nB = has_next ? (const char*)g.Bt + (size_t)nxt.pn * tstep : cB;
        for (int t = 0; t < nt; t += 2) {
            const bool last = (t == nt - 2);
            const char* a1 = cA + (size_t)(t + 1) * kstep;
            const char* a2 = last ? nA : cA + (size_t)(t + 2) * kstep; const char* b2 = last ? nB : cB + (size_t)(t + 2) * kstep;
            const char* a3 = a2 + kstep; const char* b3 = b2 + kstep;
            if (last && has_next) S.a_ready(nxt);
            if constexpr (Epi::MID) { if (t == (nt >> 1)) E.mid(acc, cur, wr, wc, fr, fq); }
            if constexpr (SP2) {
            PG8_LDB(B0, 0, 0); PG8_LDB(B1, 0, 1); PG8_SCHED; PG8_LDA(At, 0, 0); PG8_STAGE(PG8_SA(1, 1), a1 + hstep, voffA);
            PG8_WAIT_V(8); PG8_WAIT_L(0); PG8_BAR; PG8_MMA(0, 0, At, B0); PG8_MMA(0, 1, At, B1); PG8_BAR; PG8_SCHED;
            PG8_LDA(At, 0, 1); PG8_STAGE(PG8_SB(0, 0), b2, voffB); PG8_STAGE(PG8_SB(0, 1), b2 + hstep, voffB); PG8_STAGE(PG8_SA(0, 0), a2, voffA);
            PG8_WAIT_V(8); PG8_WAIT_L(0); PG8_BAR; PG8_MMA(1, 0, At, B0); PG8_MMA(1, 1, At, B1); PG8_BAR; PG8_SCHED;
            PG8_LDB(B0, 1, 0); PG8_LDB(B1, 1, 1); PG8_SCHED; PG8_LDA(At, 1, 0); PG8_STAGE(PG8_SA(0, 1), a2 + hstep, voffA);
            PG8_WAIT_V(8); PG8_WAIT_L(0); PG8_BAR; PG8_MMA(0, 0, At, B0); PG8_MMA(0, 1, At, B1); PG8_BAR; PG8_SCHED;
            PG8_LDA(At, 1, 1); PG8_STAGE(PG8_SB(1, 0), b3, voffB); PG8_STAGE(PG8_SB(1, 1), b3 + hstep, voffB); PG8_STAGE(PG8_SA(1, 0), a3, voffA);
            PG8_WAIT_V(8); PG8_WAIT_L(0); PG8_BAR; PG8_MMA(1, 0, At, B0); PG8_MMA(1, 1, At, B1); PG8_BAR; PG8_SCHED;
            } else {
            PG8_LDB(B0, 0, 0); PG8_SCHED; PG8_LDA(At, 0, 0); PG8_STAGE(PG8_SA(1, 1), a1 + hstep, voffA);
            PG8_WAIT_L(8); PG8_BAR; PG8_WAIT_L(0); PG8_MMA(0, 0, At, B0); PG8_BAR; PG8_SCHED;
            PG8_LDB(B1, 0, 1); PG8_STAGE(PG8_SB(0, 0), b2, voffB);
            PG8_BAR; PG8_WAIT_L(0); PG8_MMA(0, 1, At, B1); PG8_BAR;
            PG8_LDA(At, 0, 1); PG8_STAGE(PG8_SA(0, 0), a2, voffA);
            PG8_BAR; PG8_WAIT_L(0); PG8_MMA(1, 0, At, B0); PG8_BAR; PG8_SCHED;
            PG8_STAGE(PG8_SB(0, 1), b2 + hstep, voffB);
            PG8_WAIT_V(6); PG8_BAR; PG8_MMA(1, 1, At, B1); PG8_BAR;
            PG8_LDB(B0, 1, 0); PG8_SCHED; PG8_LDA(At, 1, 0); PG8_STAGE(PG8_SA(0, 1), a2 + hstep, voffA);
            PG8_WAIT_L(8); PG8_BAR; PG8_WAIT_L(0); PG8_MMA(0, 0, At, B0); PG8_BAR; PG8_SCHED;
            PG8_LDB(B1, 1, 1); PG8_STAGE(PG8_SB(1, 0), b3, voffB);
            PG8_BAR; PG8_WAIT_L(0); PG8_MMA(0, 1, At, B1); PG8_BAR;
            PG8_LDA(At, 1, 1); PG8_STAGE(PG8_SA(1, 0), a3, voffA);
            PG8_BAR; PG8_WAIT_L(0); PG8_MMA(1, 0, At, B0); PG8_BAR; PG8_SCHED;
            PG8_STAGE(PG8_SB(1, 1), b3 + hstep, voffB);
            PG8_WAIT_V(6); PG8_BAR; PG8_MMA(1, 1, At, B1); PG8_BAR;
            }
        }
        if constexpr (ALIGN_EPI) { if (wr == 0) PG8_BAR; }
        if constexpr (!Epi::AFTER_DRAIN) { E(acc, cur, wr, wc, fr, fq); S.done(cur); }
        if (!has_next) break;
#pragma unroll
        for (int a = 0; a < 2; ++a)
#pragma unroll
            for (int b = 0; b < 2; ++b)
#pragma unroll
                for (int m = 0; m < 4; ++m)
#pragma unroll
                    for (int n = 0; n < 2; ++n) acc[a][b][m][n] = (f32x4){0.f, 0.f, 0.f, 0.f};
        cur = nxt; cA = nA; cB = nB; ++ui;
        if constexpr (ALIGN_EPI) { if (wr == 1) PG8_BAR; }
    }
    PG8_WAIT_V(0);
    if constexpr (!ALIGN_EPI) { if (wr == 0) PG8_BAR; }
    PG8_BAR;
    if constexpr (Epi::AFTER_DRAIN) { E.fused(acc, cur, wr, wc, fr, fq, lds, wid, lane); S.done(cur); }
#undef PG8_SA
#undef PG8_SB
#undef PG8_STAGE
#undef PG8_LDA
#undef PG8_LDB
#undef PG8_MMA
#undef PG8_WAIT_V
#undef PG8_WAIT_L
#undef PG8_BAR
#undef PG8_SCHED
}
}


constexpr int NWAVES = 8;
constexpr int DM = 2048, BATCH = 4, SEQ = 2048, MT = BATCH * SEQ;
constexpr int NQ = 1024, NKVW = 256, CONVC = 1024, DFF = 5632, NMOD = 6 * DM;
constexpr int N1 = 7680, N4 = 2 * DFF;
constexpr float EPS = 1e-6f, LOG2E = 1.4426950408889634f;
constexpr int N_PHASES = 9;

constexpr size_t MiB = 1u << 20;
constexpr size_t WS_CTL = 0, WS_MOD = 65536, CTL_ZERO_BYTES = 262144;
constexpr size_t WS_W1T = 1 * MiB, WS_W2T = 31 * MiB, WS_W3T = 39 * MiB, WS_W4T = 47 * MiB, WS_W5T = 91 * MiB;
constexpr size_t WS_H = 113 * MiB;
constexpr size_t WS_Q = 145 * MiB, WS_K = 161 * MiB, WS_V = 165 * MiB, WS_U = 169 * MiB, WS_R = 185 * MiB, WS_GC = 217 * MiB;
constexpr size_t WS_A2 = 249 * MiB, WS_MG = 281 * MiB, WS_END = 313 * MiB;
constexpr size_t WS_HF = 145 * MiB;
static_assert(WS_HF + (size_t)MT * DFF * 2 <= WS_A2, "HF overlay");
static_assert(WS_K - WS_Q == 2 * (size_t)8388608 && WS_V - WS_Q == 2 * (size_t)10485760, "Epi1 reaches K and V from Q by fixed element offsets");
constexpr int CW_BAR = 1024;

constexpr int RING_BYTES = 131072, LDSCTL_OFF = RING_BYTES, MISC_OFF = LDSCTL_OFF + 320, LDS_BYTES = 147456;

#define GAS __attribute__((address_space(1)))
#define LAS __attribute__((address_space(3)))
typedef unsigned short bf16;
typedef unsigned v4u __attribute__((ext_vector_type(4)));
typedef unsigned v2u __attribute__((ext_vector_type(2)));
typedef float f32x4 __attribute__((ext_vector_type(4)));
typedef float f32x2 __attribute__((ext_vector_type(2)));
typedef float f32x16 __attribute__((ext_vector_type(16)));
typedef short bf16x8 __attribute__((ext_vector_type(8)));
typedef short s16x4 __attribute__((ext_vector_type(4)));
typedef GAS unsigned gu32;
#define RLX_AGENT __ATOMIC_RELAXED, __HIP_MEMORY_SCOPE_AGENT
#define LDS_WAIT() asm volatile("s_waitcnt lgkmcnt(0)" ::: "memory")
__device__ __forceinline__ unsigned f2bf(float f) { unsigned u = __builtin_bit_cast(unsigned, f); return (u + 0x7fffu + ((u >> 16) & 1u)) >> 16; }
__device__ __forceinline__ unsigned pk2(float lo, float hi) { return f2bf(lo) | (f2bf(hi) << 16); }
__device__ __forceinline__ float bflo(unsigned w) { return __uint_as_float(w << 16); }
__device__ __forceinline__ float bfhi(unsigned w) { return __uint_as_float(w & 0xffff0000u); }
__device__ __forceinline__ float sigm(float x) { return __builtin_amdgcn_rcpf(1.0f + __builtin_amdgcn_exp2f(-LOG2E * x)); }
__device__ __forceinline__ float wave_sum(float v) {
#pragma unroll
    for (int o = 1; o < 64; o <<= 1) v += __shfl_xor(v, o);
    return v;
}

#define XB_TMO      128
#define XB_XCNT(j)  (256  + 64 * (j))
#define XB_XSUB(j)  (1280 + 64 * (j))
#define XB_XGEN(j)  (2304 + 64 * (j))
#define XB_TOP      3328
#define XB_TOPGEN   3392
#define XCD_BAR_WORDS 3456
#define XB_SPIN_CAP (1u << 18)

__device__ __forceinline__ unsigned xb_ld(unsigned* p)              { return __hip_atomic_load(p, __ATOMIC_RELAXED, __HIP_MEMORY_SCOPE_AGENT); }
__device__ __forceinline__ unsigned xb_add(unsigned* p, unsigned v) { return __hip_atomic_fetch_add(p, v, __ATOMIC_RELAXED, __HIP_MEMORY_SCOPE_AGENT); }
__device__ __forceinline__ unsigned xb_xcc_id() { return (unsigned)__builtin_amdgcn_s_getreg((3 << 11) | 20) & 0xFu; }
#define XB_SPIN(cond, bar) do { unsigned _sp = 0; while (cond) { __builtin_amdgcn_s_sleep(1); \
    if ((++_sp & 255u) == 0u) { if (xb_ld(&(bar)[XB_TMO])) break; if (_sp > XB_SPIN_CAP) { atomicAdd(&(bar)[XB_TMO], 1u); break; } } } } while (0)

struct XcdBarrier {
    unsigned* bar; unsigned x;
    volatile LAS unsigned* st;
};

__device__ __forceinline__ XcdBarrier xcd_barrier_post(unsigned* bar, volatile LAS unsigned* st) {
    XcdBarrier b; b.bar = bar; b.x = xb_xcc_id(); b.st = st;
    if (threadIdx.x == 0) (void)xb_add(&bar[XB_XCNT(b.x)], 1u);
    return b;
}
__device__ __forceinline__ void xcd_barrier_complete(unsigned* bar, unsigned x, unsigned& nloc, unsigned& nx) {
    const unsigned G = gridDim.x * gridDim.y * gridDim.z;
    unsigned sum, cnt, mine, sp = 0u;
    for (;;) {
        sum = 0u; cnt = 0u; mine = 0u;
#pragma unroll
        for (unsigned j = 0; j < 16; ++j) { const unsigned c = xb_ld(&bar[XB_XCNT(j)]); sum += c; cnt += (c > 0u) ? 1u : 0u; mine = (j == x) ? c : mine; }
        if (sum == G) break;
        __builtin_amdgcn_s_sleep(1);
        if ((++sp & 255u) == 0u) { if (xb_ld(&bar[XB_TMO])) break; if (sp > XB_SPIN_CAP) { atomicAdd(&bar[XB_TMO], 1u); break; } }
    }
    nloc = mine > 0u ? mine : 1u; nx = cnt > 0u ? cnt : 1u;
}

__device__ __forceinline__ void xcd_barrier(const XcdBarrier& b) {
    asm volatile("s_waitcnt vmcnt(0)" ::: "memory");
    __syncthreads();
    if (threadIdx.x == 0) {
        unsigned* bar = b.bar;
        __builtin_amdgcn_s_waitcnt(0);
        unsigned nloc = b.st[0], nx = b.st[1];
        if (nloc == 0u) { xcd_barrier_complete(bar, b.x, nloc, nx); b.st[0] = nloc; b.st[1] = nx; }
        const unsigned old = xb_add(&bar[XB_XSUB(b.x)], 1u);
        const unsigned gen = old / nloc;
        if (old + 1u == (gen + 1u) * nloc) {
            __builtin_amdgcn_fence(__ATOMIC_RELEASE, "agent");
            asm volatile("s_waitcnt vmcnt(0)" ::: "memory");
            const unsigned og = xb_add(&bar[XB_TOP], 1u);
            const unsigned tg = og / nx;
            if (og + 1u == (tg + 1u) * nx) xb_add(&bar[XB_TOPGEN], 1u);
            else XB_SPIN(xb_ld(&bar[XB_TOPGEN]) == tg, bar);
            __builtin_amdgcn_fence(__ATOMIC_ACQUIRE, "agent");
            xb_add(&bar[XB_XGEN(b.x)], 1u);
            asm volatile("s_waitcnt vmcnt(0)" ::: "memory");
        } else {
            XB_SPIN(xb_ld(&bar[XB_XGEN(b.x)]) == gen, bar);
            __builtin_amdgcn_fence(__ATOMIC_ACQUIRE, "agent");
            asm volatile("s_waitcnt vmcnt(0)" ::: "memory");
        }
    }
    __syncthreads();
}

__device__ __forceinline__ void p0_adaln(const float* c, const float* w_ada, const float* b_ada, float* MOD, LAS float* red, int tid, int lane, int wave) {
    for (int it = blockIdx.x; it < 48 * 16; it += gridDim.x) {
        const int cgp = it % 48, kc = it / 48, k0 = kc * 128 + wave * 16, c0 = cgp * 256 + lane * 4;
        const float cv = c[(lane >> 4) * DM + k0 + (lane & 15)];
        const float sv = cv * sigm(cv);
        f32x4 acc[4];
#pragma unroll
        for (int b = 0; b < 4; ++b) acc[b] = (f32x4){0.f, 0.f, 0.f, 0.f};
#pragma unroll
        for (int r = 0; r < 16; ++r) { const f32x4 w4 = *(const f32x4*)(w_ada + (size_t)(k0 + r) * NMOD + c0);
#pragma unroll
            for (int b = 0; b < 4; ++b) { const float s = __shfl(sv, b * 16 + r); acc[b] += w4 * s; } }
#pragma unroll
        for (int b = 0; b < 4; ++b) *(LAS f32x4*)(red + ((wave * 4 + b) * 256 + lane * 4)) = acc[b];
        __syncthreads();
#pragma unroll
        for (int e = 0; e < 2; ++e) { const int o = tid * 2 + e, b = o >> 8, col = o & 255; float s = 0.f;
#pragma unroll
            for (int w = 0; w < 8; ++w) s += red[(w * 4 + b) * 256 + col];
            if (kc == 0) s += b_ada[cgp * 256 + col];
            atomicAdd(MOD + b * NMOD + cgp * 256 + col, s); }
        __syncthreads();
    }
}
__device__ __forceinline__ int maprow(int mapid, int n0) {
    if (mapid == 1) {
        if (n0 < 1536) return n0;
        if (n0 < 2560) { const int t = n0 - 1536; return 1536 + ((t >> 7) << 8) + (t & 127); }
        if (n0 < 3584) { const int t = n0 - 2560; return 1536 + ((t >> 7) << 8) + 128 + (t & 127); }
        if (n0 < 5632) { const int t = n0 - 3584; return 3584 + ((t >> 7) << 8) + (t & 127); }
        const int t = n0 - 5632; return 3584 + ((t >> 7) << 8) + 128 + (t & 127);
    }
    if (mapid == 2) {
        if (n0 < DFF) return ((n0 >> 7) << 8) + (n0 & 127);
        const int t = n0 - DFF; return ((t >> 7) << 8) + 128 + (t & 127);
    }
    return n0;
}
__device__ __forceinline__ void transpose_item(const float* W, int N, bf16* WT, int ldk, int koff, int mapid, LAS float* scr, int item, int lane) {
    const int nblk = N / 32, kb = item / nblk, nb = item % nblk, k0 = 64 * kb, n0 = 32 * nb;
#pragma unroll 8
    for (int i = 0; i < 32; ++i) { const int kk = 2 * i + (lane >> 5); scr[kk * 33 + (lane & 31)] = W[(size_t)(k0 + kk) * N + n0 + (lane & 31)]; }
    LDS_WAIT(); asm volatile("" ::: "memory");
    const int c = lane & 7, drow0 = maprow(mapid, n0);
#pragma unroll
    for (int j = 0; j < 4; ++j) { const int n = (lane >> 3) + 8 * j; const LAS float* s = scr + (8 * c) * 33 + n;
        v4u o; o.x = pk2(s[0 * 33], s[1 * 33]); o.y = pk2(s[2 * 33], s[3 * 33]); o.z = pk2(s[4 * 33], s[5 * 33]); o.w = pk2(s[6 * 33], s[7 * 33]);
        *(GAS v4u*)(WT + (size_t)(drow0 + n) * ldk + koff + k0 + 8 * c) = o; }
    LDS_WAIT(); asm volatile("" ::: "memory");
}
__device__ __forceinline__ void modnorm_phase(const float* X, const float* g, const float* MOD, int sh_off, int sc_off, bf16* H, int gw, int NGW, int lane) {
    for (int it = gw; it < MT / 4; it += NGW) {
        const int row0 = it * 4, b = row0 / SEQ;
        f32x4 A[8], Bv[8];
#pragma unroll
        for (int j = 0; j < 8; ++j) { const int col = 4 * (lane + 64 * j);
            const f32x4 gg = *(const f32x4*)(g + col), sc = *(const f32x4*)(MOD + (size_t)b * NMOD + sc_off + col);
            A[j] = gg * (1.0f + sc); Bv[j] = *(const f32x4*)(MOD + (size_t)b * NMOD + sh_off + col); }
        for (int r = 0; r < 4; ++r) {
            const float* xr = X + (size_t)(row0 + r) * DM;
            f32x4 v[8]; float ss = 0.f;
#pragma unroll
            for (int j = 0; j < 8; ++j) { v[j] = *(const f32x4*)(xr + 4 * (lane + 64 * j)); ss += (v[j].x * v[j].x + v[j].y * v[j].y) + (v[j].z * v[j].z + v[j].w * v[j].w); }
            const float rstd = 1.0f / sqrtf(wave_sum(ss) * (1.0f / DM) + EPS);
            bf16* hr = H + (size_t)(row0 + r) * DM;
#pragma unroll
            for (int j = 0; j < 8; ++j) { const f32x4 o = v[j] * rstd * A[j] + Bv[j]; v2u w; w.x = pk2(o.x, o.y); w.y = pk2(o.z, o.w); *(GAS v2u*)(hr + 4 * (lane + 64 * j)) = w; }
        }
    }
}
__device__ __forceinline__ int crow(int r, int hi) { return (r & 3) + 8 * (r >> 2) + 4 * hi; }
__device__ __forceinline__ void attn_unit(int unit, const bf16* Qb, const bf16* Kb, const bf16* Vb, bf16* A2, const float* qg, const float* kg, const float* sinks, const float* relb,
                                          LAS unsigned char* lds, int tid, int lane, int wave) {
    const int b = unit >> 6, kvh = (unit >> 4) & 3, nb = unit & 15;
    LAS bf16* Ks = (LAS bf16*)lds;
    LAS bf16* Vt = (LAS bf16*)(lds + 36864);
    LAS float* biasT = (LAS float*)(lds + 36864 + 33792);
    LAS float* lscr = biasT + 512 + wave * 32;
    const int tok0 = b * SEQ + nb * 128;
#pragma unroll
    for (int i = 0; i < 4; ++i) {
        const int c = tid + 512 * i, key = c >> 3, part = c & 7;
        const bool real = (nb > 0) || (key >= 128);
        const long tok = (long)tok0 - 128 + key;
        v4u kw = (v4u){0u, 0u, 0u, 0u}, vw = (v4u){0u, 0u, 0u, 0u};
        if (real) { kw = *(const v4u*)(Kb + tok * 256 + kvh * 64 + part * 8); vw = *(const v4u*)(Vb + tok * 256 + kvh * 64 + part * 8); }
        const f32x4 k0 = (f32x4){bflo(kw.x), bfhi(kw.x), bflo(kw.y), bfhi(kw.y)}, k1 = (f32x4){bflo(kw.z), bfhi(kw.z), bflo(kw.w), bfhi(kw.w)};
        float ss = (k0.x * k0.x + k0.y * k0.y) + (k0.z * k0.z + k0.w * k0.w) + (k1.x * k1.x + k1.y * k1.y) + (k1.z * k1.z + k1.w * k1.w);
        ss += __shfl_xor(ss, 1); ss += __shfl_xor(ss, 2); ss += __shfl_xor(ss, 4);
        const float rstd = 1.0f / sqrtf(ss * (1.0f / 64.0f) + EPS);
        const f32x4 g0 = *(const f32x4*)(kg + part * 8) * rstd, g1 = *(const f32x4*)(kg + part * 8 + 4) * rstd;
        v4u o; o.x = pk2(k0.x * g0.x, k0.y * g0.y); o.y = pk2(k0.z * g0.z, k0.w * g0.w); o.z = pk2(k1.x * g1.x, k1.y * g1.y); o.w = pk2(k1.z * g1.z, k1.w * g1.w);
        *(LAS v4u*)(Ks + key * 72 + part * 8) = o;
        LAS bf16* vt = Vt + (part * 8) * 264 + key;
        vt[0 * 264] = (bf16)(vw.x & 0xffffu); vt[1 * 264] = (bf16)(vw.x >> 16); vt[2 * 264] = (bf16)(vw.y & 0xffffu); vt[3 * 264] = (bf16)(vw.y >> 16);
        vt[4 * 264] = (bf16)(vw.z & 0xffffu); vt[5 * 264] = (bf16)(vw.z >> 16); vt[6 * 264] = (bf16)(vw.w & 0xffffu); vt[7 * 264] = (bf16)(vw.w >> 16);
    }
    { const int g = tid >> 7, dist = tid & 127; int bucket = dist;
      if (dist >= 16) { const int l = 16 + (int)(logf((float)dist * (1.0f / 16.0f)) / 2.0794415416798357f * 16.0f); bucket = l < 31 ? l : 31; }
      biasT[tid] = relb[bucket * 16 + kvh * 4 + g] * LOG2E; }
    __syncthreads();
    const int q = lane & 31, hi = lane >> 5;
    for (int pass = 0; pass < 2; ++pass) {
        const int pi = wave * 2 + pass, g = pi >> 2, qblk = pi & 3, h = kvh * 4 + g, q0 = qblk * 32;
        const bf16* qrow = Qb + (size_t)(tok0 + q0 + q) * 1024 + h * 64 + hi * 8;
        v4u qw[4]; float ss = 0.f;
#pragma unroll
        for (int ks = 0; ks < 4; ++ks) { qw[ks] = *(const v4u*)(qrow + 16 * ks);
            const float a0 = bflo(qw[ks].x), a1 = bfhi(qw[ks].x), a2 = bflo(qw[ks].y), a3 = bfhi(qw[ks].y), a4 = bflo(qw[ks].z), a5 = bfhi(qw[ks].z), a6 = bflo(qw[ks].w), a7 = bfhi(qw[ks].w);
            ss += (a0 * a0 + a1 * a1) + (a2 * a2 + a3 * a3) + (a4 * a4 + a5 * a5) + (a6 * a6 + a7 * a7); }
        ss += __shfl_xor(ss, 32);
        const float rs = (1.0f / sqrtf(ss * (1.0f / 64.0f) + EPS)) * (0.125f * LOG2E);
        bf16x8 qf[4];
#pragma unroll
        for (int ks = 0; ks < 4; ++ks) { const f32x4 g0 = *(const f32x4*)(qg + 16 * ks + 8 * hi) * rs, g1 = *(const f32x4*)(qg + 16 * ks + 8 * hi + 4) * rs;
            v4u o; o.x = pk2(bflo(qw[ks].x) * g0.x, bfhi(qw[ks].x) * g0.y); o.y = pk2(bflo(qw[ks].y) * g0.z, bfhi(qw[ks].y) * g0.w);
            o.z = pk2(bflo(qw[ks].z) * g1.x, bfhi(qw[ks].z) * g1.y); o.w = pk2(bflo(qw[ks].w) * g1.z, bfhi(qw[ks].w) * g1.w);
            qf[ks] = __builtin_bit_cast(bf16x8, o); }
        f32x16 s[5];
#pragma unroll
        for (int tt = 0; tt < 5; ++tt) {
            s[tt] = (f32x16){0.f, 0.f, 0.f, 0.f, 0.f, 0.f, 0.f, 0.f, 0.f, 0.f, 0.f, 0.f, 0.f, 0.f, 0.f, 0.f};
            const LAS bf16* kp = Ks + (32 * (qblk + tt) + q) * 72 + 8 * hi;
#pragma unroll
            for (int ks = 0; ks < 4; ++ks) { const bf16x8 a = *(const LAS bf16x8*)(kp + 16 * ks); s[tt] = __builtin_amdgcn_mfma_f32_32x32x16_bf16(a, qf[ks], s[tt], 0, 0, 0); }
        }
        const float sk = sinks[h] * LOG2E;
        float mx = sk;
        const LAS float* bt = biasT + g * 128;
#pragma unroll
        for (int tt = 0; tt < 5; ++tt)
#pragma unroll
            for (int r = 0; r < 16; ++r) { const int dist = q + 128 - 32 * tt - crow(r, hi);
                const bool valid = (dist >= 0) && (dist < 128) && ((nb > 0) || (qblk + tt >= 4));
                float v = s[tt][r] + bt[dist & 127]; v = valid ? v : -INFINITY; s[tt][r] = v; mx = fmaxf(mx, v); }
        mx = fmaxf(mx, __shfl_xor(mx, 32));
        float l = 0.f;
#pragma unroll
        for (int tt = 0; tt < 5; ++tt)
#pragma unroll
            for (int r = 0; r < 16; ++r) { const float p = __builtin_amdgcn_exp2f(s[tt][r] - mx); s[tt][r] = p; l += p; }
        l += __shfl_xor(l, 32); l += __builtin_amdgcn_exp2f(sk - mx);
        f32x16 o[2];
        o[0] = (f32x16){0.f, 0.f, 0.f, 0.f, 0.f, 0.f, 0.f, 0.f, 0.f, 0.f, 0.f, 0.f, 0.f, 0.f, 0.f, 0.f}; o[1] = o[0];
#pragma unroll
        for (int tt = 0; tt < 5; ++tt)
#pragma unroll
            for (int s2 = 0; s2 < 2; ++s2) {
                v4u pw; pw.x = pk2(s[tt][8 * s2 + 0], s[tt][8 * s2 + 1]); pw.y = pk2(s[tt][8 * s2 + 2], s[tt][8 * s2 + 3]); pw.z = pk2(s[tt][8 * s2 + 4], s[tt][8 * s2 + 5]); pw.w = pk2(s[tt][8 * s2 + 6], s[tt][8 * s2 + 7]);
                const bf16x8 pa = __builtin_bit_cast(bf16x8, pw);
#pragma unroll
                for (int dt = 0; dt < 2; ++dt) { const LAS bf16* vp = Vt + (32 * dt + q) * 264 + 32 * (qblk + tt) + 16 * s2 + 4 * hi;
                    const s16x4 lo = *(const LAS s16x4*)vp, hh = *(const LAS s16x4*)(vp + 8);
                    const bf16x8 vb = (bf16x8){lo[0], lo[1], lo[2], lo[3], hh[0], hh[1], hh[2], hh[3]};
                    o[dt] = __builtin_amdgcn_mfma_f32_32x32x16_bf16(pa, vb, o[dt], 0, 0, 0); }
            }
        if (hi == 0) lscr[q] = 1.0f / l;
        LDS_WAIT();
        bf16* orow = A2 + (size_t)(tok0 + q0) * 2048 + h * 64 + q;
#pragma unroll
        for (int r = 0; r < 16; ++r) { const int cr = crow(r, hi); const float li = lscr[cr];
            orow[(size_t)cr * 2048] = (bf16)f2bf(o[0][r] * li); orow[(size_t)cr * 2048 + 32] = (bf16)f2bf(o[1][r] * li); }
        LDS_WAIT();
    }
}
__device__ __forceinline__ void conv_unit(int unit, const bf16* U, bf16* A2, const float* cw, const float* cb, const float* lg, const float* lb, LAS unsigned char* lds, int tid, int lane, int wave) {
    const int b = unit >> 6, t0 = (unit & 63) * 32;
    LAS unsigned* Us = (LAS unsigned*)lds;
    LAS float* red = (LAS float*)(lds + 126976);
    const __amdgpu_buffer_rsrc_t ursrc = __builtin_amdgcn_make_buffer_rsrc((void*)(U + (size_t)b * SEQ * 1024), 0, SEQ * 1024 * 2, 0x00020000);
    {   const int rr0 = tid >> 7, cc = tid & 127;
#pragma unroll 4
        for (int i = 0; i < 16; ++i) { const int rr = rr0 + 4 * i, t = t0 - 30 + rr;
            if (rr < 62) { const unsigned voff = t >= 0 ? (unsigned)(t * 2048 + cc * 16) : 0xfffffff0u;
                const v4u w = __builtin_amdgcn_raw_buffer_load_b128(ursrc, voff, 0, 0);
                *(LAS v4u*)(Us + rr * 512 + cc * 4) = w; } } }
    const __amdgpu_buffer_rsrc_t wrsrc = __builtin_amdgcn_make_buffer_rsrc((void*)cw, 0, 31 * 1024 * 4, 0x00020000);
    float w0[31], w1[31];
#pragma unroll
    for (int j = 0; j < 31; ++j) { const v2u ww = __builtin_amdgcn_raw_buffer_load_b64(wrsrc, tid * 8, j * 4096, 0); w0[j] = __uint_as_float(ww.x); w1[j] = __uint_as_float(ww.y); }
    const f32x2 bb = *(const f32x2*)(cb + 2 * tid), gg = *(const f32x2*)(lg + 2 * tid), be = *(const f32x2*)(lb + 2 * tid);
    __syncthreads();
#pragma unroll 1
    for (int cq = 0; cq < 4; ++cq) {
        float a0[8], a1[8];
#pragma unroll
        for (int i = 0; i < 8; ++i) { a0[i] = bb.x; a1[i] = bb.y; }
        const LAS unsigned* up = Us + (8 * cq) * 512 + tid;
        unsigned un0 = up[0], un1 = up[512];
#pragma unroll
        for (int r = 0; r < 38; ++r) { const unsigned uu = un0; un0 = un1; if (r + 2 < 38) un1 = up[(r + 2) * 512];
            const float u0 = bflo(uu), u1 = bfhi(uu);
#pragma unroll
            for (int i = 0; i < 8; ++i) { const int j = r - i; if (j >= 0 && j <= 30) { a0[i] += u0 * w0[j]; a1[i] += u1 * w1[j]; } }
            __builtin_amdgcn_sched_barrier(0); }
#pragma unroll
        for (int i = 0; i < 8; ++i) { const float s1 = wave_sum(a0[i] + a1[i]), s2 = wave_sum(a0[i] * a0[i] + a1[i] * a1[i]);
            if (lane == 0) { red[((cq * 8 + wave) * 8 + i) * 2] = s1; red[((cq * 8 + wave) * 8 + i) * 2 + 1] = s2; } }
        __syncthreads();
#pragma unroll
        for (int i = 0; i < 8; ++i) { float t1 = 0.f, t2 = 0.f;
#pragma unroll
            for (int w = 0; w < 8; ++w) { t1 += red[((cq * 8 + w) * 8 + i) * 2]; t2 += red[((cq * 8 + w) * 8 + i) * 2 + 1]; }
            const float mean = t1 * (1.0f / 1024.0f), var = t2 * (1.0f / 1024.0f) - mean * mean, rstd = 1.0f / sqrtf(var + EPS);
            float y0 = (a0[i] - mean) * rstd * gg.x + be.x, y1 = (a1[i] - mean) * rstd * gg.y + be.y;
            y0 *= sigm(y0); y1 *= sigm(y1);
            *(GAS unsigned*)(A2 + (size_t)(b * SEQ + t0 + 8 * cq + i) * 2048 + 1024 + 2 * tid) = pk2(y0, y1); }
    }
}

struct Args { const float* in[20]; float* out; unsigned char* ws; int ph_lo, ph_hi; };
__global__ void __launch_bounds__(NWAVES * 64, 2) fwd_kernel(Args args) {
    extern __shared__ __attribute__((aligned(16))) unsigned char lds_raw[];
    LAS unsigned char* lds = (LAS unsigned char*)lds_raw;
    volatile LAS unsigned* MISC = (volatile LAS unsigned*)(lds + MISC_OFF);
    const int tid = threadIdx.x, lane = tid & 63, wave = __builtin_amdgcn_readfirstlane(tid >> 6);
    const int G = gridDim.x, bx = blockIdx.x;
    const int vcu = (G % 8 == 0) ? (bx % 8) * (G / 8) + bx / 8 : bx;
    const int gw = vcu * NWAVES + wave, NGW = G * NWAVES;
    unsigned char* ws = args.ws;
    const float* x = args.in[0]; const float* c_in = args.in[1]; const float* w_ada = args.in[2]; const float* b_ada = args.in[3]; const float* norm_mix_g = args.in[4];
    const float* w_in = args.in[5]; const float* q_norm_g = args.in[6]; const float* k_norm_g = args.in[7]; const float* attn_sinks = args.in[8]; const float* rel_bias = args.in[9];
    const float* w_attn_out = args.in[10]; const float* conv_w = args.in[11]; const float* conv_b = args.in[12]; const float* conv_ln_g = args.in[13]; const float* conv_ln_b = args.in[14];
    const float* w_conv_out = args.in[15]; const float* w_mix_out = args.in[16]; const float* norm_ffn_g = args.in[17]; const float* w_ffn_in = args.in[18]; const float* w_ffn_out = args.in[19];
    float* out = args.out;
    float* MOD = (float*)(ws + WS_MOD);
    bf16 *W1T = (bf16*)(ws + WS_W1T), *W2T = (bf16*)(ws + WS_W2T), *W3T = (bf16*)(ws + WS_W3T), *W4T = (bf16*)(ws + WS_W4T), *W5T = (bf16*)(ws + WS_W5T);
    bf16 *H = (bf16*)(ws + WS_H), *Qb = (bf16*)(ws + WS_Q), *Kb = (bf16*)(ws + WS_K), *Vb = (bf16*)(ws + WS_V), *Ub = (bf16*)(ws + WS_U), *Rb = (bf16*)(ws + WS_R), *GCb = (bf16*)(ws + WS_GC);
    bf16 *A2 = (bf16*)(ws + WS_A2), *MG = (bf16*)(ws + WS_MG), *HF = (bf16*)(ws + WS_HF);

    for (int u = tid; u < (LDS_BYTES - LDSCTL_OFF) / 4; u += NWAVES * 64) ((LAS unsigned*)(lds + LDSCTL_OFF))[u] = 0u;
    __syncthreads();
    const int lo = args.ph_lo, hi = args.ph_hi;
#if !MK_CG_SYNC
    XcdBarrier bar; bar.bar = (unsigned*)(ws + WS_CTL) + CW_BAR; bar.x = 0; bar.st = nullptr;
    if (hi - lo > 1) bar = xcd_barrier_post((unsigned*)(ws + WS_CTL) + CW_BAR, MISC + 8);
#else
    (void)MISC;
#endif
#ifdef PHASE_MASK
#define IN(k) (((PHASE_MASK >> (k)) & 1) && lo <= (k) && (k) < hi)
#else
#define IN(k) (lo <= (k) && (k) < hi)
#endif
#define BOTH(k) (IN(k) && IN((k) + 1))
#if MK_CG_SYNC
#define GRID_BAR(k) do { if (BOTH(k)) cg::this_grid().sync(); } while (0)
#else
#define GRID_BAR(k) do { if (BOTH(k)) { if ((k) == 0) cg::this_grid().sync(); else xcd_barrier(bar); } } while (0)
#endif

    if (IN(0)) {
        p0_adaln(c_in, w_ada, b_ada, MOD, (LAS float*)lds, tid, lane, wave);
        LAS float* scr = (LAS float*)(lds + wave * 16384);
        constexpr int I0 = 32 * 240, I1 = 16 * 64, I2 = 16 * 64, I3 = 32 * 64, I4 = 32 * 352, I5 = 88 * 64, NITEMS = I0 + I1 + I2 + I3 + I4 + I5;
        for (int it = gw; it < NITEMS; it += NGW) {
            int r = it;
            if (r < I0) { transpose_item(w_in, N1, W1T, 2048, 0, 1, scr, r, lane); continue; } r -= I0;
            if (r < I1) { transpose_item(w_attn_out, DM, W2T, 2048, 0, 0, scr, r, lane); continue; } r -= I1;
            if (r < I2) { transpose_item(w_conv_out, DM, W2T, 2048, 1024, 0, scr, r, lane); continue; } r -= I2;
            if (r < I3) { transpose_item(w_mix_out, DM, W3T, 2048, 0, 0, scr, r, lane); continue; } r -= I3;
            if (r < I4) { transpose_item(w_ffn_in, N4, W4T, 2048, 0, 2, scr, r, lane); continue; } r -= I4;
            transpose_item(w_ffn_out, DM, W5T, DFF, 0, 0, scr, r, lane);
        }
        GRID_BAR(0);
    }
    if (IN(1)) { modnorm_phase(x, norm_mix_g, MOD, 0, DM, H, gw, NGW, lane); GRID_BAR(1); }
    if (IN(2)) {
        pg8::Gemm g{H, W1T, MT, N1, DM}; pg8::StaticOrder S; S.init(MT, N1, G, bx);
        pg8::Epi1 E{Qb, Ub, Rb, GCb};
        pg8::gemm_phase<pg8::Epi1, pg8::StaticOrder, true, true>(lds, g, S, E);
        GRID_BAR(2);
    }
    if (IN(3)) {
#ifndef NO_ATTN
        for (int u = bx; u < 256; u += G) { attn_unit(u, Qb, Kb, Vb, A2, q_norm_g, k_norm_g, attn_sinks, rel_bias, lds, tid, lane, wave); __syncthreads(); }
#endif
#ifndef NO_CONV
        for (int u = bx; u < 256; u += G) { conv_unit(u, Ub, A2, conv_w, conv_b, conv_ln_g, conv_ln_b, lds, tid, lane, wave); __syncthreads(); }
#endif
        GRID_BAR(3);
    }
    if (IN(4)) {
        pg8::Gemm g{A2, W2T, MT, DM, DM}; pg8::StaticOrder S; S.init(MT, DM, G, bx);
        pg8::Epi2 E{Rb, GCb, MG};
        pg8::gemm_phase<pg8::Epi2, pg8::StaticOrder, true, true>(lds, g, S, E);
        GRID_BAR(4);
    }
    if (IN(5)) {
        pg8::Gemm g{MG, W3T, MT, DM, DM}; pg8::StaticOrder S; S.init(MT, DM, G, bx);
        pg8::EpiRes E{x, out, MOD + 2 * DM};
        pg8::gemm_phase<pg8::EpiRes, pg8::StaticOrder, true, true>(lds, g, S, E);
        GRID_BAR(5);
    }
    if (IN(6)) { modnorm_phase(out, norm_ffn_g, MOD, 3 * DM, 4 * DM, H, gw, NGW, lane); GRID_BAR(6); }
    if (IN(7)) {
        pg8::Gemm g{H, W4T, MT, N4, DM}; pg8::StaticOrder S; S.init(MT, N4, G, bx);
        pg8::Epi4 E{HF};
        pg8::gemm_phase<pg8::Epi4, pg8::StaticOrder, true, true>(lds, g, S, E);
        GRID_BAR(7);
    }
    if (IN(8)) {
        pg8::Gemm g{HF, W5T, MT, DM, DFF}; pg8::StaticOrder S; S.init(MT, DM, G, bx);
        pg8::EpiRes E{out, out, MOD + 5 * DM};
        pg8::gemm_phase<pg8::EpiRes, pg8::StaticOrder, true, true>(lds, g, S, E);
    }
#undef IN
#undef BOTH
#undef GRID_BAR
}

extern "C" void kernel_launch(void* const* d_in, const int* in_sizes, int n_in, void* d_out, int out_size, void* d_ws, size_t ws_size, hipStream_t stream) {
    static int grid = 0;
    if (grid == 0) {
        if (n_in != 20 || in_sizes[0] != MT * DM || out_size != MT * DM || ws_size < WS_END) {
            fprintf(stderr, "kernel_launch: shape/workspace mismatch (n_in %d, in0 %d, out %d, ws %zu, need %zu); nothing launched\n", n_in, n_in > 0 ? in_sizes[0] : -1, out_size, ws_size, (size_t)WS_END); grid = -1; return; }
        int dev = 0, cus = 0, per_cu = 0;
        if (hipGetDevice(&dev) != hipSuccess || hipDeviceGetAttribute(&cus, hipDeviceAttributeMultiprocessorCount, dev) != hipSuccess) { fprintf(stderr, "kernel_launch: device query failed\n"); grid = -1; return; }
        if (hipFuncSetAttribute((const void*)fwd_kernel, hipFuncAttributeMaxDynamicSharedMemorySize, LDS_BYTES) != hipSuccess) { fprintf(stderr, "kernel_launch: hipFuncSetAttribute failed\n"); grid = -1; return; }
        if (hipOccupancyMaxActiveBlocksPerMultiprocessor(&per_cu, (const void*)fwd_kernel, NWAVES * 64, LDS_BYTES) != hipSuccess || per_cu < 1) { fprintf(stderr, "kernel_launch: occupancy query says %d blocks per CU\n", per_cu); per_cu = 1; }
        (void)hipGetLastError();
        grid = cus * (per_cu < 1 ? 1 : 1);
        if (grid != 256) fprintf(stderr, "kernel_launch: note: grid = %d workgroups\n", grid);
    }
    if (grid < 0) return;
    if (hipMemsetAsync((char*)d_ws + WS_CTL, 0, CTL_ZERO_BYTES, stream) != hipSuccess) { fprintf(stderr, "kernel_launch: memset failed\n"); return; }
    Args a{};
    for (int i = 0; i < 20; ++i) a.in[i] = (const float*)d_in[i];
    a.out = (float*)d_out; a.ws = (unsigned char*)d_ws;
#if MK_PER_PHASE
    for (int ph = 0; ph < N_PHASES; ++ph) { a.ph_lo = ph; a.ph_hi = ph + 1; hipLaunchKernelGGL(fwd_kernel, dim3(grid), dim3(NWAVES * 64), LDS_BYTES, stream, a); }
#else
    a.ph_lo = 0; a.ph_hi = N_PHASES;
    void* kargs[] = {(void*)&a};
    const hipError_t e = hipLaunchCooperativeKernel((const void*)fwd_kernel, dim3(grid), dim3(NWAVES * 64), kargs, LDS_BYTES, stream);
    if (e != hipSuccess) fprintf(stderr, "kernel_launch: cooperative launch failed: %s (grid %d)\n", hipGetErrorString(e), grid);
#endif
}
```

```cpp
#include <hip/hip_runtime.h>
#include <hip/hip_cooperative_groups.h>
#include <cstdio>
#include <cstdint>
namespace cg = cooperative_groups;

#ifndef MK_PER_PHASE
#define MK_PER_PHASE 0
#endif
#ifndef MK_CG_SYNC
#define MK_CG_SYNC 0
#endif

namespace pg8 {
#define PG8_LAS __attribute__((address_space(3)))
typedef unsigned short bf16_t;
typedef short bf16x8 __attribute__((ext_vector_type(8)));
typedef float f32x4 __attribute__((ext_vector_type(4)));
typedef unsigned u32x4 __attribute__((ext_vector_type(4)));
constexpr int BM = 256, BK = 64, HALF = 128, HTB = HALF * BK * 2  , STAGE_BYTES = 8 * HTB, NXCD = 8, WGM = 8;

__host__ __device__ __forceinline__ int lds_byte(int r, int c) { const int st = (r >> 4) * 2 + (c >> 5), rr = r & 15, cc = c & 31, ob = rr * 64 + cc * 2; return st * 1024 + (ob ^ (((ob >> 9) & 1) << 5)); }
__host__ __device__ __forceinline__ void stage_rc(int b, int& R, int& C) { const int st = b / 1024, sb = b % 1024, swz = sb ^ (((sb >> 9) & 1) << 5); R = (st >> 1) * 16 + swz / 64; C = (st & 1) * 32 + (swz % 64) / 2; }
__host__ __device__ __forceinline__ int perm32(int rho) { const int n = rho >> 4, i = rho & 15; return 8 * (i >> 2) + 4 * n + (i & 3); }

struct Unit { int pm, pn; };
struct Gemm { const bf16_t* A; const bf16_t* Bt; int M, N, K; };

struct StaticOrder {
    int nM, nN, nwg, G, c;
    __host__ __device__ void init(int M, int N, int G_, int c_) { nM = M / BM; nN = N / BM; nwg = nM * nN; G = G_; c = c_; }
    __host__ __device__ bool next(int i, Unit& u) const {
        const long L = (long)i * G + c; if (L >= nwg) return false;
        int wgid = (int)L; { const int q = nwg / NXCD, r = nwg % NXCD, xcd = wgid % NXCD, off = wgid / NXCD; wgid = (xcd < r ? xcd * (q + 1) : r * (q + 1) + (xcd - r) * q) + off; }
        const int nig = WGM * nN, gid = wgid / nig, fm = gid * WGM, gsz = (nM - fm) < WGM ? (nM - fm) : WGM;
        u.pm = fm + ((wgid % nig) % gsz); u.pn = (wgid % nig) / gsz; return true;
    }
    __device__ __forceinline__ void a_ready(const Unit&) const {}
    __device__ __forceinline__ void done(const Unit&) const {}
};


__device__ __forceinline__ unsigned cvt_pk_bf16(float lo, float hi) { unsigned r; asm volatile("v_cvt_pk_bf16_f32 %0, %1, %2" : "=v"(r) : "v"(lo), "v"(hi)); return r; }
__device__ __forceinline__ float sigm(float x) { return __builtin_amdgcn_rcpf(1.0f + __builtin_amdgcn_exp2f(-1.4426950408889634f * x)); }
__device__ __forceinline__ u32x4 pack8(const f32x4& v0, const f32x4& v1) { u32x4 w; w.x = cvt_pk_bf16(v0[0], v0[1]); w.y = cvt_pk_bf16(v0[2], v0[3]); w.z = cvt_pk_bf16(v1[0], v1[1]); w.w = cvt_pk_bf16(v1[2], v1[3]); return w; }
__device__ __forceinline__ void unpack8(const u32x4& w, f32x4& v0, f32x4& v1) {
    v0[0] = __uint_as_float(w.x << 16); v0[1] = __uint_as_float(w.x & 0xffff0000u); v0[2] = __uint_as_float(w.y << 16); v0[3] = __uint_as_float(w.y & 0xffff0000u);
    v1[0] = __uint_as_float(w.z << 16); v1[1] = __uint_as_float(w.z & 0xffff0000u); v1[2] = __uint_as_float(w.w << 16); v1[3] = __uint_as_float(w.w & 0xffff0000u); }

struct Epi1 {
    static constexpr bool PERM = true, AFTER_DRAIN = false, MID = false;
    bf16_t *Q, *U, *R, *GC;
    __device__ __forceinline__ void mid(f32x4 (&)[2][2][4][2], const Unit&, int, int, int, int) const {}
    __device__ __forceinline__ void operator()(const f32x4 (&acc)[2][2][4][2], const Unit& u, int wr, int wc, int fr, int fq) const {
        const int row0 = u.pm * BM + wr * 64 + fr, cl = wc * 32 + 8 * fq;
        if (u.pn < 6) {
            const size_t boff = u.pn < 4 ? (size_t)0 : (u.pn == 4 ? (size_t)8388608 : (size_t)10485760);
            bf16_t* base = Q + boff; const int ld = u.pn < 4 ? 1024 : 256, c0 = u.pn < 4 ? u.pn * 256 : 0;
#pragma unroll
            for (int ai = 0; ai < 2; ++ai)
#pragma unroll
                for (int m = 0; m < 4; ++m) { bf16_t* rowp = base + (size_t)(row0 + ai * HALF + m * 16) * ld + c0 + cl;
#pragma unroll
                    for (int bj = 0; bj < 2; ++bj) *(u32x4*)(rowp + bj * HALF) = pack8(acc[ai][bj][m][0], acc[ai][bj][m][1]); }
        } else if (u.pn < 14) {
            const int c0 = (u.pn - 6) * 128 + cl;
#pragma unroll
            for (int ai = 0; ai < 2; ++ai)
#pragma unroll
                for (int m = 0; m < 4; ++m) { f32x4 o[2];
#pragma unroll
                    for (int n = 0; n < 2; ++n)
#pragma unroll
                        for (int e = 0; e < 4; ++e) o[n][e] = acc[ai][0][m][n][e] * sigm(acc[ai][1][m][n][e]);
                    *(u32x4*)(U + (size_t)(row0 + ai * HALF + m * 16) * 1024 + c0) = pack8(o[0], o[1]); }
        } else {
            const int c0 = (u.pn - 14) * 128 + cl;
#pragma unroll
            for (int ai = 0; ai < 2; ++ai)
#pragma unroll
                for (int m = 0; m < 4; ++m) { f32x4 r[2], g[2];
#pragma unroll
                    for (int n = 0; n < 2; ++n)
#pragma unroll
                        for (int e = 0; e < 4; ++e) { const float ea = __builtin_amdgcn_exp2f(-1.4426950408889634f * acc[ai][0][m][n][e]), ec = __builtin_amdgcn_exp2f(-1.4426950408889634f * acc[ai][1][m][n][e]);
                            g[n][e] = __builtin_amdgcn_rcpf(1.0f + ec); r[n][e] = (1.0f + ec) * __builtin_amdgcn_rcpf(1.0f + ea); }
                    const size_t off = (size_t)(row0 + ai * HALF + m * 16) * 2048 + c0;
                    *(u32x4*)(R + off) = pack8(r[0], r[1]); *(u32x4*)(GC + off) = pack8(g[0], g[1]); }
        }
    }
};
struct Epi2 {
    static constexpr bool PERM = true, AFTER_DRAIN = false, MID = true;
    const bf16_t *R, *GC; bf16_t* O;
    __device__ __forceinline__ void mid(f32x4 (&acc)[2][2][4][2], const Unit& u, int wr, int wc, int fr, int fq) const {
        asm volatile("" : "+v"(fr), "+v"(fq));
        const int row0 = u.pm * BM + wr * 64 + fr, col0 = u.pn * BM + wc * 32 + 8 * fq;
#pragma unroll
        for (int ai = 0; ai < 2; ++ai)
#pragma unroll
            for (int m = 0; m < 4; ++m) { const bf16_t* rowp = R + (size_t)(row0 + ai * HALF + m * 16) * 2048 + col0;
#pragma unroll
                for (int bj = 0; bj < 2; ++bj) { const u32x4 w = *(const u32x4*)(rowp + bj * HALF); f32x4 s0, s1; unpack8(w, s0, s1); acc[ai][bj][m][0] *= s0; acc[ai][bj][m][1] *= s1; }
                if (m & 1) asm volatile("" ::: "memory"); }
    }
    __device__ __forceinline__ void operator()(const f32x4 (&acc)[2][2][4][2], const Unit& u, int wr, int wc, int fr, int fq) const {
        const int row0 = u.pm * BM + wr * 64 + fr, col0 = u.pn * BM + wc * 32 + 8 * fq;
#pragma unroll
        for (int ai = 0; ai < 2; ++ai)
#pragma unroll
            for (int m = 0; m < 4; ++m) { const size_t off = (size_t)(row0 + ai * HALF + m * 16) * 2048 + col0;
#pragma unroll
                for (int bj = 0; bj < 2; ++bj) { const u32x4 w = *(const u32x4*)(GC + off + bj * HALF); f32x4 s0, s1; unpack8(w, s0, s1);
                    *(u32x4*)(O + off + bj * HALF) = pack8(acc[ai][bj][m][0] * s0, acc[ai][bj][m][1] * s1); }
                if (m & 1) asm volatile("" ::: "memory"); }
    }
};
struct EpiRes {
    static constexpr bool PERM = false, AFTER_DRAIN = false, MID = false;
    const float* base; float* out; const float* gate;
    __device__ __forceinline__ void mid(f32x4 (&)[2][2][4][2], const Unit&, int, int, int, int) const {}
    __device__ __forceinline__ void operator()(const f32x4 (&acc)[2][2][4][2], const Unit& u, int wr, int wc, int fr, int fq) const {
        const int row0 = u.pm * BM + wr * 64 + fr, col0 = u.pn * BM + wc * 32 + 4 * fq;
        const float* gp = gate + (size_t)(u.pm >> 3) * 12288 + col0;
        f32x4 gv[2][2];
#pragma unroll
        for (int bj = 0; bj < 2; ++bj)
#pragma unroll
            for (int n = 0; n < 2; ++n) gv[bj][n] = *(const f32x4*)(gp + bj * HALF + n * 16);
#pragma unroll
        for (int ai = 0; ai < 2; ++ai)
#pragma unroll
            for (int m = 0; m < 4; ++m) { const size_t off = (size_t)(row0 + ai * HALF + m * 16) * 2048 + col0;
#pragma unroll
                for (int bj = 0; bj < 2; ++bj)
#pragma unroll
                    for (int n = 0; n < 2; ++n) { const f32x4 b = *(const f32x4*)(base + off + bj * HALF + n * 16); *(f32x4*)(out + off + bj * HALF + n * 16) = b + gv[bj][n] * acc[ai][bj][m][n]; } }
    }
};
struct Epi4 {
    static constexpr bool PERM = true, AFTER_DRAIN = false, MID = false;
    bf16_t* HF;
    __device__ __forceinline__ void mid(f32x4 (&)[2][2][4][2], const Unit&, int, int, int, int) const {}
    __device__ __forceinline__ void operator()(const f32x4 (&acc)[2][2][4][2], const Unit& u, int wr, int wc, int fr, int fq) const {
        const int row0 = u.pm * BM + wr * 64 + fr, c0 = u.pn * 128 + wc * 32 + 8 * fq;
#pragma unroll
        for (int ai = 0; ai < 2; ++ai)
#pragma unroll
            for (int m = 0; m < 4; ++m) { f32x4 o[2];
#pragma unroll
                for (int n = 0; n < 2; ++n)
#pragma unroll
                    for (int e = 0; e < 4; ++e) { const float g = acc[ai][0][m][n][e]; o[n][e] = g * sigm(g) * acc[ai][1][m][n][e]; }
                *(u32x4*)(HF + (size_t)(row0 + ai * HALF + m * 16) * 5632 + c0) = pack8(o[0], o[1]); }
    }
};

template <class Epi, class Sched, bool ALIGN_EPI = false, bool SP2 = false>
__device__ __forceinline__ void gemm_phase(PG8_LAS unsigned char* lds, const Gemm g, const Sched& S, const Epi& E) {
    const int tid = threadIdx.x, wid = __builtin_amdgcn_readfirstlane(tid >> 6), lane = tid & 63, wr = wid >> 2, wc = wid & 3, fr = lane & 15, fq = lane >> 4;
    const int K = g.K, nt = K / BK;
    unsigned voffA[2], voffB[2];
#pragma unroll
    for (int i = 0; i < 2; ++i) { int R, C; stage_rc(tid * 16 + i * 8192, R, C); const int Rb = Epi::PERM ? ((R & ~31) + perm32(R & 31)) : R;
        voffA[i] = (unsigned)(R * K + C) * 2u; voffB[i] = (unsigned)(Rb * K + C) * 2u; }
    const size_t kstep = (size_t)(BK * 2);
    const size_t hstep = (size_t)HALF * K * 2;
    const size_t tstep = 2 * hstep;
    const unsigned ldsw = (unsigned)wid * 1024u;
    const int aoff = lds_byte(wr * 64 + fr, fq * 8), boff = lds_byte(wc * 32 + fr, fq * 8);
#define PG8_SA(b, h) (((b) * 2 + (h)) * HTB)
#define PG8_SB(b, h) ((4 + (b) * 2 + (h)) * HTB)
#define PG8_STAGE(bufoff, gbase, voff) do { _Pragma("unroll") for (int _i = 0; _i < 2; ++_i) \
        __builtin_amdgcn_global_load_lds((const unsigned*)((const char*)(gbase) + (voff)[_i]), (PG8_LAS unsigned*)(lds + (bufoff) + ldsw + _i * 8192), 16, 0, 0); } while (0)
#define PG8_LDA(dst, b, h) do { _Pragma("unroll") for (int m = 0; m < 4; ++m) _Pragma("unroll") for (int k = 0; k < 2; ++k) dst[m][k] = *(const PG8_LAS bf16x8*)(lds + PG8_SA(b, h) + aoff + m * 2048 + k * 1024); } while (0)
#define PG8_LDB(dst, b, h) do { _Pragma("unroll") for (int n = 0; n < 2; ++n) _Pragma("unroll") for (int k = 0; k < 2; ++k) dst[n][k] = *(const PG8_LAS bf16x8*)(lds + PG8_SB(b, h) + boff + n * 2048 + k * 1024); } while (0)
#define PG8_MMA(ai, bj, At, Bt) do { __builtin_amdgcn_s_setprio(1); _Pragma("unroll") for (int m = 0; m < 4; ++m) _Pragma("unroll") for (int n = 0; n < 2; ++n) _Pragma("unroll") for (int k = 0; k < 2; ++k) \
        acc[ai][bj][m][n] = __builtin_amdgcn_mfma_f32_16x16x32_bf16(Bt[n][k], At[m][k], acc[ai][bj][m][n], 0, 0, 0); __builtin_amdgcn_s_setprio(0); } while (0)
#define PG8_WAIT_V(n) asm volatile("s_waitcnt vmcnt(" #n ")" ::: "memory")
#define PG8_WAIT_L(n) asm volatile("s_waitcnt lgkmcnt(" #n ")" ::: "memory")
#define PG8_BAR __builtin_amdgcn_s_barrier()
#define PG8_SCHED __builtin_amdgcn_sched_barrier(0)
    Unit cur, nxt; int ui = 0;
    if (!S.next(0, cur)) return;
    f32x4 acc[2][2][4][2];
#pragma unroll
    for (int a = 0; a < 2; ++a)
#pragma unroll
        for (int b = 0; b < 2; ++b)
#pragma unroll
            for (int m = 0; m < 4; ++m)
#pragma unroll
                for (int n = 0; n < 2; ++n) acc[a][b][m][n] = (f32x4){0.f, 0.f, 0.f, 0.f};
    bf16x8 At[4][2], B0[2][2], B1[2][2];
    const char* cA = (const char*)g.A + (size_t)cur.pm * tstep; const char* cB = (const char*)g.Bt + (size_t)cur.pn * tstep;
    S.a_ready(cur);
    if constexpr (SP2) {
        PG8_STAGE(PG8_SB(0, 0), cB, voffB); PG8_STAGE(PG8_SB(0, 1), cB + hstep, voffB); PG8_STAGE(PG8_SA(0, 0), cA, voffA); PG8_STAGE(PG8_SA(0, 1), cA + hstep, voffA);
        if (wr == 1) PG8_BAR;
        PG8_WAIT_V(2); PG8_BAR;
        PG8_STAGE(PG8_SB(1, 0), cB + kstep, voffB); PG8_STAGE(PG8_SA(1, 0), cA + kstep, voffA); PG8_STAGE(PG8_SB(1, 1), cB + hstep + kstep, voffB);
        PG8_WAIT_V(6); PG8_BAR;
    } else {
        PG8_STAGE(PG8_SB(0, 0), cB, voffB); PG8_STAGE(PG8_SA(0, 0), cA, voffA); PG8_STAGE(PG8_SB(0, 1), cB + hstep, voffB); PG8_STAGE(PG8_SA(0, 1), cA + hstep, voffA);
        if (wr == 1) PG8_BAR;
        PG8_WAIT_V(4); PG8_BAR;
        PG8_STAGE(PG8_SB(1, 0), cB + kstep, voffB); PG8_STAGE(PG8_SA(1, 0), cA + kstep, voffA); PG8_STAGE(PG8_SB(1, 1), cB + hstep + kstep, voffB);
        PG8_WAIT_V(6); PG8_BAR;
    }
    for (;;) {
        const bool has_next = S.next(ui + 1, nxt);
        const char* nA = has_next ? (const char*)g.A + (size_t)nxt.pm * tstep : cA; const char* nB = has_next ? (const char*)g.Bt + (size_t)nxt.pn * tstep : cB;
        for (int t = 0; t < nt; t += 2) {
            const bool last = (t == nt - 2);
            const char* a1 = cA + (size_t)(t + 1) * kstep;
            const char* a2 = last ? nA : cA + (size_t)(t + 2) * kstep; const char* b2 = last ? nB : cB + (size_t)(t + 2) * kstep;
            const char* a3 = a2 + kstep; const char* b3 = b2 + kstep;
            if (last && has_next) S.a_ready(nxt);
            if constexpr (Epi::MID) { if (t == (nt >> 1)) E.mid(acc, cur, wr, wc, fr, fq); }
            if constexpr (SP2) {
            PG8_LDB(B0, 0, 0); PG8_LDB(B1, 0, 1); PG8_SCHED; PG8_LDA(At, 0, 0); PG8_STAGE(PG8_SA(1, 1), a1 + hstep, voffA);
            PG8_WAIT_V(8); PG8_WAIT_L(0); PG8_BAR; PG8_MMA(0, 0, At, B0); PG8_MMA(0, 1, At, B1); PG8_BAR; PG8_SCHED;
            PG8_LDA(At, 0, 1); PG8_STAGE(PG8_SB(0, 0), b2, voffB); PG8_STAGE(PG8_SB(0, 1), b2 + hstep, voffB); PG8_STAGE(PG8_SA(0, 0), a2, voffA);
            PG8_WAIT_V(8); PG8_WAIT_L(0); PG8_BAR; PG8_MMA(1, 0, At, B0); PG8_MMA(1, 1, At, B1); PG8_BAR; PG8_SCHED;
            PG8_LDB(B0, 1, 0); PG8_LDB(B1, 1, 1); PG8_SCHED; PG8_LDA(At, 1, 0); PG8_STAGE(PG8_SA(0, 1), a2 + hstep, voffA);
            PG8_WAIT_V(8); PG8_WAIT_L(0); PG8_BAR; PG8_MMA(0, 0, At, B0); PG8_MMA(0, 1, At, B1); PG8_BAR; PG8_SCHED;
            PG8_LDA(At, 1, 1); PG8_STAGE(PG8_SB(1, 0), b3, voffB); PG8_STAGE(PG8_SB(1, 1), b3 + hstep, voffB); PG8_STAGE(PG8_SA(1, 0), a3, voffA);
            PG8_WAIT_V(8); PG8_WAIT_L(0); PG8_BAR; PG8_MMA(1, 0, At, B0); PG8_MMA(1, 1, At, B1); PG8_BAR; PG8_SCHED;
            } else {
            PG8_LDB(B0, 0, 0); PG8_SCHED; PG8_LDA(At, 0, 0); PG8_STAGE(PG8_SA(1, 1), a1 + hstep, voffA);
            PG8_WAIT_L(8); PG8_BAR; PG8_WAIT_L(0); PG8_MMA(0, 0, At, B0); PG8_BAR; PG8_SCHED;
            PG8_LDB(B1, 0, 1); PG8_STAGE(PG8_SB(0, 0), b2, voffB);
            PG8_BAR; PG8_WAIT_L(0); PG8_MMA(0, 1, At, B1); PG8_BAR;
            PG8_LDA(At, 0, 1); PG8_STAGE(PG8_SA(0, 0), a2, voffA);
            PG8_BAR; PG8_WAIT_L(0); PG8_MMA(1, 0, At, B0); PG8_BAR; PG8_SCHED;
            PG8_STAGE(PG8_SB(0, 1), b2 + hstep, voffB);
            PG8_WAIT_V(6); PG8_BAR; PG8_MMA(1, 1, At, B1); PG8_BAR;
            PG8_LDB(B0, 1, 0); PG8_SCHED; PG8_LDA(At, 1, 0); PG8_STAGE(PG8_SA(0, 1), a2 + hstep, voffA);
            PG8_WAIT_L(8); PG8_BAR; PG8_WAIT_L(0); PG8_MMA(0, 0, At, B0); PG8_BAR; PG8_SCHED;
            PG8_LDB(B1, 1, 1); PG8_STAGE(PG8_SB(1, 0), b3, voffB);
            PG8_BAR; PG8_WAIT_L(0); PG8_MMA(0, 1, At, B1); PG8_BAR;
            PG8_LDA(At, 1, 1); PG8_STAGE(PG8_SA(1, 0), a3, voffA);
            PG8_BAR; PG8_WAIT_L(0); PG8_MMA(1, 0, At, B0); PG8_BAR; PG8_SCHED;
            PG8_STAGE(PG8_SB(1, 1), b3 + hstep, voffB);
            PG8_WAIT_V(6); PG8_BAR; PG8_MMA(1, 1, At, B1); PG8_BAR;
            }
        }
        if constexpr (ALIGN_EPI) { if (wr == 0) PG8_BAR; }
        if constexpr (!Epi::AFTER_DRAIN) { E(acc, cur, wr, wc, fr, fq); S.done(cur); }
        if (!has_next) break;
#pragma unroll
        for (int a = 0; a < 2; ++a)
#pragma unroll
            for (int b = 0; b < 2; ++b)
#pragma unroll
                for (int m = 0; m < 4; ++m)
#pragma unroll
                    for (int n = 0; n < 2; ++n) acc[a][b][m][n] = (f32x4){0.f, 0.f, 0.f, 0.f};
        cur = nxt; cA = nA; cB = nB; ++ui;
        if constexpr (ALIGN_EPI) { if (wr == 1) PG8_BAR; }
    }
    PG8_WAIT_V(0);
    if constexpr (!ALIGN_EPI) { if (wr == 0) PG8_BAR; }
    PG8_BAR;
    if constexpr (Epi::AFTER_DRAIN) { E.fused(acc, cur, wr, wc, fr, fq, lds, wid, lane); S.done(cur); }
#undef PG8_SA
#undef PG8_SB
#undef PG8_STAGE
#undef PG8_LDA
#undef PG8_LDB
#undef PG8_MMA
#undef PG8_WAIT_V
#undef PG8_WAIT_L
#undef PG8_BAR
#undef PG8_SCHED
}
}


constexpr int NWAVES = 8;
constexpr int DM = 2048, BATCH = 4, SEQ = 2048, MT = BATCH * SEQ;
constexpr int NQ = 1024, NKVW = 256, CONVC = 1024, DFF = 5632, NMOD = 6 * DM;
constexpr int N1 = 7680, N4 = 2 * DFF;
constexpr float EPS = 1e-6f, LOG2E = 1.4426950408889634f;
constexpr int N_PHASES = 9;

constexpr size_t MiB = 1u << 20;
constexpr size_t WS_CTL = 0, WS_MOD = 65536, CTL_ZERO_BYTES = 262144;
constexpr size_t WS_W1T = 1 * MiB, WS_W2T = 31 * MiB, WS_W3T = 39 * MiB, WS_W4T = 47 * MiB, WS_W5T = 91 * MiB;
constexpr size_t WS_H = 113 * MiB;
constexpr size_t WS_Q = 145 * MiB, WS_K = 161 * MiB, WS_V = 165 * MiB, WS_U = 169 * MiB, WS_R = 185 * MiB, WS_GC = 217 * MiB;
constexpr size_t WS_A2 = 249 * MiB, WS_MG = 281 * MiB, WS_END = 313 * MiB;
constexpr size_t WS_HF = 145 * MiB;
static_assert(WS_HF + (size_t)MT * DFF * 2 <= WS_A2, "HF overlay");
static_assert(WS_K - WS_Q == 2 * (size_t)8388608 && WS_V - WS_Q == 2 * (size_t)10485760, "Epi1 reaches K and V from Q by fixed element offsets");
constexpr int CW_BAR = 1024;

constexpr int RING_BYTES = 131072, LDSCTL_OFF = RING_BYTES, MISC_OFF = LDSCTL_OFF + 320, LDS_BYTES = 147456;

#define GAS __attribute__((address_space(1)))
#define LAS __attribute__((address_space(3)))
typedef unsigned short bf16;
typedef unsigned v4u __attribute__((ext_vector_type(4)));
typedef unsigned v2u __attribute__((ext_vector_type(2)));
typedef float f32x4 __attribute__((ext_vector_type(4)));
typedef float f32x2 __attribute__((ext_vector_type(2)));
typedef float f32x16 __attribute__((ext_vector_type(16)));
typedef short bf16x8 __attribute__((ext_vector_type(8)));
typedef short s16x4 __attribute__((ext_vector_type(4)));
typedef GAS unsigned gu32;
#define RLX_AGENT __ATOMIC_RELAXED, __HIP_MEMORY_SCOPE_AGENT
#define LDS_WAIT() asm volatile("s_waitcnt lgkmcnt(0)" ::: "memory")
__device__ __forceinline__ unsigned f2bf(float f) { unsigned u = __builtin_bit_cast(unsigned, f); return (u + 0x7fffu + ((u >> 16) & 1u)) >> 16; }
__device__ __forceinline__ unsigned pk2(float lo, float hi) { return f2bf(lo) | (f2bf(hi) << 16); }
__device__ __forceinline__ float bflo(unsigned w) { return __uint_as_float(w << 16); }
__device__ __forceinline__ float bfhi(unsigned w) { return __uint_as_float(w & 0xffff0000u); }
__device__ __forceinline__ float sigm(float x) { return __builtin_amdgcn_rcpf(1.0f + __builtin_amdgcn_exp2f(-LOG2E * x)); }
__device__ __forceinline__ float wave_sum(float v) {
#pragma unroll
    for (int o = 1; o < 64; o <<= 1) v += __shfl_xor(v, o);
    return v;
}

#define XB_TMO      128
#define XB_XCNT(j)  (256  + 64 * (j))
#define XB_XSUB(j)  (1280 + 64 * (j))
#define XB_XGEN(j)  (2304 + 64 * (j))
#define XB_TOP      3328
#define XB_TOPGEN   3392
#define XCD_BAR_WORDS 3456
#define XB_SPIN_CAP (1u << 18)

__device__ __forceinline__ unsigned xb_ld(unsigned* p)              { return __hip_atomic_load(p, __ATOMIC_RELAXED, __HIP_MEMORY_SCOPE_AGENT); }
__device__ __forceinline__ unsigned xb_add(unsigned* p, unsigned v) { return __hip_atomic_fetch_add(p, v, __ATOMIC_RELAXED, __HIP_MEMORY_SCOPE_AGENT); }
__device__ __forceinline__ unsigned xb_xcc_id() { return (unsigned)__builtin_amdgcn_s_getreg((3 << 11) | 20) & 0xFu; }
#define XB_SPIN(cond, bar) do { unsigned _sp = 0; while (cond) { __builtin_amdgcn_s_sleep(1); \
    if ((++_sp & 255u) == 0u) { if (xb_ld(&(bar)[XB_TMO])) break; if (_sp > XB_SPIN_CAP) { atomicAdd(&(bar)[XB_TMO], 1u); break; } } } } while (0)

struct XcdBarrier {
    unsigned* bar; unsigned x;
    volatile LAS unsigned* st;
};

__device__ __forceinline__ XcdBarrier xcd_barrier_post(unsigned* bar, volatile LAS unsigned* st) {
    XcdBarrier b; b.bar = bar; b.x = xb_xcc_id(); b.st = st;
    if (threadIdx.x == 0) (void)xb_add(&bar[XB_XCNT(b.x)], 1u);
    return b;
}
__device__ __forceinline__ void xcd_barrier_complete(unsigned* bar, unsigned x, unsigned& nloc, unsigned& nx) {
    const unsigned G = gridDim.x * gridDim.y * gridDim.z;
    unsigned sum, cnt, mine, sp = 0u;
    for (;;) {
        sum = 0u; cnt = 0u; mine = 0u;
#pragma unroll
        for (unsigned j = 0; j < 16; ++j) { const unsigned c = xb_ld(&bar[XB_XCNT(j)]); sum += c; cnt += (c > 0u) ? 1u : 0u; mine = (j == x) ? c : mine; }
        if (sum == G) break;
        __builtin_amdgcn_s_sleep(1);
        if ((++sp & 255u) == 0u) { if (xb_ld(&bar[XB_TMO])) break; if (sp > XB_SPIN_CAP) { atomicAdd(&bar[XB_TMO], 1u); break; } }
    }
    nloc = mine > 0u ? mine : 1u; nx = cnt > 0u ? cnt : 1u;
}

__device__ __forceinline__ void xcd_barrier(const XcdBarrier& b) {
    asm volatile("s_waitcnt vmcnt(0)" ::: "memory");
    __syncthreads();
    if (threadIdx.x == 0) {
        unsigned* bar = b.bar;
        __builtin_amdgcn_s_waitcnt(0);
        unsigned nloc = b.st[0], nx = b.st[1];
        if (nloc == 0u) { xcd_barrier_complete(bar, b.x, nloc, nx); b.st[0] = nloc; b.st[1] = nx; }
        const unsigned old = xb_add(&bar[XB_XSUB(b.x)], 1u);
        const unsigned gen = old / nloc;
        if (old + 1u == (gen + 1u) * nloc) {
            __builtin_amdgcn_fence(__ATOMIC_RELEASE, "agent");
            asm volatile("s_waitcnt vmcnt(0)" ::: "memory");
            const unsigned og = xb_add(&bar[XB_TOP], 1u);
            const unsigned tg = og / nx;
            if (og + 1u == (tg + 1u) * nx) xb_add(&bar[XB_TOPGEN], 1u);
            else XB_SPIN(xb_ld(&bar[XB_TOPGEN]) == tg, bar);
            __builtin_amdgcn_fence(__ATOMIC_ACQUIRE, "agent");
            xb_add(&bar[XB_XGEN(b.x)], 1u);
            asm volatile("s_waitcnt vmcnt(0)" ::: "memory");
        } else {
            XB_SPIN(xb_ld(&bar[XB_XGEN(b.x)]) == gen, bar);
            __builtin_amdgcn_fence(__ATOMIC_ACQUIRE, "agent");
            asm volatile("s_waitcnt vmcnt(0)" ::: "memory");
        }
    }
    __syncthreads();
}

__device__ __forceinline__ void p0_adaln(const float* c, const float* w_ada, const float* b_ada, float* MOD, LAS float* red, int tid, int lane, int wave) {
    for (int it = blockIdx.x; it < 48 * 16; it += gridDim.x) {
        const int cgp = it % 48, kc = it / 48, k0 = kc * 128 + wave * 16, c0 = cgp * 256 + lane * 4;
        const float cv = c[(lane >> 4) * DM + k0 + (lane & 15)];
        const float sv = cv * sigm(cv);
        f32x4 acc[4];
#pragma unroll
        for (int b = 0; b < 4; ++b) acc[b] = (f32x4){0.f, 0.f, 0.f, 0.f};
#pragma unroll
        for (int r = 0; r < 16; ++r) { const f32x4 w4 = *(const f32x4*)(w_ada + (size_t)(k0 + r) * NMOD + c0);
#pragma unroll
            for (int b = 0; b < 4; ++b) { const float s = __shfl(sv, b * 16 + r); acc[b] += w4 * s; } }
#pragma unroll
        for (int b = 0; b < 4; ++b) *(LAS f32x4*)(red + ((wave * 4 + b) * 256 + lane * 4)) = acc[b];
        __syncthreads();
#pragma unroll
        for (int e = 0; e < 2; ++e) { const int o = tid * 2 + e, b = o >> 8, col = o & 255; float s = 0.f;
#pragma unroll
            for (int w = 0; w < 8; ++w) s += red[(w * 4 + b) * 256 + col];
            if (kc == 0) s += b_ada[cgp * 256 + col];
            atomicAdd(MOD + b * NMOD + cgp * 256 + col, s); }
        __syncthreads();
    }
}
__device__ __forceinline__ int maprow(int mapid, int n0) {
    if (mapid == 1) {
        if (n0 < 1536) return n0;
        if (n0 < 2560) { const int t = n0 - 1536; return 1536 + ((t >> 7) << 8) + (t & 127); }
        if (n0 < 3584) { const int t = n0 - 2560; return 1536 + ((t >> 7) << 8) + 128 + (t & 127); }
        if (n0 < 5632) { const int t = n0 - 3584; return 3584 + ((t >> 7) << 8) + (t & 127); }
        const int t = n0 - 5632; return 3584 + ((t >> 7) << 8) + 128 + (t & 127);
    }
    if (mapid == 2) {
        if (n0 < DFF) return ((n0 >> 7) << 8) + (n0 & 127);
        const int t = n0 - DFF; return ((t >> 7) << 8) + 128 + (t & 127);
    }
    return n0;
}
__device__ __forceinline__ void transpose_item(const float* W, int N, bf16* WT, int ldk, int koff, int mapid, LAS float* scr, int item, int lane) {
    const int nblk = N / 32, kb = item / nblk, nb = item % nblk, k0 = 64 * kb, n0 = 32 * nb;
#pragma unroll 8
    for (int i = 0; i < 32; ++i) { const int kk = 2 * i + (lane >> 5); scr[kk * 33 + (lane & 31)] = W[(size_t)(k0 + kk) * N + n0 + (lane & 31)]; }
    LDS_WAIT(); asm volatile("" ::: "memory");
    const int c = lane & 7, drow0 = maprow(mapid, n0);
#pragma unroll
    for (int j = 0; j < 4; ++j) { const int n = (lane >> 3) + 8 * j; const LAS float* s = scr + (8 * c) * 33 + n;
        v4u o; o.x = pk2(s[0 * 33], s[1 * 33]); o.y = pk2(s[2 * 33], s[3 * 33]); o.z = pk2(s[4 * 33], s[5 * 33]); o.w = pk2(s[6 * 33], s[7 * 33]);
        *(GAS v4u*)(WT + (size_t)(drow0 + n) * ldk + koff + k0 + 8 * c) = o; }
    LDS_WAIT(); asm volatile("" ::: "memory");
}
__device__ __forceinline__ void modnorm_phase(const float* X, const float* g, const float* MOD, int sh_off, int sc_off, bf16* H, int gw, int NGW, int lane) {
    for (int it = gw; it < MT / 4; it += NGW) {
        const int row0 = it * 4, b = row0 / SEQ;
        f32x4 A[8], Bv[8];
#pragma unroll
        for (int j = 0; j < 8; ++j) { const int col = 4 * (lane + 64 * j);
            const f32x4 gg = *(const f32x4*)(g + col), sc = *(const f32x4*)(MOD + (size_t)b * NMOD + sc_off + col);
            A[j] = gg * (1.0f + sc); Bv[j] = *(const f32x4*)(MOD + (size_t)b * NMOD + sh_off + col); }
        for (int r = 0; r < 4; ++r) {
            const float* xr = X + (size_t)(row0 + r) * DM;
            f32x4 v[8]; float ss = 0.f;
#pragma unroll
            for (int j = 0; j < 8; ++j) { v[j] = *(const f32x4*)(xr + 4 * (lane + 64 * j)); ss += (v[j].x * v[j].x + v[j].y * v[j].y) + (v[j].z * v[j].z + v[j].w * v[j].w); }
            const float rstd = 1.0f / sqrtf(wave_sum(ss) * (1.0f / DM) + EPS);
            bf16* hr = H + (size_t)(row0 + r) * DM;
#pragma unroll
            for (int j = 0; j < 8; ++j) { const f32x4 o = v[j] * rstd * A[j] + Bv[j]; v2u w; w.x = pk2(o.x, o.y); w.y = pk2(o.z, o.w); *(GAS v2u*)(hr + 4 * (lane + 64 * j)) = w; }
        }
    }
}
__device__ __forceinline__ int crow(int r, int hi) { return (r & 3) + 8 * (r >> 2) + 4 * hi; }
__device__ __forceinline__ void attn_unit(int unit, const bf16* Qb, const bf16* Kb, const bf16* Vb, bf16* A2, const float* qg, const float* kg, const float* sinks, const float* relb,
                                          LAS unsigned char* lds, int tid, int lane, int wave) {
    const int b = unit >> 6, kvh = (unit >> 4) & 3, nb = unit & 15;
    LAS bf16* Ks = (LAS bf16*)lds;
    LAS bf16* Vt = (LAS bf16*)(lds + 36864);
    LAS float* biasT = (LAS float*)(lds + 36864 + 33792);
    LAS float* lscr = biasT + 512 + wave * 32;
    const int tok0 = b * SEQ + nb * 128;
#pragma unroll
    for (int i = 0; i < 4; ++i) {
        const int c = tid + 512 * i, key = c >> 3, part = c & 7;
        const bool real = (nb > 0) || (key >= 128);
        const long tok = (long)tok0 - 128 + key;
        v4u kw = (v4u){0u, 0u, 0u, 0u}, vw = (v4u){0u, 0u, 0u, 0u};
        if (real) { kw = *(const v4u*)(Kb + tok * 256 + kvh * 64 + part * 8); vw = *(const v4u*)(Vb + tok * 256 + kvh * 64 + part * 8); }
        const f32x4 k0 = (f32x4){bflo(kw.x), bfhi(kw.x), bflo(kw.y), bfhi(kw.y)}, k1 = (f32x4){bflo(kw.z), bfhi(kw.z), bflo(kw.w), bfhi(kw.w)};
        float ss = (k0.x * k0.x + k0.y * k0.y) + (k0.z * k0.z + k0.w * k0.w) + (k1.x * k1.x + k1.y * k1.y) + (k1.z * k1.z + k1.w * k1.w);
        ss += __shfl_xor(ss, 1); ss += __shfl_xor(ss, 2); ss += __shfl_xor(ss, 4);
        const float rstd = 1.0f / sqrtf(ss * (1.0f / 64.0f) + EPS);
        const f32x4 g0 = *(const f32x4*)(kg + part * 8) * rstd, g1 = *(const f32x4*)(kg + part * 8 + 4) * rstd;
        v4u o; o.x = pk2(k0.x * g0.x, k0.y * g0.y); o.y = pk2(k0.z * g0.z, k0.w * g0.w); o.z = pk2(k1.x * g1.x, k1.y * g1.y); o.w = pk2(k1.z * g1.z, k1.w * g1.w);
        *(LAS v4u*)(Ks + key * 72 + part * 8) = o;
        LAS bf16* vt = Vt + (part * 8) * 264 + key;
        vt[0 * 264] = (bf16)(vw.x & 0xffffu); vt[1 * 264] = (bf16)(vw.x >> 16); vt[2 * 264] = (bf16)(vw.y & 0xffffu); vt[3 * 264] = (bf16)(vw.y >> 16);
        vt[4 * 264] = (bf16)(vw.z & 0xffffu); vt[5 * 264] = (bf16)(vw.z >> 16); vt[6 * 264] = (bf16)(vw.w & 0xffffu); vt[7 * 264] = (bf16)(vw.w >> 16);
    }
    { const int g = tid >> 7, dist = tid & 127; int bucket = dist;
      if (dist >= 16) { const int l = 16 + (int)(logf((float)dist * (1.0f / 16.0f)) / 2.0794415416798357f * 16.0f); bucket = l < 31 ? l : 31; }
      biasT[tid] = relb[bucket * 16 + kvh * 4 + g] * LOG2E; }
    __syncthreads();
    const int q = lane & 31, hi = lane >> 5;
    for (int pass = 0; pass < 2; ++pass) {
        const int pi = wave * 2 + pass, g = pi >> 2, qblk = pi & 3, h = kvh * 4 + g, q0 = qblk * 32;
        const bf16* qrow = Qb + (size_t)(tok0 + q0 + q) * 1024 + h * 64 + hi * 8;
        v4u qw[4]; float ss = 0.f;
#pragma unroll
        for (int ks = 0; ks < 4; ++ks) { qw[ks] = *(const v4u*)(qrow + 16 * ks);
            const float a0 = bflo(qw[ks].x), a1 = bfhi(qw[ks].x), a2 = bflo(qw[ks].y), a3 = bfhi(qw[ks].y), a4 = bflo(qw[ks].z), a5 = bfhi(qw[ks].z), a6 = bflo(qw[ks].w), a7 = bfhi(qw[ks].w);
            ss += (a0 * a0 + a1 * a1) + (a2 * a2 + a3 * a3) + (a4 * a4 + a5 * a5) + (a6 * a6 + a7 * a7); }
        ss += __shfl_xor(ss, 32);
        const float rs = (1.0f / sqrtf(ss * (1.0f / 64.0f) + EPS)) * (0.125f * LOG2E);
        bf16x8 qf[4];
#pragma unroll
        for (int ks = 0; ks < 4; ++ks) { const f32x4 g0 = *(const f32x4*)(qg + 16 * ks + 8 * hi) * rs, g1 = *(const f32x4*)(qg + 16 * ks + 8 * hi + 4) * rs;
            v4u o; o.x = pk2(bflo(qw[ks].x) * g0.x, bfhi(qw[ks].x) * g0.y); o.y = pk2(bflo(qw[ks].y) * g0.z, bfhi(qw[ks].y) * g0.w);
            o.z = pk2(bflo(qw[ks].z) * g1.x, bfhi(qw[ks].z) * g1.y); o.w = pk2(bflo(qw[ks].w) * g1.z, bfhi(qw[ks].w) * g1.w);
            qf[ks] = __builtin_bit_cast(bf16x8, o); }
        f32x16 s[5];
#pragma unroll
        for (int tt = 0; tt < 5; ++tt) {
            s[tt] = (f32x16){0.f, 0.f, 0.f, 0.f, 0.f, 0.f, 0.f, 0.f, 0.f, 0.f, 0.f, 0.f, 0.f, 0.f, 0.f, 0.f};
            const LAS bf16* kp = Ks + (32 * (qblk + tt) + q) * 72 + 8 * hi;
#pragma unroll
            for (int ks = 0; ks < 4; ++ks) { const bf16x8 a = *(const LAS bf16x8*)(kp + 16 * ks); s[tt] = __builtin_amdgcn_mfma_f32_32x32x16_bf16(a, qf[ks], s[tt], 0, 0, 0); }
        }
        const float sk = sinks[h] * LOG2E;
        float mx = sk;
        const LAS float* bt = biasT + g * 128;
#pragma unroll
        for (int tt = 0; tt < 5; ++tt)
#pragma unroll
            for (int r = 0; r < 16; ++r) { const int dist = q + 128 - 32 * tt - crow(r, hi);
                const bool valid = (dist >= 0) && (dist < 128) && ((nb > 0) || (qblk + tt >= 4));
                float v = s[tt][r] + bt[dist & 127]; v = valid ? v : -INFINITY; s[tt][r] = v; mx = fmaxf(mx, v); }
        mx = fmaxf(mx, __shfl_xor(mx, 32));
        float l = 0.f;
#pragma unroll
        for (int tt = 0; tt < 5; ++tt)
#pragma unroll
            for (int r = 0; r < 16; ++r) { const float p = __builtin_amdgcn_exp2f(s[tt][r] - mx); s[tt][r] = p; l += p; }
        l += __shfl_xor(l, 32); l += __builtin_amdgcn_exp2f(sk - mx);
        f32x16 o[2];
        o[0] = (f32x16){0.f, 0.f, 0.f, 0.f, 0.f, 0.f, 0.f, 0.f, 0.f, 0.f, 0.f, 0.f, 0.f, 0.f, 0.f, 0.f}; o[1] = o[0];
#pragma unroll
        for (int tt = 0; tt < 5; ++tt)
#pragma unroll
            for (int s2 = 0; s2 < 2; ++s2) {
                v4u pw; pw.x = pk2(s[tt][8 * s2 + 0], s[tt][8 * s2 + 1]); pw.y = pk2(s[tt][8 * s2 + 2], s[tt][8 * s2 + 3]); pw.z = pk2(s[tt][8 * s2 + 4], s[tt][8 * s2 + 5]); pw.w = pk2(s[tt][8 * s2 + 6], s[tt][8 * s2 + 7]);
                const bf16x8 pa = __builtin_bit_cast(bf16x8, pw);
#pragma unroll
                for (int dt = 0; dt < 2; ++dt) { const LAS bf16* vp = Vt + (32 * dt + q) * 264 + 32 * (qblk + tt) + 16 * s2 + 4 * hi;
                    const s16x4 lo = *(const LAS s16x4*)vp, hh = *(const LAS s16x4*)(vp + 8);
                    const bf16x8 vb = (bf16x8){lo[0], lo[1], lo[2], lo[3], hh[0], hh[1], hh[2], hh[3]};
                    o[dt] = __builtin_amdgcn_mfma_f32_32x32x16_bf16(pa, vb, o[dt], 0, 0, 0); }
            }
        if (hi == 0) lscr[q] = 1.0f / l;
        LDS_WAIT();
        bf16* orow = A2 + (size_t)(tok0 + q0) * 2048 + h * 64 + q;
#pragma unroll
        for (int r = 0; r < 16; ++r) { const int cr = crow(r, hi); const float li = lscr[cr];
            orow[(size_t)cr * 2048] = (bf16)f2bf(o[0][r] * li); orow[(size_t)cr * 2048 + 32] = (bf16)f2bf(o[1][r] * li); }
        LDS_WAIT();
    }
}
__device__ __forceinline__ void conv_unit(int unit, const bf16* U, bf16* A2, const float* cw, const float* cb, const float* lg, const float* lb, LAS unsigned char* lds, int tid, int lane, int wave) {
    const int b = unit >> 6, t0 = (unit & 63) * 32;
    LAS unsigned* Us = (LAS unsigned*)lds;
    LAS float* red = (LAS float*)(lds + 126976);
    const __amdgpu_buffer_rsrc_t ursrc = __builtin_amdgcn_make_buffer_rsrc((void*)(U + (size_t)b * SEQ * 1024), 0, SEQ * 1024 * 2, 0x00020000);
    {   const int rr0 = tid >> 7, cc = tid & 127;
#pragma unroll 4
        for (int i = 0; i < 16; ++i) { const int rr = rr0 + 4 * i, t = t0 - 30 + rr;
            if (rr < 62) { const unsigned voff = t >= 0 ? (unsigned)(t * 2048 + cc * 16) : 0xfffffff0u;
                const v4u w = __builtin_amdgcn_raw_buffer_load_b128(ursrc, voff, 0, 0);
                *(LAS v4u*)(Us + rr * 512 + cc * 4) = w; } } }
    const __amdgpu_buffer_rsrc_t wrsrc = __builtin_amdgcn_make_buffer_rsrc((void*)cw, 0, 31 * 1024 * 4, 0x00020000);
    float w0[31], w1[31];
#pragma unroll
    for (int j = 0; j < 31; ++j) { const v2u ww = __builtin_amdgcn_raw_buffer_load_b64(wrsrc, tid * 8, j * 4096, 0); w0[j] = __uint_as_float(ww.x); w1[j] = __uint_as_float(ww.y); }
    const f32x2 bb = *(const f32x2*)(cb + 2 * tid), gg = *(const f32x2*)(lg + 2 * tid), be = *(const f32x2*)(lb + 2 * tid);
    __syncthreads();
#pragma unroll 1
    for (int cq = 0; cq < 4; ++cq) {
        float a0[8], a1[8];
#pragma unroll
        for (int i = 0; i < 8; ++i) { a0[i] = bb.x; a1[i] = bb.y; }
        const LAS unsigned* up = Us + (8 * cq) * 512 + tid;
        unsigned un0 = up[0], un1 = up[512];
#pragma unroll
        for (int r = 0; r < 38; ++r) { const unsigned uu = un0; un0 = un1; if (r + 2 < 38) un1 = up[(r + 2) * 512];
            const float u0 = bflo(uu), u1 = bfhi(uu);
#pragma unroll
            for (int i = 0; i < 8; ++i) { const int j = r - i; if (j >= 0 && j <= 30) { a0[i] += u0 * w0[j]; a1[i] += u1 * w1[j]; } }
            __builtin_amdgcn_sched_barrier(0); }
#pragma unroll
        for (int i = 0; i < 8; ++i) { const float s1 = wave_sum(a0[i] + a1[i]), s2 = wave_sum(a0[i] * a0[i] + a1[i] * a1[i]);
            if (lane == 0) { red[((cq * 8 + wave) * 8 + i) * 2] = s1; red[((cq * 8 + wave) * 8 + i) * 2 + 1] = s2; } }
        __syncthreads();
#pragma unroll
        for (int i = 0; i < 8; ++i) { float t1 = 0.f, t2 = 0.f;
#pragma unroll
            for (int w = 0; w < 8; ++w) { t1 += red[((cq * 8 + w) * 8 + i) * 2]; t2 += red[((cq * 8 + w) * 8 + i) * 2 + 1]; }
            const float mean = t1 * (1.0f / 1024.0f), var = t2 * (1.0f / 1024.0f) - mean * mean, rstd = 1.0f / sqrtf(var + EPS);
            float y0 = (a0[i] - mean) * rstd * gg.x + be.x, y1 = (a1[i] - mean) * rstd * gg.y + be.y;
            y0 *= sigm(y0); y1 *= sigm(y1);
            *(GAS unsigned*)(A2 + (size_t)(b * SEQ + t0 + 8 * cq + i) * 2048 + 1024 + 2 * tid) = pk2(y0, y1); }
    }
}

struct Args { const float* in[20]; float* out; unsigned char* ws; int ph_lo, ph_hi; };
__global__ void __launch_bounds__(NWAVES * 64, 2) fwd_kernel(Args args) {
    extern __shared__ __attribute__((aligned(16))) unsigned char lds_raw[];
    LAS unsigned char* lds = (LAS unsigned char*)lds_raw;
    volatile LAS unsigned* MISC = (volatile LAS unsigned*)(lds + MISC_OFF);
    const int tid = threadIdx.x, lane = tid & 63, wave = __builtin_amdgcn_readfirstlane(tid >> 6);
    const int G = gridDim.x, bx = blockIdx.x;
    const int vcu = (G % 8 == 0) ? (bx % 8) * (G / 8) + bx / 8 : bx;
    const int gw = vcu * NWAVES + wave, NGW = G * NWAVES;
    unsigned char* ws = args.ws;
    const float* x = args.in[0]; const float* c_in = args.in[1]; const float* w_ada = args.in[2]; const float* b_ada = args.in[3]; const float* norm_mix_g = args.in[4];
    const float* w_in = args.in[5]; const float* q_norm_g = args.in[6]; const float* k_norm_g = args.in[7]; const float* attn_sinks = args.in[8]; const float* rel_bias = args.in[9];
    const float* w_attn_out = args.in[10]; const float* conv_w = args.in[11]; const float* conv_b = args.in[12]; const float* conv_ln_g = args.in[13]; const float* conv_ln_b = args.in[14];
    const float* w_conv_out = args.in[15]; const float* w_mix_out = args.in[16]; const float* norm_ffn_g = args.in[17]; const float* w_ffn_in = args.in[18]; const float* w_ffn_out = args.in[19];
    float* out = args.out;
    float* MOD = (float*)(ws + WS_MOD);
    bf16 *W1T = (bf16*)(ws + WS_W1T), *W2T = (bf16*)(ws + WS_W2T), *W3T = (bf16*)(ws + WS_W3T), *W4T = (bf16*)(ws + WS_W4T), *W5T = (bf16*)(ws + WS_W5T);
    bf16 *H = (bf16*)(ws + WS_H), *Qb = (bf16*)(ws + WS_Q), *Kb = (bf16*)(ws + WS_K), *Vb = (bf16*)(ws + WS_V), *Ub = (bf16*)(ws + WS_U), *Rb = (bf16*)(ws + WS_R), *GCb = (bf16*)(ws + WS_GC);
    bf16 *A2 = (bf16*)(ws + WS_A2), *MG = (bf16*)(ws + WS_MG), *HF = (bf16*)(ws + WS_HF);

    for (int u = tid; u < (LDS_BYTES - LDSCTL_OFF) / 4; u += NWAVES * 64) ((LAS unsigned*)(lds + LDSCTL_OFF))[u] = 0u;
    __syncthreads();
    const int lo = args.ph_lo, hi = args.ph_hi;
#if !MK_CG_SYNC
    XcdBarrier bar; bar.bar = (unsigned*)(ws + WS_CTL) + CW_BAR; bar.x = 0; bar.st = nullptr;
    if (hi - lo > 1) bar = xcd_barrier_post((unsigned*)(ws + WS_CTL) + CW_BAR, MISC + 8);
#else
    (void)MISC;
#endif
#ifdef PHASE_MASK
#define IN(k) (((PHASE_MASK >> (k)) & 1) && lo <= (k) && (k) < hi)
#else
#define IN(k) (lo <= (k) && (k) < hi)
#endif
#define BOTH(k) (IN(k) && IN((k) + 1))
#if MK_CG_SYNC
#define GRID_BAR(k) do { if (BOTH(k)) cg::this_grid().sync(); } while (0)
#else
#define GRID_BAR(k) do { if (BOTH(k)) { if ((k) == 0) cg::this_grid().sync(); else xcd_barrier(bar); } } while (0)
#endif

    if (IN(0)) {
        p0_adaln(c_in, w_ada, b_ada, MOD, (LAS float*)lds, tid, lane, wave);
        LAS float* scr = (LAS float*)(lds + wave * 16384);
        constexpr int I0 = 32 * 240, I1 = 16 * 64, I2 = 16 * 64, I3 = 32 * 64, I4 = 32 * 352, I5 = 88 * 64, NITEMS = I0 + I1 + I2 + I3 + I4 + I5;
        for (int it = gw; it < NITEMS; it += NGW) {
            int r = it;
            if (r < I0) { transpose_item(w_in, N1, W1T, 2048, 0, 1, scr, r, lane); continue; } r -= I0;
            if (r < I1) { transpose_item(w_attn_out, DM, W2T, 2048, 0, 0, scr, r, lane); continue; } r -= I1;
            if (r < I2) { transpose_item(w_conv_out, DM, W2T, 2048, 1024, 0, scr, r, lane); continue; } r -= I2;
            if (r < I3) { transpose_item(w_mix_out, DM, W3T, 2048, 0, 0, scr, r, lane); continue; } r -= I3;
            if (r < I4) { transpose_item(w_ffn_in, N4, W4T, 2048, 0, 2, scr, r, lane); continue; } r -= I4;
            transpose_item(w_ffn_out, DM, W5T, DFF, 0, 0, scr, r, lane);
        }
        GRID_BAR(0);
    }
    if (IN(1)) { modnorm_phase(x, norm_mix_g, MOD, 0, DM, H, gw, NGW, lane); GRID_BAR(1); }
    if (IN(2)) {
        pg8::Gemm g{H, W1T, MT, N1, DM}; pg8::StaticOrder S; S.init(MT, N1, G, bx);
        pg8::Epi1 E{Qb, Ub, Rb, GCb};
        pg8::gemm_phase<pg8::Epi1, pg8::StaticOrder, true, true>(lds, g, S, E);
        GRID_BAR(2);
    }
    if (IN(3)) {
#ifndef NO_ATTN
        for (int u = bx; u < 256; u += G) { attn_unit(u, Qb, Kb, Vb, A2, q_norm_g, k_norm_g, attn_sinks, rel_bias, lds, tid, lane, wave); __syncthreads(); }
#endif
#ifndef NO_CONV
        for (int u = bx; u < 256; u += G) { conv_unit(u, Ub, A2, conv_w, conv_b, conv_ln_g, conv_ln_b, lds, tid, lane, wave); __syncthreads(); }
#endif
        GRID_BAR(3);
    }
    if (IN(4)) {
        pg8::Gemm g{A2, W2T, MT, DM, DM}; pg8::StaticOrder S; S.init(MT, DM, G, bx);
        pg8::Epi2 E{Rb, GCb, MG};
        pg8::gemm_phase<pg8::Epi2, pg8::StaticOrder, true, true>(lds, g, S, E);
        GRID_BAR(4);
    }
    if (IN(5)) {
        pg8::Gemm g{MG, W3T, MT, DM, DM}; pg8::StaticOrder S; S.init(MT, DM, G, bx);
        pg8::EpiRes E{x, out, MOD + 2 * DM};
        pg8::gemm_phase<pg8::EpiRes, pg8::StaticOrder, true, true>(lds, g, S, E);
        GRID_BAR(5);
    }
    if (IN(6)) { modnorm_phase(out, norm_ffn_g, MOD, 3 * DM, 4 * DM, H, gw, NGW, lane); GRID_BAR(6); }
    if (IN(7)) {
        pg8::Gemm g{H, W4T, MT, N4, DM}; pg8::StaticOrder S; S.init(MT, N4, G, bx);
        pg8::Epi4 E{HF};
        pg8::gemm_phase<pg8::Epi4, pg8::StaticOrder, true, true>(lds, g, S, E);
        GRID_BAR(7);
    }
    if (IN(8)) {
        pg8::Gemm g{HF, W5T, MT, DM, DFF}; pg8::StaticOrder S; S.init(MT, DM, G, bx);
        pg8::EpiRes E{out, out, MOD + 5 * DM};
        pg8::gemm_phase<pg8::EpiRes, pg8::StaticOrder, true, true>(lds, g, S, E);
    }
#undef IN
#undef BOTH
#undef GRID_BAR
}

extern "C" void kernel_launch(void* const* d_in, const int* in_sizes, int n_in, void* d_out, int out_size, void* d_ws, size_t ws_size, hipStream_t stream) {
    static int grid = 0;
    if (grid == 0) {
        if (n_in != 20 || in_sizes[0] != MT * DM || out_size != MT * DM || ws_size < WS_END) {
            fprintf(stderr, "kernel_launch: shape/workspace mismatch (n_in %d, in0 %d, out %d, ws %zu, need %zu); nothing launched\n", n_in, n_in > 0 ? in_sizes[0] : -1, out_size, ws_size, (size_t)WS_END); grid = -1; return; }
        int dev = 0, cus = 0, per_cu = 0;
        if (hipGetDevice(&dev) != hipSuccess || hipDeviceGetAttribute(&cus, hipDeviceAttributeMultiprocessorCount, dev) != hipSuccess) { fprintf(stderr, "kernel_launch: device query failed\n"); grid = -1; return; }
        if (hipFuncSetAttribute((const void*)fwd_kernel, hipFuncAttributeMaxDynamicSharedMemorySize, LDS_BYTES) != hipSuccess) { fprintf(stderr, "kernel_launch: hipFuncSetAttribute failed\n"); grid = -1; return; }
        if (hipOccupancyMaxActiveBlocksPerMultiprocessor(&per_cu, (const void*)fwd_kernel, NWAVES * 64, LDS_BYTES) != hipSuccess || per_cu < 1) { fprintf(stderr, "kernel_launch: occupancy query says %d blocks per CU\n", per_cu); per_cu = 1; }
        (void)hipGetLastError();
        grid = cus * (per_cu < 1 ? 1 : 1);
        if (grid != 256) fprintf(stderr, "kernel_launch: note: grid = %d workgroups\n", grid);
    }
    if (grid < 0) return;
    if (hipMemsetAsync((char*)d_ws + WS_CTL, 0, CTL_ZERO_BYTES, stream) != hipSuccess) { fprintf(stderr, "kernel_launch: memset failed\n"); return; }
    Args a{};
    for (int i = 0; i < 20; ++i) a.in[i] = (const float*)d_in[i];
    a.out = (float*)d_out; a.ws = (unsigned char*)d_ws;
#if MK_PER_PHASE
    for (int ph = 0; ph < N_PHASES; ++ph) { a.ph_lo = ph; a.ph_hi = ph + 1; hipLaunchKernelGGL(fwd_kernel, dim3(grid), dim3(NWAVES * 64), LDS_BYTES, stream, a); }
#else
    a.ph_lo = 0; a.ph_hi = N_PHASES;
    void* kargs[] = {(void*)&a};
    const hipError_t e = hipLaunchCooperativeKernel((const void*)fwd_kernel, dim3(grid), dim3(NWAVES * 64), kargs, LDS_BYTES, stream);
    if (e != hipSuccess) fprintf(stderr, "kernel_launch: cooperative launch failed: %s (grid %d)\n", hipGetErrorString(e), grid);
#endif
}
```

```cpp
#include <hip/hip_runtime.h>
#include <hip/hip_cooperative_groups.h>
#include <cstdio>
#include <cstdint>
namespace cg = cooperative_groups;

#ifndef MK_PER_PHASE
#define MK_PER_PHASE 0
#endif
#ifndef MK_CG_SYNC
#define MK_CG_SYNC 0
#endif

namespace pg8 {
#define PG8_LAS __attribute__((address_space(3)))
typedef unsigned short bf16_t;
typedef short bf16x8 __attribute__((ext_vector_type(8)));
typedef float f32x4 __attribute__((ext_vector_type(4)));
typedef unsigned u32x4 __attribute__((ext_vector_type(4)));
constexpr int BM = 256, BK = 64, HALF = 128, HTB = HALF * BK * 2  , STAGE_BYTES = 8 * HTB, NXCD = 8, WGM = 8;

__host__ __device__ __forceinline__ int lds_byte(int r, int c) { const int st = (r >> 4) * 2 + (c >> 5), rr = r & 15, cc = c & 31, ob = rr * 64 + cc * 2; return st * 1024 + (ob ^ (((ob >> 9) & 1) << 5)); }
__host__ __device__ __forceinline__ void stage_rc(int b, int& R, int& C) { const int st = b / 1024, sb = b % 1024, swz = sb ^ (((sb >> 9) & 1) << 5); R = (st >> 1) * 16 + swz / 64; C = (st & 1) * 32 + (swz % 64) / 2; }
__host__ __device__ __forceinline__ int perm32(int rho) { const int n = rho >> 4, i = rho & 15; return 8 * (i >> 2) + 4 * n + (i & 3); }

struct Unit { int pm, pn; };
struct Gemm { const bf16_t* A; const bf16_t* Bt; int M, N, K; };

struct StaticOrder {
    int nM, nN, nwg, G, c;
    __host__ __device__ void init(int M, int N, int G_, int c_) { nM = M / BM; nN = N / BM; nwg = nM * nN; G = G_; c = c_; }
    __host__ __device__ bool next(int i, Unit& u) const {
        const long L = (long)i * G + c; if (L >= nwg) return false;
        int wgid = (int)L; { const int q = nwg / NXCD, r = nwg % NXCD, xcd = wgid % NXCD, off = wgid / NXCD; wgid = (xcd < r ? xcd * (q + 1) : r * (q + 1) + (xcd - r) * q) + off; }
        const int nig = WGM * nN, gid = wgid / nig, fm = gid * WGM, gsz = (nM - fm) < WGM ? (nM - fm) : WGM;
        u.pm = fm + ((wgid % nig) % gsz); u.pn = (wgid % nig) / gsz; return true;
    }
    __device__ __forceinline__ void a_ready(const Unit&) const {}
    __device__ __forceinline__ void done(const Unit&) const {}
};


__device__ __forceinline__ unsigned cvt_pk_bf16(float lo, float hi) { unsigned r; asm volatile("v_cvt_pk_bf16_f32 %0, %1, %2" : "=v"(r) : "v"(lo), "v"(hi)); return r; }
__device__ __forceinline__ float sigm(float x) { return __builtin_amdgcn_rcpf(1.0f + __builtin_amdgcn_exp2f(-1.4426950408889634f * x)); }
__device__ __forceinline__ u32x4 pack8(const f32x4& v0, const f32x4& v1) { u32x4 w; w.x = cvt_pk_bf16(v0[0], v0[1]); w.y = cvt_pk_bf16(v0[2], v0[3]); w.z = cvt_pk_bf16(v1[0], v1[1]); w.w = cvt_pk_bf16(v1[2], v1[3]); return w; }
__device__ __forceinline__ void unpack8(const u32x4& w, f32x4& v0, f32x4& v1) {
    v0[0] = __uint_as_float(w.x << 16); v0[1] = __uint_as_float(w.x & 0xffff0000u); v0[2] = __uint_as_float(w.y << 16); v0[3] = __uint_as_float(w.y & 0xffff0000u);
    v1[0] = __uint_as_float(w.z << 16); v1[1] = __uint_as_float(w.z & 0xffff0000u); v1[2] = __uint_as_float(w.w << 16); v1[3] = __uint_as_float(w.w & 0xffff0000u); }

struct Epi1 {
    static constexpr bool PERM = true, AFTER_DRAIN = false, MID = false;
    bf16_t *Q, *U, *R, *GC;
    __device__ __forceinline__ void mid(f32x4 (&)[2][2][4][2], const Unit&, int, int, int, int) const {}
    __device__ __forceinline__ void operator()(const f32x4 (&acc)[2][2][4][2], const Unit& u, int wr, int wc, int fr, int fq) const {
        const int row0 = u.pm * BM + wr * 64 + fr, cl = wc * 32 + 8 * fq;
        if (u.pn < 6) {
            const size_t boff = u.pn < 4 ? (size_t)0 : (u.pn == 4 ? (size_t)8388608 : (size_t)10485760);
            bf16_t* base = Q + boff; const int ld = u.pn < 4 ? 1024 : 256, c0 = u.pn < 4 ? u.pn * 256 : 0;
#pragma unroll
            for (int ai = 0; ai < 2; ++ai)
#pragma unroll
                for (int m = 0; m < 4; ++m) { bf16_t* rowp = base + (size_t)(row0 + ai * HALF + m * 16) * ld + c0 + cl;
#pragma unroll
                    for (int bj = 0; bj < 2; ++bj) *(u32x4*)(rowp + bj * HALF) = pack8(acc[ai][bj][m][0], acc[ai][bj][m][1]); }
        } else if (u.pn < 14) {
            const int c0 = (u.pn - 6) * 128 + cl;
#pragma unroll
            for (int ai = 0; ai < 2; ++ai)
#pragma unroll
                for (int m = 0; m < 4; ++m) { f32x4 o[2];
#pragma unroll
                    for (int n = 0; n < 2; ++n)
#pragma unroll
                        for (int e = 0; e < 4; ++e) o[n][e] = acc[ai][0][m][n][e] * sigm(acc[ai][1][m][n][e]);
                    *(u32x4*)(U + (size_t)(row0 + ai * HALF + m * 16) * 1024 + c0) = pack8(o[0], o[1]); }
        } else {
            const int c0 = (u.pn - 14) * 128 + cl;
#pragma unroll
            for (int ai = 0; ai < 2; ++ai)
#pragma unroll
                for (int m = 0; m < 4; ++m) { f32x4 r[2], g[2];
#pragma unroll
                    for (int n = 0; n < 2; ++n)
#pragma unroll
                        for (int e = 0; e < 4; ++e) { const float ea = __builtin_amdgcn_exp2f(-1.4426950408889634f * acc[ai][0][m][n][e]), ec = __builtin_amdgcn_exp2f(-1.4426950408889634f * acc[ai][1][m][n][e]);
                            g[n][e] = __builtin_amdgcn_rcpf(1.0f + ec); r[n][e] = (1.0f + ec) * __builtin_amdgcn_rcpf(1.0f + ea); }
                    const size_t off = (size_t)(row0 + ai * HALF + m * 16) * 2048 + c0;
                    *(u32x4*)(R + off) = pack8(r[0], r[1]); *(u32x4*)(GC + off) = pack8(g[0], g[1]); }
        }
    }
};
struct Epi2 {
    static constexpr bool PERM = true, AFTER_DRAIN = false, MID = true;
    const bf16_t *R, *GC; bf16_t* O;
    __device__ __forceinline__ void mid(f32x4 (&acc)[2][2][4][2], const Unit& u, int wr, int wc, int fr, int fq) const {
        asm volatile("" : "+v"(fr), "+v"(fq));
        const int row0 = u.pm * BM + wr * 64 + fr, col0 = u.pn * BM + wc * 32 + 8 * fq;
#pragma unroll
        for (int ai = 0; ai < 2; ++ai)
#pragma unroll
            for (int m = 0; m < 4; ++m) { const bf16_t* rowp = R + (size_t)(row0 + ai * HALF + m * 16) * 2048 + col0;
#pragma unroll
                for (int bj = 0; bj < 2; ++bj) { const u32x4 w = *(const u32x4*)(rowp + bj * HALF); f32x4 s0, s1; unpack8(w, s0, s1); acc[ai][bj][m][0] *= s0; acc[ai][bj][m][1] *= s1; }
                if (m & 1) asm volatile("" ::: "memory"); }
    }
    __device__ __forceinline__ void operator()(const f32x4 (&acc)[2][2][4][2], const Unit& u, int wr, int wc, int fr, int fq) const {
        const int row0 = u.pm * BM + wr * 64 + fr, col0 = u.pn * BM + wc * 32 + 8 * fq;
#pragma unroll
        for (int ai = 0; ai < 2; ++ai)
#pragma unroll
            for (int m = 0; m < 4; ++m) { const size_t off = (size_t)(row0 + ai * HALF + m * 16) * 2048 + col0;
#pragma unroll
                for (int bj = 0; bj < 2; ++bj) { const u32x4 w = *(const u32x4*)(GC + off + bj * HALF); f32x4 s0, s1; unpack8(w, s0, s1);
                    *(u32x4*)(O + off + bj * HALF) = pack8(acc[ai][bj][m][0] * s0, acc[ai][bj][m][1] * s1); }
                if (m & 1) asm volatile("" ::: "memory"); }
    }
};
struct EpiRes {
    static constexpr bool PERM = false, AFTER_DRAIN = false, MID = false;
    const float* base; float* out; const float* gate;
    __device__ __forceinline__ void mid(f32x4 (&)[2][2][4][2], const Unit&, int, int, int, int) const {}
    __device__ __forceinline__ void operator()(const f32x4 (&acc)[2][2][4][2], const Unit& u, int wr, int wc, int fr, int fq) const {
        const int row0 = u.pm * BM + wr * 64 + fr, col0 = u.pn * BM + wc * 32 + 4 * fq;
        const float* gp = gate + (size_t)(u.pm >> 3) * 12288 + col0;
        f32x4 gv[2][2];
#pragma unroll
        for (int bj = 0; bj < 2; ++bj)
#pragma unroll
            for (int n = 0; n < 2; ++n) gv[bj][n] = *(const f32x4*)(gp + bj * HALF + n * 16);
#pragma unroll
        for (int ai = 0; ai < 2; ++ai)
#pragma unroll
            for (int m = 0; m < 4; ++m) { const size_t off = (size_t)(row0 + ai * HALF + m * 16) * 2048 + col0;
#pragma unroll
                for (int bj = 0; bj < 2; ++bj)
#pragma unroll
                    for (int n = 0; n < 2; ++n) { const f32x4 b = *(const f32x4*)(base + off + bj * HALF + n * 16); *(f32x4*)(out + off + bj * HALF + n * 16) = b + gv[bj][n] * acc[ai][bj][m][n]; } }
    }
};
struct Epi4 {
    static constexpr bool PERM = true, AFTER_DRAIN = false, MID = false;
    bf16_t* HF;
    __device__ __forceinline__ void mid(f32x4 (&)[2][2][4][2], const Unit&, int, int, int, int) const {}
    __device__ __forceinline__ void operator()(const f32x4 (&acc)[2][2][4][2], const Unit& u, int wr, int wc, int fr, int fq) const {
        const int row0 = u.pm * BM + wr * 64 + fr, c0 = u.pn * 128 + wc * 32 + 8 * fq;
#pragma unroll
        for (int ai = 0; ai < 2; ++ai)
#pragma unroll
            for (int m = 0; m < 4; ++m) { f32x4 o[2];
#pragma unroll
                for (int n = 0; n < 2; ++n)
#pragma unroll
                    for (int e = 0; e < 4; ++e) { const float g = acc[ai][0][m][n][e]; o[n][e] = g * sigm(g) * acc[ai][1][m][n][e]; }
                *(u32x4*)(HF + (size_t)(row0 + ai * HALF + m * 16) * 5632 + c0) = pack8(o[0], o[1]); }
    }
};

template <class Epi, class Sched, bool ALIGN_EPI = false, bool SP2 = false>
__device__ __forceinline__ void gemm_phase(PG8_LAS unsigned char* lds, const Gemm g, const Sched& S, const Epi& E) {
    const int tid = threadIdx.x, wid = __builtin_amdgcn_readfirstlane(tid >> 6), lane = tid & 63, wr = wid >> 2, wc = wid & 3, fr = lane & 15, fq = lane >> 4;
    const int K = g.K, nt = K / BK;
    unsigned voffA[2], voffB[2];
#pragma unroll
    for (int i = 0; i < 2; ++i) { int R, C; stage_rc(tid * 16 + i * 8192, R, C); const int Rb = Epi::PERM ? ((R & ~31) + perm32(R & 31)) : R;
        voffA[i] = (unsigned)(R * K + C) * 2u; voffB[i] = (unsigned)(Rb * K + C) * 2u; }
    const size_t kstep = (size_t)(BK * 2);
    const size_t hstep = (size_t)HALF * K * 2;
    const size_t tstep = 2 * hstep;
    const unsigned ldsw = (unsigned)wid * 1024u;
    const int aoff = lds_byte(wr * 64 + fr, fq * 8), boff = lds_byte(wc * 32 + fr, fq * 8);
#define PG8_SA(b, h) (((b) * 2 + (h)) * HTB)
#define PG8_SB(b, h) ((4 + (b) * 2 + (h)) * HTB)
#define PG8_STAGE(bufoff, gbase, voff) do { _Pragma("unroll") for (int _i = 0; _i < 2; ++_i) \
        __builtin_amdgcn_global_load_lds((const unsigned*)((const char*)(gbase) + (voff)[_i]), (PG8_LAS unsigned*)(lds + (bufoff) + ldsw + _i * 8192), 16, 0, 0); } while (0)
#define PG8_LDA(dst, b, h) do { _Pragma("unroll") for (int m = 0; m < 4; ++m) _Pragma("unroll") for (int k = 0; k < 2; ++k) dst[m][k] = *(const PG8_LAS bf16x8*)(lds + PG8_SA(b, h) + aoff + m * 2048 + k * 1024); } while (0)
#define PG8_LDB(dst, b, h) do { _Pragma("unroll") for (int n = 0; n < 2; ++n) _Pragma("unroll") for (int k = 0; k < 2; ++k) dst[n][k] = *(const PG8_LAS bf16x8*)(lds + PG8_SB(b, h) + boff + n * 2048 + k * 1024); } while (0)
#define PG8_MMA(ai, bj, At, Bt) do { __builtin_amdgcn_s_setprio(1); _Pragma("unroll") for (int m = 0; m < 4; ++m) _Pragma("unroll") for (int n = 0; n < 2; ++n) _Pragma("unroll") for (int k = 0; k < 2; ++k) \
        acc[ai][bj][m][n] = __builtin_amdgcn_mfma_f32_16x16x32_bf16(Bt[n][k], At[m][k], acc[ai][bj][m][n], 0, 0, 0); __builtin_amdgcn_s_setprio(0); } while (0)
#define PG8_WAIT_V(n) asm volatile("s_waitcnt vmcnt(" #n ")" ::: "memory")
#define PG8_WAIT_L(n) asm volatile("s_waitcnt lgkmcnt(" #n ")" ::: "memory")
#define PG8_BAR __builtin_amdgcn_s_barrier()
#define PG8_SCHED __builtin_amdgcn_sched_barrier(0)
    Unit cur, nxt; int ui = 0;
    if (!S.next(0, cur)) return;
    f32x4 acc[2][2][4][2];
#pragma unroll
    for (int a = 0; a < 2; ++a)
#pragma unroll
        for (int b = 0; b < 2; ++b)
#pragma unroll
            for (int m = 0; m < 4; ++m)
#pragma unroll
                for (int n = 0; n < 2; ++n) acc[a][b][m][n] = (f32x4){0.f, 0.f, 0.f, 0.f};
    bf16x8 At[4][2], B0[2][2], B1[2][2];
    const char* cA = (const char*)g.A + (size_t)cur.pm * tstep; const char* cB = (const char*)g.Bt + (size_t)cur.pn * tstep;
    S.a_ready(cur);
    if constexpr (SP2) {
        PG8_STAGE(PG8_SB(0, 0), cB, voffB); PG8_STAGE(PG8_SB(0, 1), cB + hstep, voffB); PG8_STAGE(PG8_SA(0, 0), cA, voffA); PG8_STAGE(PG8_SA(0, 1), cA + hstep, voffA);
        if (wr == 1) PG8_BAR;
        PG8_WAIT_V(2); PG8_BAR;
        PG8_STAGE(PG8_SB(1, 0), cB + kstep, voffB); PG8_STAGE(PG8_SA(1, 0), cA + kstep, voffA); PG8_STAGE(PG8_SB(1, 1), cB + hstep + kstep, voffB);
        PG8_WAIT_V(6); PG8_BAR;
    } else {
        PG8_STAGE(PG8_SB(0, 0), cB, voffB); PG8_STAGE(PG8_SA(0, 0), cA, voffA); PG8_STAGE(PG8_SB(0, 1), cB + hstep, voffB); PG8_STAGE(PG8_SA(0, 1), cA + hstep, voffA);
        if (wr == 1) PG8_BAR;
        PG8_WAIT_V(4); PG8_BAR;
        PG8_STAGE(PG8_SB(1, 0), cB + kstep, voffB); PG8_STAGE(PG8_SA(1, 0), cA + kstep, voffA); PG8_STAGE(PG8_SB(1, 1), cB + hstep + kstep, voffB);
        PG8_WAIT_V(6); PG8_BAR;
    }
    for (;;) {
        const bool has_next = S.next(ui + 1, nxt);
        const char* nA = has_next ? (const char*)g.A + (size_t)nxt.pm * tstep : cA; const char* nB = has_next ? (const char*)g.Bt + (size_t)nxt.pn * tstep : cB;
        for (int t = 0; t < nt; t += 2) {
            const bool last = (t == nt - 2);
            const char* a1 = cA + (size_t)(t + 1) * kstep;
            const char* a2 = last ? nA : cA + (size_t)(t + 2) * kstep; const char* b2 = last ? nB : cB + (size_t)(t + 2) * kstep;
            const char* a3 = a2 + kstep; const char* b3 = b2 + kstep;
            if (last && has_next) S.a_ready(nxt);
            if constexpr (Epi::MID) { if (t == (nt >> 1)) E.mid(acc, cur, wr, wc, fr, fq); }
            if constexpr (SP2) {
            PG8_LDB(B0, 0, 0); PG8_LDB(B1, 0, 1); PG8_SCHED; PG8_LDA(At, 0, 0); PG8_STAGE(PG8_SA(1, 1), a1 + hstep, voffA);
            PG8_WAIT_V(8); PG8_WAIT_L(0); PG8_BAR; PG8_MMA(0, 0, At, B0); PG8_MMA(0, 1, At, B1); PG8_BAR; PG8_SCHED;
            PG8_LDA(At, 0, 1); PG8_STAGE(PG8_SB(0, 0), b2, voffB); PG8_STAGE(PG8_SB(0, 1), b2 + hstep, voffB); PG8_STAGE(PG8_SA(0, 0), a2, voffA);
            PG8_WAIT_V(8); PG8_WAIT_L(0); PG8_BAR; PG8_MMA(1, 0, At, B0); PG8_MMA(1, 1, At, B1); PG8_BAR; PG8_SCHED;
            PG8_LDB(B0, 1, 0); PG8_LDB(B1, 1, 1); PG8_SCHED; PG8_LDA(At, 1, 0); PG8_STAGE(PG8_SA(0, 1), a2 + hstep, voffA);
            PG8_WAIT_V(8); PG8_WAIT_L(0); PG8_BAR; PG8_MMA(0, 0, At, B0); PG8_MMA(0, 1, At, B1); PG8_BAR; PG8_SCHED;
            PG8_LDA(At, 1, 1); PG8_STAGE(PG8_SB(1, 0), b3, voffB); PG8_STAGE(PG8_SB(1, 1), b3 + hstep, voffB); PG8_STAGE(PG8_SA(1, 0), a3, voffA);
            PG8_WAIT_V(8); PG8_WAIT_L(0); PG8_BAR; PG8_MMA(1, 0, At, B0); PG8_MMA(1, 1, At, B1); PG8_BAR; PG8_SCHED;
            } else {
            PG8_LDB(B0, 0, 0); PG8_SCHED; PG8_LDA(At, 0, 0); PG8_STAGE(PG8_SA(1, 1), a1 + hstep, voffA);
            PG8_WAIT_L(8); PG8_BAR; PG8_WAIT_L(0); PG8_MMA(0, 0, At, B0); PG8_BAR; PG8_SCHED;
            PG8_LDB(B1, 0, 1); PG8_STAGE(PG8_SB(0, 0), b2, voffB);
            PG8_BAR; PG8_WAIT_L(0); PG8_MMA(0, 1, At, B1); PG8_BAR;
            PG8_LDA(At, 0, 1); PG8_STAGE(PG8_SA(0, 0), a2, voffA);
            PG8_BAR; PG8_WAIT_L(0); PG8_MMA(1, 0, At, B0); PG8_BAR; PG8_SCHED;
            PG8_STAGE(PG8_SB(0, 1), b2 + hstep, voffB);
            PG8_WAIT_V(6); PG8_BAR; PG8_MMA(1, 1, At, B1); PG8_BAR;
            PG8_LDB(B0, 1, 0); PG8_SCHED; PG8_LDA(At, 1, 0); PG8_STAGE(PG8_SA(0, 1), a2 + hstep, voffA);
            PG8_WAIT_L(8); PG8_BAR; PG8_WAIT_L(0); PG8_MMA(0, 0, At, B0); PG8_BAR; PG8_SCHED;
            PG8_LDB(B1, 1, 1); PG8_STAGE(PG8_SB(1, 0), b3, voffB);
            PG8_BAR; PG8_WAIT_L(0); PG8_MMA(0, 1, At, B1); PG8_BAR;
            PG8_LDA(At, 1, 1); PG8_STAGE(PG8_SA(1, 0), a3, voffA);
            PG8_BAR; PG8_WAIT_L(0); PG8_MMA(1, 0, At, B0); PG8_BAR; PG8_SCHED;
            PG8_STAGE(PG8_SB(1, 1), b3 + hstep, voffB);
            PG8_WAIT_V(6); PG8_BAR; PG8_MMA(1, 1, At, B1); PG8_BAR;
            }
        }
        if constexpr (ALIGN_EPI) { if (wr == 0) PG8_BAR; }
        if constexpr (!Epi::AFTER_DRAIN) { E(acc, cur, wr, wc, fr, fq); S.done(cur); }
        if (!has_next) break;
#pragma unroll
        for (int a = 0; a < 2; ++a)
#pragma unroll
            for (int b = 0; b < 2; ++b)
#pragma unroll
                for (int m = 0; m < 4; ++m)
#pragma unroll
                    for (int n = 0; n < 2; ++n) acc[a][b][m][n] = (f32x4){0.f, 0.f, 0.f, 0.f};
        cur = nxt; cA = nA; cB = nB; ++ui;
        if constexpr (ALIGN_EPI) { if (wr == 1) PG8_BAR; }
    }
    PG8_WAIT_V(0);
    if constexpr (!ALIGN_EPI) { if (wr == 0) PG8_BAR; }
    PG8_BAR;
    if constexpr (Epi::AFTER_DRAIN) { E.fused(acc, cur, wr, wc, fr, fq, lds, wid, lane); S.done(cur); }
#undef PG8_SA
#undef PG8_SB
#undef PG8_STAGE
#undef PG8_LDA
#undef PG8_LDB
#undef PG8_MMA
#undef PG8_WAIT_V
#undef PG8_WAIT_L
#undef PG8_BAR
#undef PG8_SCHED
}
}


constexpr int NWAVES = 8;
constexpr int DM = 2048, BATCH = 4, SEQ = 2048, MT = BATCH * SEQ;
constexpr int NQ = 1024, NKVW = 256, CONVC = 1024, DFF = 5632, NMOD = 6 * DM;
constexpr int N1 = 7680, N4 = 2 * DFF;
constexpr float EPS = 1e-6f, LOG2E = 1.4426950408889634f;
constexpr int N_PHASES = 9;

constexpr size_t MiB = 1u << 20;
constexpr size_t WS_CTL = 0, WS_MOD = 65536, CTL_ZERO_BYTES = 262144;
constexpr size_t WS_W1T = 1 * MiB, WS_W2T = 31 * MiB, WS_W3T = 39 * MiB, WS_W4T = 47 * MiB, WS_W5T = 91 * MiB;
constexpr size_t WS_H = 113 * MiB;
constexpr size_t WS_Q = 145 * MiB, WS_K = 161 * MiB, WS_V = 165 * MiB, WS_U = 169 * MiB, WS_R = 185 * MiB, WS_GC = 217 * MiB;
constexpr size_t WS_A2 = 249 * MiB, WS_MG = 281 * MiB, WS_END = 313 * MiB;
constexpr size_t WS_HF = 145 * MiB;
static_assert(WS_HF + (size_t)MT * DFF * 2 <= WS_A2, "HF overlay");
static_assert(WS_K - WS_Q == 2 * (size_t)8388608 && WS_V - WS_Q == 2 * (size_t)10485760, "Epi1 reaches K and V from Q by fixed element offsets");
constexpr int CW_BAR = 1024;

constexpr int RING_BYTES = 131072, LDSCTL_OFF = RING_BYTES, MISC_OFF = LDSCTL_OFF + 320, LDS_BYTES = 147456;

#define GAS __attribute__((address_space(1)))
#define LAS __attribute__((address_space(3)))
typedef unsigned short bf16;
typedef unsigned v4u __attribute__((ext_vector_type(4)));
typedef unsigned v2u __attribute__((ext_vector_type(2)));
typedef float f32x4 __attribute__((ext_vector_type(4)));
typedef float f32x2 __attribute__((ext_vector_type(2)));
typedef float f32x16 __attribute__((ext_vector_type(16)));
typedef short bf16x8 __attribute__((ext_vector_type(8)));
typedef short s16x4 __attribute__((ext_vector_type(4)));
typedef GAS unsigned gu32;
#define RLX_AGENT __ATOMIC_RELAXED, __HIP_MEMORY_SCOPE_AGENT
#define LDS_WAIT() asm volatile("s_waitcnt lgkmcnt(0)" ::: "memory")
__device__ __forceinline__ unsigned f2bf(float f) { unsigned u = __builtin_bit_cast(unsigned, f); return (u + 0x7fffu + ((u >> 16) & 1u)) >> 16; }
__device__ __forceinline__ unsigned pk2(float lo, float hi) { return f2bf(lo) | (f2bf(hi) << 16); }
__device__ __forceinline__ float bflo(unsigned w) { return __uint_as_float(w << 16); }
__device__ __forceinline__ float bfhi(unsigned w) { return __uint_as_float(w & 0xffff0000u); }
__device__ __forceinline__ float sigm(float x) { return __builtin_amdgcn_rcpf(1.0f + __builtin_amdgcn_exp2f(-LOG2E * x)); }
__device__ __forceinline__ float wave_sum(float v) {
#pragma unroll
    for (int o = 1; o < 64; o <<= 1) v += __shfl_xor(v, o);
    return v;
}

#define XB_TMO      128
#define XB_XCNT(j)  (256  + 64 * (j))
#define XB_XSUB(j)  (1280 + 64 * (j))
#define XB_XGEN(j)  (2304 + 64 * (j))
#define XB_TOP      3328
#define XB_TOPGEN   3392
#define XCD_BAR_WORDS 3456
#define XB_SPIN_CAP (1u << 18)

__device__ __forceinline__ unsigned xb_ld(unsigned* p)              { return __hip_atomic_load(p, __ATOMIC_RELAXED, __HIP_MEMORY_SCOPE_AGENT); }
__device__ __forceinline__ unsigned xb_add(unsigned* p, unsigned v) { return __hip_atomic_fetch_add(p, v, __ATOMIC_RELAXED, __HIP_MEMORY_SCOPE_AGENT); }
__device__ __forceinline__ unsigned xb_xcc_id() { return (unsigned)__builtin_amdgcn_s_getreg((3 << 11) | 20) & 0xFu; }
#define XB_SPIN(cond, bar) do { unsigned _sp = 0; while (cond) { __builtin_amdgcn_s_sleep(1); \
    if ((++_sp & 255u) == 0u) { if (xb_ld(&(bar)[XB_TMO])) break; if (_sp > XB_SPIN_CAP) { atomicAdd(&(bar)[XB_TMO], 1u); break; } } } } while (0)

struct XcdBarrier {
    unsigned* bar; unsigned x;
    volatile LAS unsigned* st;
};

__device__ __forceinline__ XcdBarrier xcd_barrier_post(unsigned* bar, volatile LAS unsigned* st) {
    XcdBarrier b; b.bar = bar; b.x = xb_xcc_id(); b.st = st;
    if (threadIdx.x == 0) (void)xb_add(&bar[XB_XCNT(b.x)], 1u);
    return b;
}
__device__ __forceinline__ void xcd_barrier_complete(unsigned* bar, unsigned x, unsigned& nloc, unsigned& nx) {
    const unsigned G = gridDim.x * gridDim.y * gridDim.z;
    unsigned sum, cnt, mine, sp = 0u;
    for (;;) {
        sum = 0u; cnt = 0u; mine = 0u;
#pragma unroll
        for (unsigned j = 0; j < 16; ++j) { const unsigned c = xb_ld(&bar[XB_XCNT(j)]); sum += c; cnt += (c > 0u) ? 1u : 0u; mine = (j == x) ? c : mine; }
        if (sum == G) break;
        __builtin_amdgcn_s_sleep(1);
        if ((++sp & 255u) == 0u) { if (xb_ld(&bar[XB_TMO])) break; if (sp > XB_SPIN_CAP) { atomicAdd(&bar[XB_TMO], 1u); break; } }
    }
    nloc = mine > 0u ? mine : 1u; nx = cnt > 0u ? cnt : 1u;
}

__device__ __forceinline__ void xcd_barrier(const XcdBarrier& b) {
    asm volatile("s_waitcnt vmcnt(0)" ::: "memory");
    __syncthreads();
    if (threadIdx.x == 0) {
        unsigned* bar = b.bar;
        __builtin_amdgcn_s_waitcnt(0);
        unsigned nloc = b.st[0], nx = b.st[1];
        if (nloc == 0u) { xcd_barrier_complete(bar, b.x, nloc, nx); b.st[0] = nloc; b.st[1] = nx; }
        const unsigned old = xb_add(&bar[XB_XSUB(b.x)], 1u);
        const unsigned gen = old / nloc;
        if (old + 1u == (gen + 1u) * nloc) {
            __builtin_amdgcn_fence(__ATOMIC_RELEASE, "agent");
            asm volatile("s_waitcnt vmcnt(0)" ::: "memory");
            const unsigned og = xb_add(&bar[XB_TOP], 1u);
            const unsigned tg = og / nx;
            if (og + 1u == (tg + 1u) * nx) xb_add(&bar[XB_TOPGEN], 1u);
            else XB_SPIN(xb_ld(&bar[XB_TOPGEN]) == tg, bar);
            __builtin_amdgcn_fence(__ATOMIC_ACQUIRE, "agent");
            xb_add(&bar[XB_XGEN(b.x)], 1u);
            asm volatile("s_waitcnt vmcnt(0)" ::: "memory");
        } else {
            XB_SPIN(xb_ld(&bar[XB_XGEN(b.x)]) == gen, bar);
            __builtin_amdgcn_fence(__ATOMIC_ACQUIRE, "agent");
            asm volatile("s_waitcnt vmcnt(0)" ::: "memory");
        }
    }
    __syncthreads();
}

__device__ __forceinline__ void p0_adaln(const float* c, const float* w_ada, const float* b_ada, float* MOD, LAS float* red, int tid, int lane, int wave) {
    for (int it = blockIdx.x; it < 48 * 16; it += gridDim.x) {
        const int cgp = it % 48, kc = it / 48, k0 = kc * 128 + wave * 16, c0 = cgp * 256 + lane * 4;
        const float cv = c[(lane >> 4) * DM + k0 + (lane & 15)];
        const float sv = cv * sigm(cv);
        f32x4 acc[4];
#pragma unroll
        for (int b = 0; b < 4; ++b) acc[b] = (f32x4){0.f, 0.f, 0.f, 0.f};
#pragma unroll
        for (int r = 0; r < 16; ++r) { const f32x4 w4 = *(const f32x4*)(w_ada + (size_t)(k0 + r) * NMOD + c0);
#pragma unroll
            for (int b = 0; b < 4; ++b) { const float s = __shfl(sv, b * 16 + r); acc[b] += w4 * s; } }
#pragma unroll
        for (int b = 0; b < 4; ++b) *(LAS f32x4*)(red + ((wave * 4 + b) * 256 + lane * 4)) = acc[b];
        __syncthreads();
#pragma unroll
        for (int e = 0; e < 2; ++e) { const int o = tid * 2 + e, b = o >> 8, col = o & 255; float s = 0.f;
#pragma unroll
            for (int w = 0; w < 8; ++w) s += red[(w * 4 + b) * 256 + col];
            if (kc == 0) s += b_ada[cgp * 256 + col];
            atomicAdd(MOD + b * NMOD + cgp * 256 + col, s); }
        __syncthreads();
    }
}
__device__ __forceinline__ int maprow(int mapid, int n0) {
    if (mapid == 1) {
        if (n0 < 1536) return n0;
        if (n0 < 2560) { const int t = n0 - 1536; return 1536 + ((t >> 7) << 8) + (t & 127); }
        if (n0 < 3584) { const int t = n0 - 2560; return 1536 + ((t >> 7) << 8) + 128 + (t & 127); }
        if (n0 < 5632) { const int t = n0 - 3584; return 3584 + ((t >> 7) << 8) + (t & 127); }
        const int t = n0 - 5632; return 3584 + ((t >> 7) << 8) + 128 + (t & 127);
    }
    if (mapid == 2) {
        if (n0 < DFF) return ((n0 >> 7) << 8) + (n0 & 127);
        const int t = n0 - DFF; return ((t >> 7) << 8) + 128 + (t & 127);
    }
    return n0;
}
__device__ __forceinline__ void transpose_item(const float* W, int N, bf16* WT, int ldk, int koff, int mapid, LAS float* scr, int item, int lane) {
    const int nblk = N / 32, kb = item / nblk, nb = item % nblk, k0 = 64 * kb, n0 = 32 * nb;
#pragma unroll 8
    for (int i = 0; i < 32; ++i) { const int kk = 2 * i + (lane >> 5); scr[kk * 33 + (lane & 31)] = W[(size_t)(k0 + kk) * N + n0 + (lane & 31)]; }
    LDS_WAIT(); asm volatile("" ::: "memory");
    const int c = lane & 7, drow0 = maprow(mapid, n0);
#pragma unroll
    for (int j = 0; j < 4; ++j) { const int n = (lane >> 3) + 8 * j; const LAS float* s = scr + (8 * c) * 33 + n;
        v4u o; o.x = pk2(s[0 * 33], s[1 * 33]); o.y = pk2(s[2 * 33], s[3 * 33]); o.z = pk2(s[4 * 33], s[5 * 33]); o.w = pk2(s[6 * 33], s[7 * 33]);
        *(GAS v4u*)(WT + (size_t)(drow0 + n) * ldk + koff + k0 + 8 * c) = o; }
    LDS_WAIT(); asm volatile("" ::: "memory");
}
__device__ __forceinline__ void modnorm_phase(const float* X, const float* g, const float* MOD, int sh_off, int sc_off, bf16* H, int gw, int NGW, int lane) {
    for (int it = gw; it < MT / 4; it += NGW) {
        const int row0 = it * 4, b = row0 / SEQ;
        f32x4 A[8], Bv[8];
#pragma unroll
        for (int j = 0; j < 8; ++j) { const int col = 4 * (lane + 64 * j);
            const f32x4 gg = *(const f32x4*)(g + col), sc = *(const f32x4*)(MOD + (size_t)b * NMOD + sc_off + col);
            A[j] = gg * (1.0f + sc); Bv[j] = *(const f32x4*)(MOD + (size_t)b * NMOD + sh_off + col); }
        for (int r = 0; r < 4; ++r) {
            const float* xr = X + (size_t)(row0 + r) * DM;
            f32x4 v[8]; float ss = 0.f;
#pragma unroll
            for (int j = 0; j < 8; ++j) { v[j] = *(const f32x4*)(xr + 4 * (lane + 64 * j)); ss += (v[j].x * v[j].x + v[j].y * v[j].y) + (v[j].z * v[j].z + v[j].w * v[j].w); }
            const float rstd = 1.0f / sqrtf(wave_sum(ss) * (1.0f / DM) + EPS);
            bf16* hr = H + (size_t)(row0 + r) * DM;
#pragma unroll
            for (int j = 0; j < 8; ++j) { const f32x4 o = v[j] * rstd * A[j] + Bv[j]; v2u w; w.x = pk2(o.x, o.y); w.y = pk2(o.z, o.w); *(GAS v2u*)(hr + 4 * (lane + 64 * j)) = w; }
        }
    }
}
__device__ __forceinline__ int crow(int r, int hi) { return (r & 3) + 8 * (r >> 2) + 4 * hi; }
__device__ __forceinline__ void attn_unit(int unit, const bf16* Qb, const bf16* Kb, const bf16* Vb, bf16* A2, const float* qg, const float* kg, const float* sinks, const float* relb,
                                          LAS unsigned char* lds, int tid, int lane, int wave) {
    const int b = unit >> 6, kvh = (unit >> 4) & 3, nb = unit & 15;
    LAS bf16* Ks = (LAS bf16*)lds;
    LAS bf16* Vt = (LAS bf16*)(lds + 36864);
    LAS float* biasT = (LAS float*)(lds + 36864 + 33792);
    LAS float* lscr = biasT + 512 + wave * 32;
    const int tok0 = b * SEQ + nb * 128;
#pragma unroll
    for (int i = 0; i < 4; ++i) {
        const int c = tid + 512 * i, key = c >> 3, part = c & 7;
        const bool real = (nb > 0) || (key >= 128);
        const long tok = (long)tok0 - 128 + key;
        v4u kw = (v4u){0u, 0u, 0u, 0u}, vw = (v4u){0u, 0u, 0u, 0u};
        if (real) { kw = *(const v4u*)(Kb + tok * 256 + kvh * 64 + part * 8); vw = *(const v4u*)(Vb + tok * 256 + kvh * 64 + part * 8); }
        const f32x4 k0 = (f32x4){bflo(kw.x), bfhi(kw.x), bflo(kw.y), bfhi(kw.y)}, k1 = (f32x4){bflo(kw.z), bfhi(kw.z), bflo(kw.w), bfhi(kw.w)};
        float ss = (k0.x * k0.x + k0.y * k0.y) + (k0.z * k0.z + k0.w * k0.w) + (k1.x * k1.x + k1.y * k1.y) + (k1.z * k1.z + k1.w * k1.w);
        ss += __shfl_xor(ss, 1); ss += __shfl_xor(ss, 2); ss += __shfl_xor(ss, 4);
        const float rstd = 1.0f / sqrtf(ss * (1.0f / 64.0f) + EPS);
        const f32x4 g0 = *(const f32x4*)(kg + part * 8) * rstd, g1 = *(const f32x4*)(kg + part * 8 + 4) * rstd;
        v4u o; o.x = pk2(k0.x * g0.x, k0.y * g0.y); o.y = pk2(k0.z * g0.z, k0.w * g0.w); o.z = pk2(k1.x * g1.x, k1.y * g1.y); o.w = pk2(k1.z * g1.z, k1.w * g1.w);
        *(LAS v4u*)(Ks + key * 72 + part * 8) = o;
        LAS bf16* vt = Vt + (part * 8) * 264 + key;
        vt[0 * 264] = (bf16)(vw.x & 0xffffu); vt[1 * 264] = (bf16)(vw.x >> 16); vt[2 * 264] = (bf16)(vw.y & 0xffffu); vt[3 * 264] = (bf16)(vw.y >> 16);
        vt[4 * 264] = (bf16)(vw.z & 0xffffu); vt[5 * 264] = (bf16)(vw.z >> 16); vt[6 * 264] = (bf16)(vw.w & 0xffffu); vt[7 * 264] = (bf16)(vw.w >> 16);
    }
    { const int g = tid >> 7, dist = tid & 127; int bucket = dist;
      if (dist >= 16) { const int l = 16 + (int)(logf((float)dist * (1.0f / 16.0f)) / 2.0794415416798357f * 16.0f); bucket = l < 31 ? l : 31; }
      biasT[tid] = relb[bucket * 16 + kvh * 4 + g] * LOG2E; }
    __syncthreads();
    const int q = lane & 31, hi = lane >> 5;
    for (int pass = 0; pass < 2; ++pass) {
        const int pi = wave * 2 + pass, g = pi >> 2, qblk = pi & 3, h = kvh * 4 + g, q0 = qblk * 32;
        const bf16* qrow = Qb + (size_t)(tok0 + q0 + q) * 1024 + h * 64 + hi * 8;
        v4u qw[4]; float ss = 0.f;
#pragma unroll
        for (int ks = 0; ks < 4; ++ks) { qw[ks] = *(const v4u*)(qrow + 16 * ks);
            const float a0 = bflo(qw[ks].x), a1 = bfhi(qw[ks].x), a2 = bflo(qw[ks].y), a3 = bfhi(qw[ks].y), a4 = bflo(qw[ks].z), a5 = bfhi(qw[ks].z), a6 = bflo(qw[ks].w), a7 = bfhi(qw[ks].w);
            ss += (a0 * a0 + a1 * a1) + (a2 * a2 + a3 * a3) + (a4 * a4 + a5 * a5) + (a6 * a6 + a7 * a7); }
        ss += __shfl_xor(ss, 32);
        const float rs = (1.0f / sqrtf(ss * (1.0f / 64.0f) + EPS)) * (0.125f * LOG2E);
        bf16x8 qf[4];
#pragma unroll
        for (int ks = 0; ks < 4; ++ks) { const f32x4 g0 = *(const f32x4*)(qg + 16 * ks + 8 * hi) * rs, g1 = *(const f32x4*)(qg + 16 * ks + 8 * hi + 4) * rs;
            v4u o; o.x = pk2(bflo(qw[ks].x) * g0.x, bfhi(qw[ks].x) * g0.y); o.y = pk2(bflo(qw[ks].y) * g0.z, bfhi(qw[ks].y) * g0.w);
            o.z = pk2(bflo(qw[ks].z) * g1.x, bfhi(qw[ks].z) * g1.y); o.w = pk2(bflo(qw[ks].w) * g1.z, bfhi(qw[ks].w) * g1.w);
            qf[ks] = __builtin_bit_cast(bf16x8, o); }
        f32x16 s[5];
#pragma unroll
        for (int tt = 0; tt < 5; ++tt) {
            s[tt] = (f32x16){0.f, 0.f, 0.f, 0.f, 0.f, 0.f, 0.f, 0.f, 0.f, 0.f, 0.f, 0.f, 0.f, 0.f, 0.f, 0.f};
            const LAS bf16* kp = Ks + (32 * (qblk + tt) + q) * 72 + 8 * hi;
#pragma unroll
            for (int ks = 0; ks < 4; ++ks) { const bf16x8 a = *(const LAS bf16x8*)(kp + 16 * ks); s[tt] = __builtin_amdgcn_mfma_f32_32x32x16_bf16(a, qf[ks], s[tt], 0, 0, 0); }
        }
        const float sk = sinks[h] * LOG2E;
        float mx = sk;
        const LAS float* bt = biasT + g * 128;
#pragma unroll
        for (int tt = 0; tt < 5; ++tt)
#pragma unroll
            for (int r = 0; r < 16; ++r) { const int dist = q + 128 - 32 * tt - crow(r, hi);
                const bool valid = (dist >= 0) && (dist < 128) && ((nb > 0) || (qblk + tt >= 4));
                float v = s[tt][r] + bt[dist & 127]; v = valid ? v : -INFINITY; s[tt][r] = v; mx = fmaxf(mx, v); }
        mx = fmaxf(mx, __shfl_xor(mx, 32));
        float l = 0.f;
#pragma unroll
        for (int tt = 0; tt < 5; ++tt)
#pragma unroll
            for (int r = 0; r < 16; ++r) { const float p = __builtin_amdgcn_exp2f(s[tt][r] - mx); s[tt][r] = p; l += p; }
        l += __shfl_xor(l, 32); l += __builtin_amdgcn_exp2f(sk - mx);
        f32x16 o[2];
        o[0] = (f32x16){0.f, 0.f, 0.f, 0.f, 0.f, 0.f, 0.f, 0.f, 0.f, 0.f, 0.f, 0.f, 0.f, 0.f, 0.f, 0.f}; o[1] = o[0];
#pragma unroll
        for (int tt = 0; tt < 5; ++tt)
#pragma unroll
            for (int s2 = 0; s2 < 2; ++s2) {
                v4u pw; pw.x = pk2(s[tt][8 * s2 + 0], s[tt][8 * s2 + 1]); pw.y = pk2(s[tt][8 * s2 + 2], s[tt][8 * s2 + 3]); pw.z = pk2(s[tt][8 * s2 + 4], s[tt][8 * s2 + 5]); pw.w = pk2(s[tt][8 * s2 + 6], s[tt][8 * s2 + 7]);
                const bf16x8 pa = __builtin_bit_cast(bf16x8, pw);
#pragma unroll
                for (int dt = 0; dt < 2; ++dt) { const LAS bf16* vp = Vt + (32 * dt + q) * 264 + 32 * (qblk + tt) + 16 * s2 + 4 * hi;
                    const s16x4 lo = *(const LAS s16x4*)vp, hh = *(const LAS s16x4*)(vp + 8);
                    const bf16x8 vb = (bf16x8){lo[0], lo[1], lo[2], lo[3], hh[0], hh[1], hh[2], hh[3]};
                    o[dt] = __builtin_amdgcn_mfma_f32_32x32x16_bf16(pa, vb, o[dt], 0, 0, 0); }
            }
        if (hi == 0) lscr[q] = 1.0f / l;
        LDS_WAIT();
        bf16* orow = A2 + (size_t)(tok0 + q0) * 2048 + h * 64 + q;
#pragma unroll
        for (int r = 0; r < 16; ++r) { const int cr = crow(r, hi); const float li = lscr[cr];
            orow[(size_t)cr * 2048] = (bf16)f2bf(o[0][r] * li); orow[(size_t)cr * 2048 + 32] = (bf16)f2bf(o[1][r] * li); }
        LDS_WAIT();
    }
}
__device__ __forceinline__ void conv_unit(int unit, const bf16* U, bf16* A2, const float* cw, const float* cb, const float* lg, const float* lb, LAS unsigned char* lds, int tid, int lane, int wave) {
    const int b = unit >> 6, t0 = (unit & 63) * 32;
    LAS unsigned* Us = (LAS unsigned*)lds;
    LAS float* red = (LAS float*)(lds + 126976);
    const __amdgpu_buffer_rsrc_t ursrc = __builtin_amdgcn_make_buffer_rsrc((void*)(U + (size_t)b * SEQ * 1024), 0, SEQ * 1024 * 2, 0x00020000);
    {   const int rr0 = tid >> 7, cc = tid & 127;
#pragma unroll 4
        for (int i = 0; i < 16; ++i) { const int rr = rr0 + 4 * i, t = t0 - 30 + rr;
            if (rr < 62) { const unsigned voff = t >= 0 ? (unsigned)(t * 2048 + cc * 16) : 0xfffffff0u;
                const v4u w = __builtin_amdgcn_raw_buffer_load_b128(ursrc, voff, 0, 0);
                *(LAS v4u*)(Us + rr * 512 + cc * 4) = w; } } }
    const __amdgpu_buffer_rsrc_t wrsrc = __builtin_amdgcn_make_buffer_rsrc((void*)cw, 0, 31 * 1024 * 4, 0x00020000);
    float w0[31], w1[31];
#pragma unroll
    for (int j = 0; j < 31; ++j) { const v2u ww = __builtin_amdgcn_raw_buffer_load_b64(wrsrc, tid * 8, j * 4096, 0); w0[j] = __uint_as_float(ww.x); w1[j] = __uint_as_float(ww.y); }
    const f32x2 bb = *(const f32x2*)(cb + 2 * tid), gg = *(const f32x2*)(lg + 2 * tid), be = *(const f32x2*)(lb + 2 * tid);
    __syncthreads();
#pragma unroll 1
    for (int cq = 0; cq < 4; ++cq) {
        float a0[8], a1[8];
#pragma unroll
        for (int i = 0; i < 8; ++i) { a0[i] = bb.x; a1[i] = bb.y; }
        const LAS unsigned* up = Us + (8 * cq) * 512 + tid;
        unsigned un0 = up[0], un1 = up[512];
#pragma unroll
        for (int r = 0; r < 38; ++r) { const unsigned uu = un0; un0 = un1; if (r + 2 < 38) un1 = up[(r + 2) * 512];
            const float u0 = bflo(uu), u1 = bfhi(uu);
#pragma unroll
            for (int i = 0; i < 8; ++i) { const int j = r - i; if (j >= 0 && j <= 30) { a0[i] += u0 * w0[j]; a1[i] += u1 * w1[j]; } }
            __builtin_amdgcn_sched_barrier(0); }
#pragma unroll
        for (int i = 0; i < 8; ++i) { const float s1 = wave_sum(a0[i] + a1[i]), s2 = wave_sum(a0[i] * a0[i] + a1[i] * a1[i]);
            if (lane == 0) { red[((cq * 8 + wave) * 8 + i) * 2] = s1; red[((cq * 8 + wave) * 8 + i) * 2 + 1] = s2; } }
        __syncthreads();
#pragma unroll
        for (int i = 0; i < 8; ++i) { float t1 = 0.f, t2 = 0.f;
#pragma unroll
            for (int w = 0; w < 8; ++w) { t1 += red[((cq * 8 + w) * 8 + i) * 2]; t2 += red[((cq * 8 + w) * 8 + i) * 2 + 1]; }
            const float mean = t1 * (1.0f / 1024.0f), var = t2 * (1.0f / 1024.0f) - mean * mean, rstd = 1.0f / sqrtf(var + EPS);
            float y0 = (a0[i] - mean) * rstd * gg.x + be.x, y1 = (a1[i] - mean) * rstd * gg.y + be.y;
            y0 *= sigm(y0); y1 *= sigm(y1);
            *(GAS unsigned*)(A2 + (size_t)(b * SEQ + t0 + 8 * cq + i) * 2048 + 1024 + 2 * tid) = pk2(y0, y1); }
    }
}

struct Args { const float* in[20]; float* out; unsigned char* ws; int ph_lo, ph_hi; };
__global__ void __launch_bounds__(NWAVES * 64, 2) fwd_kernel(Args args) {
    extern __shared__ __attribute__((aligned(16))) unsigned char lds_raw[];
    LAS unsigned char* lds = (LAS unsigned char*)lds_raw;
    volatile LAS unsigned* MISC = (volatile LAS unsigned*)(lds + MISC_OFF);
    const int tid = threadIdx.x, lane = tid & 63, wave = __builtin_amdgcn_readfirstlane(tid >> 6);
    const int G = gridDim.x, bx = blockIdx.x;
    const int vcu = (G % 8 == 0) ? (bx % 8) * (G / 8) + bx / 8 : bx;
    const int gw = vcu * NWAVES + wave, NGW = G * NWAVES;
    unsigned char* ws = args.ws;
    const float* x = args.in[0]; const float* c_in = args.in[1]; const float* w_ada = args.in[2]; const float* b_ada = args.in[3]; const float* norm_mix_g = args.in[4];
    const float* w_in = args.in[5]; const float* q_norm_g = args.in[6]; const float* k_norm_g = args.in[7]; const float* attn_sinks = args.in[8]; const float* rel_bias = args.in[9];
    const float* w_attn_out = args.in[10]; const float* conv_w = args.in[11]; const float* conv_b = args.in[12]; const float* conv_ln_g = args.in[13]; const float* conv_ln_b = args.in[14];
    const float* w_conv_out = args.in[15]; const float* w_mix_out = args.in[16]; const float* norm_ffn_g = args.in[17]; const float* w_ffn_in = args.in[18]; const float* w_ffn_out = args.in[19];
    float* out = args.out;
    float* MOD = (float*)(ws + WS_MOD);
    bf16 *W1T = (bf16*)(ws + WS_W1T), *W2T = (bf16*)(ws + WS_W2T), *W3T = (bf16*)(ws + WS_W3T), *W4T = (bf16*)(ws + WS_W4T), *W5T = (bf16*)(ws + WS_W5T);
    bf16 *H = (bf16*)(ws + WS_H), *Qb = (bf16*)(ws + WS_Q), *Kb = (bf16*)(ws + WS_K), *Vb = (bf16*)(ws + WS_V), *Ub = (bf16*)(ws + WS_U), *Rb = (bf16*)(ws + WS_R), *GCb = (bf16*)(ws + WS_GC);
    bf16 *A2 = (bf16*)(ws + WS_A2), *MG = (bf16*)(ws + WS_MG), *HF = (bf16*)(ws + WS_HF);

    for (int u = tid; u < (LDS_BYTES - LDSCTL_OFF) / 4; u += NWAVES * 64) ((LAS unsigned*)(lds + LDSCTL_OFF))[u] = 0u;
    __syncthreads();
    const int lo = args.ph_lo, hi = args.ph_hi;
#if !MK_CG_SYNC
    XcdBarrier bar; bar.bar = (unsigned*)(ws + WS_CTL) + CW_BAR; bar.x = 0; bar.st = nullptr;
    if (hi - lo > 1) bar = xcd_barrier_post((unsigned*)(ws + WS_CTL) + CW_BAR, MISC + 8);
    if (lo < 0) cg::this_grid().sync();
#else
    (void)MISC;
#endif
#ifdef PHASE_MASK
#define IN(k) (((PHASE_MASK >> (k)) & 1) && lo <= (k) && (k) < hi)
#else
#define IN(k) (lo <= (k) && (k) < hi)
#endif
#define BOTH(k) (IN(k) && IN((k) + 1))
#ifndef REPEAT_MASK
#define REPEAT_MASK 0
#endif
#define NREP(k) ((((REPEAT_MASK) >> (k)) & 1) ? 2 : 1)
#if MK_CG_SYNC
#define GRID_BAR(k) do { if (BOTH(k)) cg::this_grid().sync(); } while (0)
#else
#define GRID_BAR(k) do { if (BOTH(k)) xcd_barrier(bar); } while (0)
#endif

    if (IN(0)) {
        p0_adaln(c_in, w_ada, b_ada, MOD, (LAS float*)lds, tid, lane, wave);
        LAS float* scr = (LAS float*)(lds + wave * 16384);
        constexpr int I0 = 32 * 240, I1 = 16 * 64, I2 = 16 * 64, I3 = 32 * 64, I4 = 32 * 352, I5 = 88 * 64, NITEMS = I0 + I1 + I2 + I3 + I4 + I5;
        for (int it = gw; it < NITEMS; it += NGW) {
            int r = it;
            if (r < I0) { transpose_item(w_in, N1, W1T, 2048, 0, 1, scr, r, lane); continue; } r -= I0;
            if (r < I1) { transpose_item(w_attn_out, DM, W2T, 2048, 0, 0, scr, r, lane); continue; } r -= I1;
            if (r < I2) { transpose_item(w_conv_out, DM, W2T, 2048, 1024, 0, scr, r, lane); continue; } r -= I2;
            if (r < I3) { transpose_item(w_mix_out, DM, W3T, 2048, 0, 0, scr, r, lane); continue; } r -= I3;
            if (r < I4) { transpose_item(w_ffn_in, N4, W4T, 2048, 0, 2, scr, r, lane); continue; } r -= I4;
            transpose_item(w_ffn_out, DM, W5T, DFF, 0, 0, scr, r, lane);
        }
        GRID_BAR(0);
    }
    if (IN(1)) { modnorm_phase(x, norm_mix_g, MOD, 0, DM, H, gw, NGW, lane); GRID_BAR(1); }
    if (IN(2)) for (int rep = 0; rep < NREP(2); ++rep) {
        pg8::Gemm g{H, W1T, MT, N1, DM}; pg8::StaticOrder S; S.init(MT, N1, G, bx);
        pg8::Epi1 E{Qb, Ub, Rb, GCb};
        pg8::gemm_phase<pg8::Epi1, pg8::StaticOrder, true, true>(lds, g, S, E);
        GRID_BAR(2);
    }
    if (IN(3)) for (int rep = 0; rep < NREP(3); ++rep) {
#ifndef NO_ATTN
        for (int u = bx; u < 256; u += G) { attn_unit(u, Qb, Kb, Vb, A2, q_norm_g, k_norm_g, attn_sinks, rel_bias, lds, tid, lane, wave); __syncthreads(); }
#endif
#ifndef NO_CONV
        for (int u = bx; u < 256; u += G) { conv_unit(u, Ub, A2, conv_w, conv_b, conv_ln_g, conv_ln_b, lds, tid, lane, wave); __syncthreads(); }
#endif
        GRID_BAR(3);
    }
    if (IN(4)) for (int rep = 0; rep < NREP(4); ++rep) {
        pg8::Gemm g{A2, W2T, MT, DM, DM}; pg8::StaticOrder S; S.init(MT, DM, G, bx);
        pg8::Epi2 E{Rb, GCb, MG};
        pg8::gemm_phase<pg8::Epi2, pg8::StaticOrder, true, true>(lds, g, S, E);
        GRID_BAR(4);
    }
    if (IN(5)) for (int rep = 0; rep < NREP(5); ++rep) {
        pg8::Gemm g{MG, W3T, MT, DM, DM}; pg8::StaticOrder S; S.init(MT, DM, G, bx);
        pg8::EpiRes E{x, out, MOD + 2 * DM};
        pg8::gemm_phase<pg8::EpiRes, pg8::StaticOrder, true, true>(lds, g, S, E);
        GRID_BAR(5);
    }
    if (IN(6)) { modnorm_phase(out, norm_ffn_g, MOD, 3 * DM, 4 * DM, H, gw, NGW, lane); GRID_BAR(6); }
    if (IN(7)) for (int rep = 0; rep < NREP(7); ++rep) {
        pg8::Gemm g{H, W4T, MT, N4, DM}; pg8::StaticOrder S; S.init(MT, N4, G, bx);
        pg8::Epi4 E{HF};
        pg8::gemm_phase<pg8::Epi4, pg8::StaticOrder, true, true>(lds, g, S, E);
        GRID_BAR(7);
    }
    if (IN(8)) {
        pg8::Gemm g{HF, W5T, MT, DM, DFF}; pg8::StaticOrder S; S.init(MT, DM, G, bx);
        pg8::EpiRes E{out, out, MOD + 5 * DM};
        pg8::gemm_phase<pg8::EpiRes, pg8::StaticOrder, true, true>(lds, g, S, E);
    }
#undef IN
#undef BOTH
#undef GRID_BAR
}

extern "C" void kernel_launch(void* const* d_in, const int* in_sizes, int n_in, void* d_out, int out_size, void* d_ws, size_t ws_size, hipStream_t stream) {
    static int grid = 0;
    if (grid == 0) {
        if (n_in != 20 || in_sizes[0] != MT * DM || out_size != MT * DM || ws_size < WS_END) {
            fprintf(stderr, "kernel_launch: shape/workspace mismatch (n_in %d, in0 %d, out %d, ws %zu, need %zu); nothing launched\n", n_in, n_in > 0 ? in_sizes[0] : -1, out_size, ws_size, (size_t)WS_END); grid = -1; return; }
        int dev = 0, cus = 0, per_cu = 0;
        if (hipGetDevice(&dev) != hipSuccess || hipDeviceGetAttribute(&cus, hipDeviceAttributeMultiprocessorCount, dev) != hipSuccess) { fprintf(stderr, "kernel_launch: device query failed\n"); grid = -1; return; }
        if (hipFuncSetAttribute((const void*)fwd_kernel, hipFuncAttributeMaxDynamicSharedMemorySize, LDS_BYTES) != hipSuccess) { fprintf(stderr, "kernel_launch: hipFuncSetAttribute failed\n"); grid = -1; return; }
        if (hipOccupancyMaxActiveBlocksPerMultiprocessor(&per_cu, (const void*)fwd_kernel, NWAVES * 64, LDS_BYTES) != hipSuccess || per_cu < 1) { fprintf(stderr, "kernel_launch: occupancy query says %d blocks per CU\n", per_cu); per_cu = 1; }
        (void)hipGetLastError();
        grid = cus * (per_cu < 1 ? 1 : 1);
        if (grid != 256) fprintf(stderr, "kernel_launch: note: grid = %d workgroups\n", grid);
    }
    if (grid < 0) return;
    if (hipMemsetAsync((char*)d_ws + WS_CTL, 0, CTL_ZERO_BYTES, stream) != hipSuccess) { fprintf(stderr, "kernel_launch: memset failed\n"); return; }
    Args a{};
    for (int i = 0; i < 20; ++i) a.in[i] = (const float*)d_in[i];
    a.out = (float*)d_out; a.ws = (unsigned char*)d_ws;
#if MK_PER_PHASE
    for (int ph = 0; ph < N_PHASES; ++ph) { a.ph_lo = ph; a.ph_hi = ph + 1; hipLaunchKernelGGL(fwd_kernel, dim3(grid), dim3(NWAVES * 64), LDS_BYTES, stream, a); }
#else
    a.ph_lo = 0; a.ph_hi = N_PHASES;
    void* kargs[] = {(void*)&a};
    const hipError_t e = hipLaunchCooperativeKernel((const void*)fwd_kernel, dim3(grid), dim3(NWAVES * 64), kargs, LDS_BYTES, stream);
    if (e != hipSuccess) fprintf(stderr, "kernel_launch: cooperative launch failed: %s (grid %d)\n", hipGetErrorString(e), grid);
#endif
}
```

```cpp
#include <hip/hip_runtime.h>
#include <hip/hip_cooperative_groups.h>
#include <cstdio>
#include <cstdint>
namespace cg = cooperative_groups;

#ifndef MK_PER_PHASE
#define MK_PER_PHASE 0
#endif
#ifndef MK_CG_SYNC
#define MK_CG_SYNC 0
#endif

namespace pg8 {
#define PG8_LAS __attribute__((address_space(3)))
typedef unsigned short bf16_t;
typedef short bf16x8 __attribute__((ext_vector_type(8)));
typedef float f32x4 __attribute__((ext_vector_type(4)));
typedef unsigned u32x4 __attribute__((ext_vector_type(4)));
constexpr int BM = 256, BK = 64, HALF = 128, HTB = HALF * BK * 2  , STAGE_BYTES = 8 * HTB, NXCD = 8, WGM = 8;

__host__ __device__ __forceinline__ int lds_byte(int r, int c) { const int st = (r >> 4) * 2 + (c >> 5), rr = r & 15, cc = c & 31, ob = rr * 64 + cc * 2; return st * 1024 + (ob ^ (((ob >> 9) & 1) << 5)); }
__host__ __device__ __forceinline__ void stage_rc(int b, int& R, int& C) { const int st = b / 1024, sb = b % 1024, swz = sb ^ (((sb >> 9) & 1) << 5); R = (st >> 1) * 16 + swz / 64; C = (st & 1) * 32 + (swz % 64) / 2; }
__host__ __device__ __forceinline__ int perm32(int rho) { const int n = rho >> 4, i = rho & 15; return 8 * (i >> 2) + 4 * n + (i & 3); }

struct Unit { int pm, pn; };
struct Gemm { const bf16_t* A; const bf16_t* Bt; int M, N, K; };

struct StaticOrder {
    int nM, nN, nwg, G, c;
    __host__ __device__ void init(int M, int N, int G_, int c_) { nM = M / BM; nN = N / BM; nwg = nM * nN; G = G_; c = c_; }
    __host__ __device__ bool next(int i, Unit& u) const {
        const long L = (long)i * G + c; if (L >= nwg) return false;
        int wgid = (int)L; { const int q = nwg / NXCD, r = nwg % NXCD, xcd = wgid % NXCD, off = wgid / NXCD; wgid = (xcd < r ? xcd * (q + 1) : r * (q + 1) + (xcd - r) * q) + off; }
        const int nig = WGM * nN, gid = wgid / nig, fm = gid * WGM, gsz = (nM - fm) < WGM ? (nM - fm) : WGM;
        u.pm = fm + ((wgid % nig) % gsz); u.pn = (wgid % nig) / gsz; return true;
    }
    __device__ __forceinline__ void a_ready(const Unit&) const {}
    __device__ __forceinline__ void done(const Unit&) const {}
};


__device__ __forceinline__ unsigned cvt_pk_bf16(float lo, float hi) { unsigned r; asm volatile("v_cvt_pk_bf16_f32 %0, %1, %2" : "=v"(r) : "v"(lo), "v"(hi)); return r; }
__device__ __forceinline__ float sigm(float x) { return __builtin_amdgcn_rcpf(1.0f + __builtin_amdgcn_exp2f(-1.4426950408889634f * x)); }
__device__ __forceinline__ u32x4 pack8(const f32x4& v0, const f32x4& v1) { u32x4 w; w.x = cvt_pk_bf16(v0[0], v0[1]); w.y = cvt_pk_bf16(v0[2], v0[3]); w.z = cvt_pk_bf16(v1[0], v1[1]); w.w = cvt_pk_bf16(v1[2], v1[3]); return w; }
__device__ __forceinline__ void unpack8(const u32x4& w, f32x4& v0, f32x4& v1) {
    v0[0] = __uint_as_float(w.x << 16); v0[1] = __uint_as_float(w.x & 0xffff0000u); v0[2] = __uint_as_float(w.y << 16); v0[3] = __uint_as_float(w.y & 0xffff0000u);
    v1[0] = __uint_as_float(w.z << 16); v1[1] = __uint_as_float(w.z & 0xffff0000u); v1[2] = __uint_as_float(w.w << 16); v1[3] = __uint_as_float(w.w & 0xffff0000u); }

struct Epi1 {
    static constexpr bool PERM = true, AFTER_DRAIN = false, MID = false;
    bf16_t *Q, *U, *R, *GC;
    __device__ __forceinline__ void mid(f32x4 (&)[2][2][4][2], const Unit&, int, int, int, int) const {}
    __device__ __forceinline__ void operator()(const f32x4 (&acc)[2][2][4][2], const Unit& u, int wr, int wc, int fr, int fq) const {
        const int row0 = u.pm * BM + wr * 64 + fr, cl = wc * 32 + 8 * fq;
        if (u.pn < 6) {
            const size_t boff = u.pn < 4 ? (size_t)0 : (u.pn == 4 ? (size_t)8388608 : (size_t)10485760);
            bf16_t* base = Q + boff; const int ld = u.pn < 4 ? 1024 : 256, c0 = u.pn < 4 ? u.pn * 256 : 0;
#pragma unroll
            for (int ai = 0; ai < 2; ++ai)
#pragma unroll
                for (int m = 0; m < 4; ++m) { bf16_t* rowp = base + (size_t)(row0 + ai * HALF + m * 16) * ld + c0 + cl;
#pragma unroll
                    for (int bj = 0; bj < 2; ++bj) *(u32x4*)(rowp + bj * HALF) = pack8(acc[ai][bj][m][0], acc[ai][bj][m][1]); }
        } else if (u.pn < 14) {
            const int c0 = (u.pn - 6) * 128 + cl;
#pragma unroll
            for (int ai = 0; ai < 2; ++ai)
#pragma unroll
                for (int m = 0; m < 4; ++m) { f32x4 o[2];
#pragma unroll
                    for (int n = 0; n < 2; ++n)
#pragma unroll
                        for (int e = 0; e < 4; ++e) o[n][e] = acc[ai][0][m][n][e] * sigm(acc[ai][1][m][n][e]);
                    *(u32x4*)(U + (size_t)(row0 + ai * HALF + m * 16) * 1024 + c0) = pack8(o[0], o[1]); }
        } else {
            const int c0 = (u.pn - 14) * 128 + cl;
#pragma unroll
            for (int ai = 0; ai < 2; ++ai)
#pragma unroll
                for (int m = 0; m < 4; ++m) { f32x4 r[2], g[2];
#pragma unroll
                    for (int n = 0; n < 2; ++n)
#pragma unroll
                        for (int e = 0; e < 4; ++e) { const float ea = __builtin_amdgcn_exp2f(-1.4426950408889634f * acc[ai][0][m][n][e]), ec = __builtin_amdgcn_exp2f(-1.4426950408889634f * acc[ai][1][m][n][e]);
                            g[n][e] = __builtin_amdgcn_rcpf(1.0f + ec); r[n][e] = (1.0f + ec) * __builtin_amdgcn_rcpf(1.0f + ea); }
                    const size_t off = (size_t)(row0 + ai * HALF + m * 16) * 2048 + c0;
                    *(u32x4*)(R + off) = pack8(r[0], r[1]); *(u32x4*)(GC + off) = pack8(g[0], g[1]); }
        }
    }
};
struct Epi2 {
    static constexpr bool PERM = true, AFTER_DRAIN = false, MID = true;
    const bf16_t *R, *GC; bf16_t* O;
    __device__ __forceinline__ void mid(f32x4 (&acc)[2][2][4][2], const Unit& u, int wr, int wc, int fr, int fq) const {
        asm volatile("" : "+v"(fr), "+v"(fq));
        const int row0 = u.pm * BM + wr * 64 + fr, col0 = u.pn * BM + wc * 32 + 8 * fq;
#pragma unroll
        for (int ai = 0; ai < 2; ++ai)
#pragma unroll
            for (int m = 0; m < 4; ++m) { const bf16_t* rowp = R + (size_t)(row0 + ai * HALF + m * 16) * 2048 + col0;
#pragma unroll
                for (int bj = 0; bj < 2; ++bj) { const u32x4 w = *(const u32x4*)(rowp + bj * HALF); f32x4 s0, s1; unpack8(w, s0, s1); acc[ai][bj][m][0] *= s0; acc[ai][bj][m][1] *= s1; }
                if (m & 1) asm volatile("" ::: "memory"); }
    }
    __device__ __forceinline__ void operator()(const f32x4 (&acc)[2][2][4][2], const Unit& u, int wr, int wc, int fr, int fq) const {
        const int row0 = u.pm * BM + wr * 64 + fr, col0 = u.pn * BM + wc * 32 + 8 * fq;
#pragma unroll
        for (int ai = 0; ai < 2; ++ai)
#pragma unroll
            for (int m = 0; m < 4; ++m) { const size_t off = (size_t)(row0 + ai * HALF + m * 16) * 2048 + col0;
#pragma unroll
                for (int bj = 0; bj < 2; ++bj) { const u32x4 w = *(const u32x4*)(GC + off + bj * HALF); f32x4 s0, s1; unpack8(w, s0, s1);
                    *(u32x4*)(O + off + bj * HALF) = pack8(acc[ai][bj][m][0] * s0, acc[ai][bj][m][1] * s1); }
                if (m & 1) asm volatile("" ::: "memory"); }
    }
};
struct EpiRes {
    static constexpr bool PERM = false, AFTER_DRAIN = false, MID = false;
    const float* base; float* out; const float* gate;
    __device__ __forceinline__ void mid(f32x4 (&)[2][2][4][2], const Unit&, int, int, int, int) const {}
    __device__ __forceinline__ void operator()(const f32x4 (&acc)[2][2][4][2], const Unit& u, int wr, int wc, int fr, int fq) const {
        const int row0 = u.pm * BM + wr * 64 + fr, col0 = u.pn * BM + wc * 32 + 4 * fq;
        const float* gp = gate + (size_t)(u.pm >> 3) * 12288 + col0;
        f32x4 gv[2][2];
#pragma unroll
        for (int bj = 0; bj < 2; ++bj)
#pragma unroll
            for (int n = 0; n < 2; ++n) gv[bj][n] = *(const f32x4*)(gp + bj * HALF + n * 16);
#pragma unroll
        for (int ai = 0; ai < 2; ++ai)
#pragma unroll
            for (int m = 0; m < 4; ++m) { const size_t off = (size_t)(row0 + ai * HALF + m * 16) * 2048 + col0;
#pragma unroll
                for (int bj = 0; bj < 2; ++bj)
#pragma unroll
                    for (int n = 0; n < 2; ++n) { const f32x4 b = *(const f32x4*)(base + off + bj * HALF + n * 16); *(f32x4*)(out + off + bj * HALF + n * 16) = b + gv[bj][n] * acc[ai][bj][m][n]; } }
    }
};
struct Epi4 {
    static constexpr bool PERM = true, AFTER_DRAIN = false, MID = false;
    bf16_t* HF;
    __device__ __forceinline__ void mid(f32x4 (&)[2][2][4][2], const Unit&, int, int, int, int) const {}
    __device__ __forceinline__ void operator()(const f32x4 (&acc)[2][2][4][2], const Unit& u, int wr, int wc, int fr, int fq) const {
        const int row0 = u.pm * BM + wr * 64 + fr, c0 = u.pn * 128 + wc * 32 + 8 * fq;
#pragma unroll
        for (int ai = 0; ai < 2; ++ai)
#pragma unroll
            for (int m = 0; m < 4; ++m) { f32x4 o[2];
#pragma unroll
                for (int n = 0; n < 2; ++n)
#pragma unroll
                    for (int e = 0; e < 4; ++e) { const float g = acc[ai][0][m][n][e]; o[n][e] = g * sigm(g) * acc[ai][1][m][n][e]; }
                *(u32x4*)(HF + (size_t)(row0 + ai * HALF + m * 16) * 5632 + c0) = pack8(o[0], o[1]); }
    }
};

template <class Epi, class Sched, bool ALIGN_EPI = false, bool SP2 = false>
__device__ __forceinline__ void gemm_phase(PG8_LAS unsigned char* lds, const Gemm g, const Sched& S, const Epi& E) {
    const int tid = threadIdx.x, wid = __builtin_amdgcn_readfirstlane(tid >> 6), lane = tid & 63, wr = wid >> 2, wc = wid & 3, fr = lane & 15, fq = lane >> 4;
    const int K = g.K, nt = K / BK;
    unsigned voffA[2], voffB[2];
#pragma unroll
    for (int i = 0; i < 2; ++i) { int R, C; stage_rc(tid * 16 + i * 8192, R, C); const int Rb = Epi::PERM ? ((R & ~31) + perm32(R & 31)) : R;
        voffA[i] = (unsigned)(R * K + C) * 2u; voffB[i] = (unsigned)(Rb * K + C) * 2u; }
    const size_t kstep = (size_t)(BK * 2);
    const size_t hstep = (size_t)HALF * K * 2;
    const size_t tstep = 2 * hstep;
    const unsigned ldsw = (unsigned)wid * 1024u;
    const int aoff = lds_byte(wr * 64 + fr, fq * 8), boff = lds_byte(wc * 32 + fr, fq * 8);
#define PG8_SA(b, h) (((b) * 2 + (h)) * HTB)
#define PG8_SB(b, h) ((4 + (b) * 2 + (h)) * HTB)
#define PG8_STAGE(bufoff, gbase, voff) do { _Pragma("unroll") for (int _i = 0; _i < 2; ++_i) \
        __builtin_amdgcn_global_load_lds((const unsigned*)((const char*)(gbase) + (voff)[_i]), (PG8_LAS unsigned*)(lds + (bufoff) + ldsw + _i * 8192), 16, 0, 0); } while (0)
#define PG8_LDA(dst, b, h) do { _Pragma("unroll") for (int m = 0; m < 4; ++m) _Pragma("unroll") for (int k = 0; k < 2; ++k) dst[m][k] = *(const PG8_LAS bf16x8*)(lds + PG8_SA(b, h) + aoff + m * 2048 + k * 1024); } while (0)
#define PG8_LDB(dst, b, h) do { _Pragma("unroll") for (int n = 0; n < 2; ++n) _Pragma("unroll") for (int k = 0; k < 2; ++k) dst[n][k] = *(const PG8_LAS bf16x8*)(lds + PG8_SB(b, h) + boff + n * 2048 + k * 1024); } while (0)
#define PG8_MMA(ai, bj, At, Bt) do { __builtin_amdgcn_s_setprio(1); _Pragma("unroll") for (int m = 0; m < 4; ++m) _Pragma("unroll") for (int n = 0; n < 2; ++n) _Pragma("unroll") for (int k = 0; k < 2; ++k) \
        acc[ai][bj][m][n] = __builtin_amdgcn_mfma_f32_16x16x32_bf16(Bt[n][k], At[m][k], acc[ai][bj][m][n], 0, 0, 0); __builtin_amdgcn_s_setprio(0); } while (0)
#define PG8_WAIT_V(n) asm volatile("s_waitcnt vmcnt(" #n ")" ::: "memory")
#define PG8_WAIT_L(n) asm volatile("s_waitcnt lgkmcnt(" #n ")" ::: "memory")
#define PG8_BAR __builtin_amdgcn_s_barrier()
#define PG8_SCHED __builtin_amdgcn_sched_barrier(0)
    Unit cur, nxt; int ui = 0;
    if (!S.next(0, cur)) return;
    f32x4 acc[2][2][4][2];
#pragma unroll
    for (int a = 0; a < 2; ++a)
#pragma unroll
        for (int b = 0; b < 2; ++b)
#pragma unroll
            for (int m = 0; m < 4; ++m)
#pragma unroll
                for (int n = 0; n < 2; ++n) acc[a][b][m][n] = (f32x4){0.f, 0.f, 0.f, 0.f};
    bf16x8 At[4][2], B0[2][2], B1[2][2];
    const char* cA = (const char*)g.A + (size_t)cur.pm * tstep; const char* cB = (const char*)g.Bt + (size_t)cur.pn * tstep;
    S.a_ready(cur);
    if constexpr (SP2) {
        PG8_STAGE(PG8_SB(0, 0), cB, voffB); PG8_STAGE(PG8_SB(0, 1), cB + hstep, voffB); PG8_STAGE(PG8_SA(0, 0), cA, voffA); PG8_STAGE(PG8_SA(0, 1), cA + hstep, voffA);
        if (wr == 1) PG8_BAR;
        PG8_WAIT_V(2); PG8_BAR;
        PG8_STAGE(PG8_SB(1, 0), cB + kstep, voffB); PG8_STAGE(PG8_SA(1, 0), cA + kstep, voffA); PG8_STAGE(PG8_SB(1, 1), cB + hstep + kstep, voffB);
        PG8_WAIT_V(6); PG8_BAR;
    } else {
        PG8_STAGE(PG8_SB(0, 0), cB, voffB); PG8_STAGE(PG8_SA(0, 0), cA, voffA); PG8_STAGE(PG8_SB(0, 1), cB + hstep, voffB); PG8_STAGE(PG8_SA(0, 1), cA + hstep, voffA);
        if (wr == 1) PG8_BAR;
        PG8_WAIT_V(4); PG8_BAR;
        PG8_STAGE(PG8_SB(1, 0), cB + kstep, voffB); PG8_STAGE(PG8_SA(1, 0), cA + kstep, voffA); PG8_STAGE(PG8_SB(1, 1), cB + hstep + kstep, voffB);
        PG8_WAIT_V(6); PG8_BAR;
    }
    for (;;) {
        const bool has_next = S.next(ui + 1, nxt);
        const char* nA = has_next ? (const char*)g.A + (size_t)nxt.pm * tstep : cA; const char* nB = has_next ? (const char*)g.Bt + (size_t)nxt.pn * tstep : cB;
        for (int t = 0; t < nt; t += 2) {
            const bool last = (t == nt - 2);
            const char* a1 = cA + (size_t)(t + 1) * kstep;
            const char* a2 = last ? nA : cA + (size_t)(t + 2) * kstep; const char* b2 = last ? nB : cB + (size_t)(t + 2) * kstep;
            const char* a3 = a2 + kstep; const char* b3 = b2 + kstep;
            if (last && has_next) S.a_ready(nxt);
            if constexpr (Epi::MID) { if (t == (nt >> 1)) E.mid(acc, cur, wr, wc, fr, fq); }
            if constexpr (SP2) {
            PG8_LDB(B0, 0, 0); PG8_LDB(B1, 0, 1); PG8_SCHED; PG8_LDA(At, 0, 0); PG8_STAGE(PG8_SA(1, 1), a1 + hstep, voffA);
            PG8_WAIT_V(8); PG8_WAIT_L(0); PG8_BAR; PG8_MMA(0, 0, At, B0); PG8_MMA(0, 1, At, B1); PG8_BAR; PG8_SCHED;
            PG8_LDA(At, 0, 1); PG8_STAGE(PG8_SB(0, 0), b2, voffB); PG8_STAGE(PG8_SB(0, 1), b2 + hstep, voffB); PG8_STAGE(PG8_SA(0, 0), a2, voffA);
            PG8_WAIT_V(8); PG8_WAIT_L(0); PG8_BAR; PG8_MMA(1, 0, At, B0); PG8_MMA(1, 1, At, B1); PG8_BAR; PG8_SCHED;
            PG8_LDB(B0, 1, 0); PG8_LDB(B1, 1, 1); PG8_SCHED; PG8_LDA(At, 1, 0); PG8_STAGE(PG8_SA(0, 1), a2 + hstep, voffA);
            PG8_WAIT_V(8); PG8_WAIT_L(0); PG8_BAR; PG8_MMA(0, 0, At, B0); PG8_MMA(0, 1, At, B1); PG8_BAR; PG8_SCHED;
            PG8_LDA(At, 1, 1); PG8_STAGE(PG8_SB(1, 0), b3, voffB); PG8_STAGE(PG8_SB(1, 1), b3 + hstep, voffB); PG8_STAGE(PG8_SA(1, 0), a3, voffA);
            PG8_WAIT_V(8); PG8_WAIT_L(0); PG8_BAR; PG8_MMA(1, 0, At, B0); PG8_MMA(1, 1, At, B1); PG8_BAR; PG8_SCHED;
            } else {
            PG8_LDB(B0, 0, 0); PG8_SCHED; PG8_LDA(At, 0, 0); PG8_STAGE(PG8_SA(1, 1), a1 + hstep, voffA);
            PG8_WAIT_L(8); PG8_BAR; PG8_WAIT_L(0); PG8_MMA(0, 0, At, B0); PG8_BAR; PG8_SCHED;
            PG8_LDB(B1, 0, 1); PG8_STAGE(PG8_SB(0, 0), b2, voffB);
            PG8_BAR; PG8_WAIT_L(0); PG8_MMA(0, 1, At, B1); PG8_BAR;
            PG8_LDA(At, 0, 1); PG8_STAGE(PG8_SA(0, 0), a2, voffA);
            PG8_BAR; PG8_WAIT_L(0); PG8_MMA(1, 0, At, B0); PG8_BAR; PG8_SCHED;
            PG8_STAGE(PG8_SB(0, 1), b2 + hstep, voffB);
            PG8_WAIT_V(6); PG8_BAR; PG8_MMA(1, 1, At, B1); PG8_BAR;
            PG8_LDB(B0, 1, 0); PG8_SCHED; PG8_LDA(At, 1, 0); PG8_STAGE(PG8_SA(0, 1), a2 + hstep, voffA);
            PG8_WAIT_L(8); PG8_BAR; PG8_WAIT_L(0); PG8_MMA(0, 0, At, B0); PG8_BAR; PG8_SCHED;
            PG8_LDB(B1, 1, 1); PG8_STAGE(PG8_SB(1, 0), b3, voffB);
            PG8_BAR; PG8_WAIT_L(0); PG8_MMA(0, 1, At, B1); PG8_BAR;
            PG8_LDA(At, 1, 1); PG8_STAGE(PG8_SA(1, 0), a3, voffA);
            PG8_BAR; PG8_WAIT_L(0); PG8_MMA(1, 0, At, B0); PG8_BAR; PG8_SCHED;
            PG8_STAGE(PG8_SB(1, 1), b3 + hstep, voffB);
            PG8_WAIT_V(6); PG8_BAR; PG8_MMA(1, 1, At, B1); PG8_BAR;
            }
        }
        if constexpr (ALIGN_EPI) { if (wr == 0) PG8_BAR; }
        if constexpr (!Epi::AFTER_DRAIN) { E(acc, cur, wr, wc, fr, fq); S.done(cur); }
        if (!has_next) break;
#pragma unroll
        for (int a = 0; a < 2; ++a)
#pragma unroll
            for (int b = 0; b < 2; ++b)
#pragma unroll
                for (int m = 0; m < 4; ++m)
#pragma unroll
                    for (int n = 0; n < 2; ++n) acc[a][b][m][n] = (f32x4){0.f, 0.f, 0.f, 0.f};
        cur = nxt; cA = nA; cB = nB; ++ui;
        if constexpr (ALIGN_EPI) { if (wr == 1) PG8_BAR; }
    }
    PG8_WAIT_V(0);
    if constexpr (!ALIGN_EPI) { if (wr == 0) PG8_BAR; }
    PG8_BAR;
    if constexpr (Epi::AFTER_DRAIN) { E.fused(acc, cur, wr, wc, fr, fq, lds, wid, lane); S.done(cur); }
#undef PG8_SA
#undef PG8_SB
#undef PG8_STAGE
#undef PG8_LDA
#undef PG8_LDB
#undef PG8_MMA
#undef PG8_WAIT_V
#undef PG8_WAIT_L
#undef PG8_BAR
#undef PG8_SCHED
}
}


constexpr int NWAVES = 8;
constexpr int DM = 2048, BATCH = 4, SEQ = 2048, MT = BATCH * SEQ;
constexpr int NQ = 1024, NKVW = 256, CONVC = 1024, DFF = 5632, NMOD = 6 * DM;
constexpr int N1 = 7680, N4 = 2 * DFF;
constexpr float EPS = 1e-6f, LOG2E = 1.4426950408889634f;
constexpr int N_PHASES = 9;

constexpr size_t MiB = 1u << 20;
constexpr size_t WS_CTL = 0, WS_MOD = 65536, CTL_ZERO_BYTES = 262144;
constexpr size_t WS_W1T = 1 * MiB, WS_W2T = 31 * MiB, WS_W3T = 39 * MiB, WS_W4T = 47 * MiB, WS_W5T = 91 * MiB;
constexpr size_t WS_H = 113 * MiB;
constexpr size_t WS_Q = 145 * MiB, WS_K = 161 * MiB, WS_V = 165 * MiB, WS_U = 169 * MiB, WS_R = 185 * MiB, WS_GC = 217 * MiB;
constexpr size_t WS_A2 = 249 * MiB, WS_MG = 281 * MiB, WS_END = 313 * MiB;
constexpr size_t WS_HF = 145 * MiB;
static_assert(WS_HF + (size_t)MT * DFF * 2 <= WS_A2, "HF overlay");
static_assert(WS_K - WS_Q == 2 * (size_t)8388608 && WS_V - WS_Q == 2 * (size_t)10485760, "Epi1 reaches K and V from Q by fixed element offsets");
constexpr int CW_BAR = 1024;

constexpr int RING_BYTES = 131072, LDSCTL_OFF = RING_BYTES, MISC_OFF = LDSCTL_OFF + 320, LDS_BYTES = 147456;

#define GAS __attribute__((address_space(1)))
#define LAS __attribute__((address_space(3)))
typedef unsigned short bf16;
typedef unsigned v4u __attribute__((ext_vector_type(4)));
typedef unsigned v2u __attribute__((ext_vector_type(2)));
typedef float f32x4 __attribute__((ext_vector_type(4)));
typedef float f32x2 __attribute__((ext_vector_type(2)));
typedef float f32x16 __attribute__((ext_vector_type(16)));
typedef short bf16x8 __attribute__((ext_vector_type(8)));
typedef short s16x4 __attribute__((ext_vector_type(4)));
typedef GAS unsigned gu32;
#define RLX_AGENT __ATOMIC_RELAXED, __HIP_MEMORY_SCOPE_AGENT
#define LDS_WAIT() asm volatile("s_waitcnt lgkmcnt(0)" ::: "memory")
__device__ __forceinline__ unsigned f2bf(float f) { unsigned u = __builtin_bit_cast(unsigned, f); return (u + 0x7fffu + ((u >> 16) & 1u)) >> 16; }
__device__ __forceinline__ unsigned pk2(float lo, float hi) { return f2bf(lo) | (f2bf(hi) << 16); }
__device__ __forceinline__ float bflo(unsigned w) { return __uint_as_float(w << 16); }
__device__ __forceinline__ float bfhi(unsigned w) { return __uint_as_float(w & 0xffff0000u); }
__device__ __forceinline__ float sigm(float x) { return __builtin_amdgcn_rcpf(1.0f + __builtin_amdgcn_exp2f(-LOG2E * x)); }
__device__ __forceinline__ float wave_sum(float v) {
#pragma unroll
    for (int o = 1; o < 64; o <<= 1) v += __shfl_xor(v, o);
    return v;
}

#define XB_TMO      128
#define XB_XCNT(j)  (256  + 64 * (j))
#define XB_XSUB(j)  (1280 + 64 * (j))
#define XB_XGEN(j)  (2304 + 64 * (j))
#define XB_TOP      3328
#define XB_TOPGEN   3392
#define XCD_BAR_WORDS 3456
#define XB_SPIN_CAP (1u << 18)

__device__ __forceinline__ unsigned xb_ld(unsigned* p)              { return __hip_atomic_load(p, __ATOMIC_RELAXED, __HIP_MEMORY_SCOPE_AGENT); }
__device__ __forceinline__ unsigned xb_add(unsigned* p, unsigned v) { return __hip_atomic_fetch_add(p, v, __ATOMIC_RELAXED, __HIP_MEMORY_SCOPE_AGENT); }
__device__ __forceinline__ unsigned xb_xcc_id() { return (unsigned)__builtin_amdgcn_s_getreg((3 << 11) | 20) & 0xFu; }
#define XB_SPIN(cond, bar) do { unsigned _sp = 0; while (cond) { __builtin_amdgcn_s_sleep(1); \
    if ((++_sp & 255u) == 0u) { if (xb_ld(&(bar)[XB_TMO])) break; if (_sp > XB_SPIN_CAP) { atomicAdd(&(bar)[XB_TMO], 1u); break; } } } } while (0)

struct XcdBarrier {
    unsigned* bar; unsigned x;
    volatile LAS unsigned* st;
};

__device__ __forceinline__ XcdBarrier xcd_barrier_post(unsigned* bar, volatile LAS unsigned* st) {
    XcdBarrier b; b.bar = bar; b.x = xb_xcc_id(); b.st = st;
    if (threadIdx.x == 0) (void)xb_add(&bar[XB_XCNT(b.x)], 1u);
    return b;
}
__device__ __forceinline__ void xcd_barrier_complete(unsigned* bar, unsigned x, unsigned& nloc, unsigned& nx) {
    const unsigned G = gridDim.x * gridDim.y * gridDim.z;
    unsigned sum, cnt, mine, sp = 0u;
    for (;;) {
        sum = 0u; cnt = 0u; mine = 0u;
#pragma unroll
        for (unsigned j = 0; j < 16; ++j) { const unsigned c = xb_ld(&bar[XB_XCNT(j)]); sum += c; cnt += (c > 0u) ? 1u : 0u; mine = (j == x) ? c : mine; }
        if (sum == G) break;
        __builtin_amdgcn_s_sleep(1);
        if ((++sp & 255u) == 0u) { if (xb_ld(&bar[XB_TMO])) break; if (sp > XB_SPIN_CAP) { atomicAdd(&bar[XB_TMO], 1u); break; } }
    }
    nloc = mine > 0u ? mine : 1u; nx = cnt > 0u ? cnt : 1u;
}

__device__ __forceinline__ void xcd_barrier(const XcdBarrier& b) {
    asm volatile("s_waitcnt vmcnt(0)" ::: "memory");
    __syncthreads();
    if (threadIdx.x == 0) {
        unsigned* bar = b.bar;
        __builtin_amdgcn_s_waitcnt(0);
        unsigned nloc = b.st[0], nx = b.st[1];
        if (nloc == 0u) { xcd_barrier_complete(bar, b.x, nloc, nx); b.st[0] = nloc; b.st[1] = nx; }
        const unsigned old = xb_add(&bar[XB_XSUB(b.x)], 1u);
        const unsigned gen = old / nloc;
        if (old + 1u == (gen + 1u) * nloc) {
            __builtin_amdgcn_fence(__ATOMIC_RELEASE, "agent");
            asm volatile("s_waitcnt vmcnt(0)" ::: "memory");
            const unsigned og = xb_add(&bar[XB_TOP], 1u);
            const unsigned tg = og / nx;
            if (og + 1u == (tg + 1u) * nx) xb_add(&bar[XB_TOPGEN], 1u);
            else XB_SPIN(xb_ld(&bar[XB_TOPGEN]) == tg, bar);
            __builtin_amdgcn_fence(__ATOMIC_ACQUIRE, "agent");
            xb_add(&bar[XB_XGEN(b.x)], 1u);
            asm volatile("s_waitcnt vmcnt(0)" ::: "memory");
        } else {
            XB_SPIN(xb_ld(&bar[XB_XGEN(b.x)]) == gen, bar);
            __builtin_amdgcn_fence(__ATOMIC_ACQUIRE, "agent");
            asm volatile("s_waitcnt vmcnt(0)" ::: "memory");
        }
    }
    __syncthreads();
}

__device__ __forceinline__ void p0_adaln(const float* c, const float* w_ada, const float* b_ada, float* MOD, LAS float* red, int tid, int lane, int wave) {
    const __amdgpu_buffer_rsrc_t wrsrc = __builtin_amdgcn_make_buffer_rsrc((void*)w_ada, 0, DM * NMOD * 4, 0x00020000);
    for (int it = blockIdx.x; it < 48 * 16; it += gridDim.x) {
        const int cgp = it % 48, kc = it / 48, k0 = kc * 128 + wave * 16, c0 = cgp * 256 + lane * 4;
        const float cv = c[(lane >> 4) * DM + k0 + (lane & 15)];
        const float sv = cv * sigm(cv);
        f32x4 acc[4], w4[16];
#pragma unroll
        for (int b = 0; b < 4; ++b) acc[b] = (f32x4){0.f, 0.f, 0.f, 0.f};
        const unsigned voff = (unsigned)(k0 * NMOD + c0) * 4u;
#pragma unroll
        for (int r = 0; r < 16; ++r) w4[r] = __builtin_bit_cast(f32x4, __builtin_amdgcn_raw_buffer_load_b128(wrsrc, voff, r * (NMOD * 4), 0));
#pragma unroll
        for (int r = 0; r < 16; ++r)
#pragma unroll
            for (int b = 0; b < 4; ++b) { const float sc = __uint_as_float(__builtin_amdgcn_readlane(__float_as_uint(sv), b * 16 + r)); acc[b] += w4[r] * sc; }
#pragma unroll
        for (int b = 0; b < 4; ++b) *(LAS f32x4*)(red + ((wave * 4 + b) * 256 + lane * 4)) = acc[b];
        __syncthreads();
#pragma unroll
        for (int e = 0; e < 2; ++e) { const int o = tid * 2 + e, b = o >> 8, col = o & 255; float s = 0.f;
#pragma unroll
            for (int w = 0; w < 8; ++w) s += red[(w * 4 + b) * 256 + col];
            if (kc == 0) s += b_ada[cgp * 256 + col];
            atomicAdd(MOD + b * NMOD + cgp * 256 + col, s); }
        __syncthreads();
    }
}
__device__ __forceinline__ int maprow(int mapid, int n0) {
    if (mapid == 1) {
        if (n0 < 1536) return n0;
        if (n0 < 2560) { const int t = n0 - 1536; return 1536 + ((t >> 7) << 8) + (t & 127); }
        if (n0 < 3584) { const int t = n0 - 2560; return 1536 + ((t >> 7) << 8) + 128 + (t & 127); }
        if (n0 < 5632) { const int t = n0 - 3584; return 3584 + ((t >> 7) << 8) + (t & 127); }
        const int t = n0 - 5632; return 3584 + ((t >> 7) << 8) + 128 + (t & 127);
    }
    if (mapid == 2) {
        if (n0 < DFF) return ((n0 >> 7) << 8) + (n0 & 127);
        const int t = n0 - DFF; return ((t >> 7) << 8) + 128 + (t & 127);
    }
    return n0;
}
__device__ __forceinline__ void transpose_write(const float (&v)[32], bf16* WT, int ldk, int kcol, int drow0, LAS float* scr, int lane) {
#pragma unroll
    for (int i = 0; i < 32; ++i) scr[(2 * i + (lane >> 5)) * 33 + (lane & 31)] = v[i];
    LDS_WAIT(); asm volatile("" ::: "memory");
    const int c = lane & 7;
#pragma unroll
    for (int j = 0; j < 4; ++j) { const int n = (lane >> 3) + 8 * j; const LAS float* s = scr + (8 * c) * 33 + n;
        v4u o; o.x = pk2(s[0 * 33], s[1 * 33]); o.y = pk2(s[2 * 33], s[3 * 33]); o.z = pk2(s[4 * 33], s[5 * 33]); o.w = pk2(s[6 * 33], s[7 * 33]);
        *(GAS v4u*)(WT + (size_t)(drow0 + n) * ldk + kcol + 8 * c) = o; }
    LDS_WAIT(); asm volatile("" ::: "memory");
}
template <int MAPID>
__device__ __forceinline__ void transpose_matrix(const float* W, int K, int N, bf16* WT, int ldk, int koff, int item_off, LAS float* scr, int gw, int NGW, int lane) {
    const int nblk = N / 32, nitems = (K / 64) * nblk;
    const __amdgpu_buffer_rsrc_t rsrc = __builtin_amdgcn_make_buffer_rsrc((void*)W, 0, K * N * 4, 0x00020000);
    const unsigned lane_off = (unsigned)((lane >> 5) * N + (lane & 31)) * 4u, rowstep = (unsigned)N * 8u;
    for (int it = ((gw - item_off) % NGW + NGW) % NGW; it < nitems; it += 2 * NGW) {
        const int itB = it + NGW; const bool hasB = itB < nitems;
        const int kA = 64 * (it / nblk), nA = 32 * (it % nblk), kB = hasB ? 64 * (itB / nblk) : 0, nB = hasB ? 32 * (itB % nblk) : 0;
        const unsigned offA = (unsigned)(kA * N + nA) * 4u + lane_off, offB = (unsigned)(kB * N + nB) * 4u + lane_off;
        float va[32], vb[32];
#pragma unroll
        for (int i = 0; i < 32; ++i) va[i] = __uint_as_float(__builtin_amdgcn_raw_buffer_load_b32(rsrc, offA, i * rowstep, 0));
        if (hasB) {
#pragma unroll
            for (int i = 0; i < 32; ++i) vb[i] = __uint_as_float(__builtin_amdgcn_raw_buffer_load_b32(rsrc, offB, i * rowstep, 0));
        }
        transpose_write(va, WT, ldk, koff + kA, maprow(MAPID, nA), scr, lane);
        if (hasB) transpose_write(vb, WT, ldk, koff + kB, maprow(MAPID, nB), scr, lane);
    }
}
__device__ __forceinline__ void modnorm_phase(const float* X, const float* g, const float* MOD, int sh_off, int sc_off, bf16* H, int gw, int NGW, int lane) {
    for (int it = gw; it < MT / 4; it += NGW) {
        const int row0 = it * 4, b = row0 / SEQ;
        f32x4 A[8], Bv[8];
#pragma unroll
        for (int j = 0; j < 8; ++j) { const int col = 4 * (lane + 64 * j);
            const f32x4 gg = *(const f32x4*)(g + col), sc = *(const f32x4*)(MOD + (size_t)b * NMOD + sc_off + col);
            A[j] = gg * (1.0f + sc); Bv[j] = *(const f32x4*)(MOD + (size_t)b * NMOD + sh_off + col); }
        for (int r = 0; r < 4; ++r) {
            const float* xr = X + (size_t)(row0 + r) * DM;
            f32x4 v[8]; float ss = 0.f;
#pragma unroll
            for (int j = 0; j < 8; ++j) { v[j] = *(const f32x4*)(xr + 4 * (lane + 64 * j)); ss += (v[j].x * v[j].x + v[j].y * v[j].y) + (v[j].z * v[j].z + v[j].w * v[j].w); }
            const float rstd = 1.0f / sqrtf(wave_sum(ss) * (1.0f / DM) + EPS);
            bf16* hr = H + (size_t)(row0 + r) * DM;
#pragma unroll
            for (int j = 0; j < 8; ++j) { const f32x4 o = v[j] * rstd * A[j] + Bv[j]; v2u w; w.x = pk2(o.x, o.y); w.y = pk2(o.z, o.w); *(GAS v2u*)(hr + 4 * (lane + 64 * j)) = w; }
        }
    }
}
__device__ __forceinline__ int crow(int r, int hi) { return (r & 3) + 8 * (r >> 2) + 4 * hi; }
__device__ __forceinline__ void attn_unit(int unit, const bf16* Qb, const bf16* Kb, const bf16* Vb, bf16* A2, const float* qg, const float* kg, const float* sinks, const float* relb,
                                          LAS unsigned char* lds, int tid, int lane, int wave) {
    const int b = unit >> 6, kvh = (unit >> 4) & 3, nb = unit & 15;
    LAS bf16* Ks = (LAS bf16*)lds;
    LAS bf16* Vt = (LAS bf16*)(lds + 36864);
    LAS float* biasT = (LAS float*)(lds + 36864 + 33792);
    LAS float* lscr = biasT + 512 + wave * 32;
    const int tok0 = b * SEQ + nb * 128;
#pragma unroll
    for (int i = 0; i < 4; ++i) {
        const int c = tid + 512 * i, key = c >> 3, part = c & 7;
        const bool real = (nb > 0) || (key >= 128);
        const long tok = (long)tok0 - 128 + key;
        v4u kw = (v4u){0u, 0u, 0u, 0u}, vw = (v4u){0u, 0u, 0u, 0u};
        if (real) { kw = *(const v4u*)(Kb + tok * 256 + kvh * 64 + part * 8); vw = *(const v4u*)(Vb + tok * 256 + kvh * 64 + part * 8); }
        const f32x4 k0 = (f32x4){bflo(kw.x), bfhi(kw.x), bflo(kw.y), bfhi(kw.y)}, k1 = (f32x4){bflo(kw.z), bfhi(kw.z), bflo(kw.w), bfhi(kw.w)};
        float ss = (k0.x * k0.x + k0.y * k0.y) + (k0.z * k0.z + k0.w * k0.w) + (k1.x * k1.x + k1.y * k1.y) + (k1.z * k1.z + k1.w * k1.w);
        ss += __shfl_xor(ss, 1); ss += __shfl_xor(ss, 2); ss += __shfl_xor(ss, 4);
        const float rstd = 1.0f / sqrtf(ss * (1.0f / 64.0f) + EPS);
        const f32x4 g0 = *(const f32x4*)(kg + part * 8) * rstd, g1 = *(const f32x4*)(kg + part * 8 + 4) * rstd;
        v4u o; o.x = pk2(k0.x * g0.x, k0.y * g0.y); o.y = pk2(k0.z * g0.z, k0.w * g0.w); o.z = pk2(k1.x * g1.x, k1.y * g1.y); o.w = pk2(k1.z * g1.z, k1.w * g1.w);
        *(LAS v4u*)(Ks + key * 72 + part * 8) = o;
        LAS bf16* vt = Vt + (part * 8) * 264 + key;
        vt[0 * 264] = (bf16)(vw.x & 0xffffu); vt[1 * 264] = (bf16)(vw.x >> 16); vt[2 * 264] = (bf16)(vw.y & 0xffffu); vt[3 * 264] = (bf16)(vw.y >> 16);
        vt[4 * 264] = (bf16)(vw.z & 0xffffu); vt[5 * 264] = (bf16)(vw.z >> 16); vt[6 * 264] = (bf16)(vw.w & 0xffffu); vt[7 * 264] = (bf16)(vw.w >> 16);
    }
    { const int g = tid >> 7, dist = tid & 127; int bucket = dist;
      if (dist >= 16) { const int l = 16 + (int)(logf((float)dist * (1.0f / 16.0f)) / 2.0794415416798357f * 16.0f); bucket = l < 31 ? l : 31; }
      biasT[tid] = relb[bucket * 16 + kvh * 4 + g] * LOG2E; }
    __syncthreads();
    const int q = lane & 31, hi = lane >> 5;
    for (int pass = 0; pass < 2; ++pass) {
        const int pi = wave * 2 + pass, g = pi >> 2, qblk = pi & 3, h = kvh * 4 + g, q0 = qblk * 32;
        const bf16* qrow = Qb + (size_t)(tok0 + q0 + q) * 1024 + h * 64 + hi * 8;
        v4u qw[4]; float ss = 0.f;
#pragma unroll
        for (int ks = 0; ks < 4; ++ks) { qw[ks] = *(const v4u*)(qrow + 16 * ks);
            const float a0 = bflo(qw[ks].x), a1 = bfhi(qw[ks].x), a2 = bflo(qw[ks].y), a3 = bfhi(qw[ks].y), a4 = bflo(qw[ks].z), a5 = bfhi(qw[ks].z), a6 = bflo(qw[ks].w), a7 = bfhi(qw[ks].w);
            ss += (a0 * a0 + a1 * a1) + (a2 * a2 + a3 * a3) + (a4 * a4 + a5 * a5) + (a6 * a6 + a7 * a7); }
        ss += __shfl_xor(ss, 32);
        const float rs = (1.0f / sqrtf(ss * (1.0f / 64.0f) + EPS)) * (0.125f * LOG2E);
        bf16x8 qf[4];
#pragma unroll
        for (int ks = 0; ks < 4; ++ks) { const f32x4 g0 = *(const f32x4*)(qg + 16 * ks + 8 * hi) * rs, g1 = *(const f32x4*)(qg + 16 * ks + 8 * hi + 4) * rs;
            v4u o; o.x = pk2(bflo(qw[ks].x) * g0.x, bfhi(qw[ks].x) * g0.y); o.y = pk2(bflo(qw[ks].y) * g0.z, bfhi(qw[ks].y) * g0.w);
            o.z = pk2(bflo(qw[ks].z) * g1.x, bfhi(qw[ks].z) * g1.y); o.w = pk2(bflo(qw[ks].w) * g1.z, bfhi(qw[ks].w) * g1.w);
            qf[ks] = __builtin_bit_cast(bf16x8, o); }
        f32x16 s[5];
#pragma unroll
        for (int tt = 0; tt < 5; ++tt) {
            s[tt] = (f32x16){0.f, 0.f, 0.f, 0.f, 0.f, 0.f, 0.f, 0.f, 0.f, 0.f, 0.f, 0.f, 0.f, 0.f, 0.f, 0.f};
            const LAS bf16* kp = Ks + (32 * (qblk + tt) + q) * 72 + 8 * hi;
#pragma unroll
            for (int ks = 0; ks < 4; ++ks) { const bf16x8 a = *(const LAS bf16x8*)(kp + 16 * ks); s[tt] = __builtin_amdgcn_mfma_f32_32x32x16_bf16(a, qf[ks], s[tt], 0, 0, 0); }
        }
        const float sk = sinks[h] * LOG2E;
        float mx = sk;
        const LAS float* bt = biasT + g * 128;
#pragma unroll
        for (int tt = 0; tt < 5; ++tt)
#pragma unroll
            for (int r = 0; r < 16; ++r) { const int dist = q + 128 - 32 * tt - crow(r, hi);
                const bool valid = (dist >= 0) && (dist < 128) && ((nb > 0) || (qblk + tt >= 4));
                float v = s[tt][r] + bt[dist & 127]; v = valid ? v : -INFINITY; s[tt][r] = v; mx = fmaxf(mx, v); }
        mx = fmaxf(mx, __shfl_xor(mx, 32));
        float l = 0.f;
#pragma unroll
        for (int tt = 0; tt < 5; ++tt)
#pragma unroll
            for (int r = 0; r < 16; ++r) { const float p = __builtin_amdgcn_exp2f(s[tt][r] - mx); s[tt][r] = p; l += p; }
        l += __shfl_xor(l, 32); l += __builtin_amdgcn_exp2f(sk - mx);
        f32x16 o[2];
        o[0] = (f32x16){0.f, 0.f, 0.f, 0.f, 0.f, 0.f, 0.f, 0.f, 0.f, 0.f, 0.f, 0.f, 0.f, 0.f, 0.f, 0.f}; o[1] = o[0];
#pragma unroll
        for (int tt = 0; tt < 5; ++tt)
#pragma unroll
            for (int s2 = 0; s2 < 2; ++s2) {
                v4u pw; pw.x = pk2(s[tt][8 * s2 + 0], s[tt][8 * s2 + 1]); pw.y = pk2(s[tt][8 * s2 + 2], s[tt][8 * s2 + 3]); pw.z = pk2(s[tt][8 * s2 + 4], s[tt][8 * s2 + 5]); pw.w = pk2(s[tt][8 * s2 + 6], s[tt][8 * s2 + 7]);
                const bf16x8 pa = __builtin_bit_cast(bf16x8, pw);
#pragma unroll
                for (int dt = 0; dt < 2; ++dt) { const LAS bf16* vp = Vt + (32 * dt + q) * 264 + 32 * (qblk + tt) + 16 * s2 + 4 * hi;
                    const s16x4 lo = *(const LAS s16x4*)vp, hh = *(const LAS s16x4*)(vp + 8);
                    const bf16x8 vb = (bf16x8){lo[0], lo[1], lo[2], lo[3], hh[0], hh[1], hh[2], hh[3]};
                    o[dt] = __builtin_amdgcn_mfma_f32_32x32x16_bf16(pa, vb, o[dt], 0, 0, 0); }
            }
        if (hi == 0) lscr[q] = 1.0f / l;
        LDS_WAIT();
        bf16* orow = A2 + (size_t)(tok0 + q0) * 2048 + h * 64 + q;
#pragma unroll
        for (int r = 0; r < 16; ++r) { const int cr = crow(r, hi); const float li = lscr[cr];
            orow[(size_t)cr * 2048] = (bf16)f2bf(o[0][r] * li); orow[(size_t)cr * 2048 + 32] = (bf16)f2bf(o[1][r] * li); }
        LDS_WAIT();
    }
}
__device__ __forceinline__ void conv_unit(int unit, const bf16* U, bf16* A2, const float* cw, const float* cb, const float* lg, const float* lb, LAS unsigned char* lds, int tid, int lane, int wave) {
    const int b = unit >> 6, t0 = (unit & 63) * 32;
    LAS unsigned* Us = (LAS unsigned*)lds;
    LAS float* red = (LAS float*)(lds + 126976);
    const __amdgpu_buffer_rsrc_t ursrc = __builtin_amdgcn_make_buffer_rsrc((void*)(U + (size_t)b * SEQ * 1024), 0, SEQ * 1024 * 2, 0x00020000);
    {   const int rr0 = tid >> 7, cc = tid & 127;
#pragma unroll 4
        for (int i = 0; i < 16; ++i) { const int rr = rr0 + 4 * i, t = t0 - 30 + rr;
            if (rr < 62) { const unsigned voff = t >= 0 ? (unsigned)(t * 2048 + cc * 16) : 0xfffffff0u;
                const v4u w = __builtin_amdgcn_raw_buffer_load_b128(ursrc, voff, 0, 0);
                *(LAS v4u*)(Us + rr * 512 + cc * 4) = w; } } }
    const __amdgpu_buffer_rsrc_t wrsrc = __builtin_amdgcn_make_buffer_rsrc((void*)cw, 0, 31 * 1024 * 4, 0x00020000);
    float w0[31], w1[31];
#pragma unroll
    for (int j = 0; j < 31; ++j) { const v2u ww = __builtin_amdgcn_raw_buffer_load_b64(wrsrc, tid * 8, j * 4096, 0); w0[j] = __uint_as_float(ww.x); w1[j] = __uint_as_float(ww.y); }
    const f32x2 bb = *(const f32x2*)(cb + 2 * tid), gg = *(const f32x2*)(lg + 2 * tid), be = *(const f32x2*)(lb + 2 * tid);
    __syncthreads();
#pragma unroll 1
    for (int cq = 0; cq < 4; ++cq) {
        float a0[8], a1[8];
#pragma unroll
        for (int i = 0; i < 8; ++i) { a0[i] = bb.x; a1[i] = bb.y; }
        const LAS unsigned* up = Us + (8 * cq) * 512 + tid;
        unsigned un0 = up[0], un1 = up[512];
#pragma unroll
        for (int r = 0; r < 38; ++r) { const unsigned uu = un0; un0 = un1; if (r + 2 < 38) un1 = up[(r + 2) * 512];
            const float u0 = bflo(uu), u1 = bfhi(uu);
#pragma unroll
            for (int i = 0; i < 8; ++i) { const int j = r - i; if (j >= 0 && j <= 30) { a0[i] += u0 * w0[j]; a1[i] += u1 * w1[j]; } }
            __builtin_amdgcn_sched_barrier(0); }
#pragma unroll
        for (int i = 0; i < 8; ++i) { const float s1 = wave_sum(a0[i] + a1[i]), s2 = wave_sum(a0[i] * a0[i] + a1[i] * a1[i]);
            if (lane == 0) { red[((cq * 8 + wave) * 8 + i) * 2] = s1; red[((cq * 8 + wave) * 8 + i) * 2 + 1] = s2; } }
        __syncthreads();
#pragma unroll
        for (int i = 0; i < 8; ++i) { float t1 = 0.f, t2 = 0.f;
#pragma unroll
            for (int w = 0; w < 8; ++w) { t1 += red[((cq * 8 + w) * 8 + i) * 2]; t2 += red[((cq * 8 + w) * 8 + i) * 2 + 1]; }
            const float mean = t1 * (1.0f / 1024.0f), var = t2 * (1.0f / 1024.0f) - mean * mean, rstd = 1.0f / sqrtf(var + EPS);
            float y0 = (a0[i] - mean) * rstd * gg.x + be.x, y1 = (a1[i] - mean) * rstd * gg.y + be.y;
            y0 *= sigm(y0); y1 *= sigm(y1);
            *(GAS unsigned*)(A2 + (size_t)(b * SEQ + t0 + 8 * cq + i) * 2048 + 1024 + 2 * tid) = pk2(y0, y1); }
    }
}

struct Args { const float* in[20]; float* out; unsigned char* ws; int ph_lo, ph_hi; };
__global__ void __launch_bounds__(NWAVES * 64, 2) fwd_kernel(Args args) {
    extern __shared__ __attribute__((aligned(16))) unsigned char lds_raw[];
    LAS unsigned char* lds = (LAS unsigned char*)lds_raw;
    volatile LAS unsigned* MISC = (volatile LAS unsigned*)(lds + MISC_OFF);
    const int tid = threadIdx.x, lane = tid & 63, wave = __builtin_amdgcn_readfirstlane(tid >> 6);
    const int G = gridDim.x, bx = blockIdx.x;
    const int vcu = (G % 8 == 0) ? (bx % 8) * (G / 8) + bx / 8 : bx;
    const int gw = vcu * NWAVES + wave, NGW = G * NWAVES;
#define P_ws (args.ws)
#define P_x (args.in[0])
#define P_c_in (args.in[1])
#define P_w_ada (args.in[2])
#define P_b_ada (args.in[3])
#define P_norm_mix_g (args.in[4])
#define P_w_in (args.in[5])
#define P_q_norm_g (args.in[6])
#define P_k_norm_g (args.in[7])
#define P_attn_sinks (args.in[8])
#define P_rel_bias (args.in[9])
#define P_w_attn_out (args.in[10])
#define P_conv_w (args.in[11])
#define P_conv_b (args.in[12])
#define P_conv_ln_g (args.in[13])
#define P_conv_ln_b (args.in[14])
#define P_w_conv_out (args.in[15])
#define P_w_mix_out (args.in[16])
#define P_norm_ffn_g (args.in[17])
#define P_w_ffn_in (args.in[18])
#define P_w_ffn_out (args.in[19])
#define P_out (args.out)
#define P_MOD ((float*)(P_ws + WS_MOD))
#define P_W1T ((bf16*)(P_ws + WS_W1T))
#define P_W2T ((bf16*)(P_ws + WS_W2T))
#define P_W3T ((bf16*)(P_ws + WS_W3T))
#define P_W4T ((bf16*)(P_ws + WS_W4T))
#define P_W5T ((bf16*)(P_ws + WS_W5T))
#define P_H ((bf16*)(P_ws + WS_H))
#define P_Qb ((bf16*)(P_ws + WS_Q))
#define P_Kb ((bf16*)(P_ws + WS_K))
#define P_Vb ((bf16*)(P_ws + WS_V))
#define P_Ub ((bf16*)(P_ws + WS_U))
#define P_Rb ((bf16*)(P_ws + WS_R))
#define P_GCb ((bf16*)(P_ws + WS_GC))
#define P_A2 ((bf16*)(P_ws + WS_A2))
#define P_MG ((bf16*)(P_ws + WS_MG))
#define P_HF ((bf16*)(P_ws + WS_HF))

    for (int u = tid; u < (LDS_BYTES - LDSCTL_OFF) / 4; u += NWAVES * 64) ((LAS unsigned*)(lds + LDSCTL_OFF))[u] = 0u;
    __syncthreads();
    const int lo = args.ph_lo, hi = args.ph_hi;
#if !MK_CG_SYNC
    XcdBarrier bar; bar.bar = (unsigned*)(P_ws + WS_CTL) + CW_BAR; bar.x = 0; bar.st = nullptr;
    if (hi - lo > 1) bar = xcd_barrier_post((unsigned*)(P_ws + WS_CTL) + CW_BAR, MISC + 8);
    if (lo < 0) cg::this_grid().sync();
#else
    (void)MISC;
#endif
#ifdef PHASE_MASK
#define IN(k) (((PHASE_MASK >> (k)) & 1) && lo <= (k) && (k) < hi)
#else
#define IN(k) (lo <= (k) && (k) < hi)
#endif
#define BOTH(k) (IN(k) && IN((k) + 1))
#ifndef REPEAT_MASK
#define REPEAT_MASK 0
#endif
#if MK_CG_SYNC
#define GRID_BAR(k) do { if (BOTH(k)) cg::this_grid().sync(); } while (0)
#else
#define GRID_BAR(k) do { if (BOTH(k)) xcd_barrier(bar); } while (0)
#endif

    if (IN(0)) {
        p0_adaln(P_c_in, P_w_ada, P_b_ada, P_MOD, (LAS float*)lds, tid, lane, wave);
        LAS float* scr = (LAS float*)(lds + wave * 16384);
        constexpr int I0 = 32 * 240, I1 = 16 * 64, I2 = 16 * 64, I3 = 32 * 64, I4 = 32 * 352;
        transpose_matrix<1>(P_w_in, DM, N1, P_W1T, 2048, 0, 0, scr, gw, NGW, lane);
        transpose_matrix<0>(P_w_attn_out, 1024, DM, P_W2T, 2048, 0, I0, scr, gw, NGW, lane);
        transpose_matrix<0>(P_w_conv_out, 1024, DM, P_W2T, 2048, 1024, I0 + I1, scr, gw, NGW, lane);
        transpose_matrix<0>(P_w_mix_out, DM, DM, P_W3T, 2048, 0, I0 + I1 + I2, scr, gw, NGW, lane);
        transpose_matrix<2>(P_w_ffn_in, DM, N4, P_W4T, 2048, 0, I0 + I1 + I2 + I3, scr, gw, NGW, lane);
        transpose_matrix<0>(P_w_ffn_out, DFF, DM, P_W5T, DFF, 0, I0 + I1 + I2 + I3 + I4, scr, gw, NGW, lane);
        GRID_BAR(0);
    }
    if (IN(1)) { modnorm_phase(P_x, P_norm_mix_g, P_MOD, 0, DM, P_H, gw, NGW, lane); GRID_BAR(1); }
    if (IN(2)) {
        pg8::Gemm g{P_H, P_W1T, MT, N1, DM}; pg8::StaticOrder S; S.init(MT, N1, G, bx);
        pg8::Epi1 E{P_Qb, P_Ub, P_Rb, P_GCb};
        pg8::gemm_phase<pg8::Epi1, pg8::StaticOrder, true, true>(lds, g, S, E);
        GRID_BAR(2);
    }
#if (REPEAT_MASK >> 2) & 1
    if (IN(2)) {
        pg8::Gemm g{P_H, P_W1T, MT, N1, DM}; pg8::StaticOrder S; S.init(MT, N1, G, bx);
        pg8::Epi1 E{P_Qb, P_Ub, P_Rb, P_GCb};
        pg8::gemm_phase<pg8::Epi1, pg8::StaticOrder, true, true>(lds, g, S, E);
        GRID_BAR(2);
    }
#endif
    if (IN(3)) {
#ifndef NO_ATTN
        for (int u = bx; u < 256; u += G) { attn_unit(u, P_Qb, P_Kb, P_Vb, P_A2, P_q_norm_g, P_k_norm_g, P_attn_sinks, P_rel_bias, lds, tid, lane, wave); __syncthreads(); }
#endif
#ifndef NO_CONV
        for (int u = bx; u < 256; u += G) { conv_unit(u, P_Ub, P_A2, P_conv_w, P_conv_b, P_conv_ln_g, P_conv_ln_b, lds, tid, lane, wave); __syncthreads(); }
#endif
        GRID_BAR(3);
    }
#if (REPEAT_MASK >> 3) & 1
    if (IN(3)) {
#ifndef NO_ATTN
        for (int u = bx; u < 256; u += G) { attn_unit(u, P_Qb, P_Kb, P_Vb, P_A2, P_q_norm_g, P_k_norm_g, P_attn_sinks, P_rel_bias, lds, tid, lane, wave); __syncthreads(); }
#endif
#ifndef NO_CONV
        for (int u = bx; u < 256; u += G) { conv_unit(u, P_Ub, P_A2, P_conv_w, P_conv_b, P_conv_ln_g, P_conv_ln_b, lds, tid, lane, wave); __syncthreads(); }
#endif
        GRID_BAR(3);
    }
#endif
    if (IN(4)) {
        pg8::Gemm g{P_A2, P_W2T, MT, DM, DM}; pg8::StaticOrder S; S.init(MT, DM, G, bx);
        pg8::Epi2 E{P_Rb, P_GCb, P_MG};
        pg8::gemm_phase<pg8::Epi2, pg8::StaticOrder, true, true>(lds, g, S, E);
        GRID_BAR(4);
    }
#if (REPEAT_MASK >> 4) & 1
    if (IN(4)) {
        pg8::Gemm g{P_A2, P_W2T, MT, DM, DM}; pg8::StaticOrder S; S.init(MT, DM, G, bx);
        pg8::Epi2 E{P_Rb, P_GCb, P_MG};
        pg8::gemm_phase<pg8::Epi2, pg8::StaticOrder, true, true>(lds, g, S, E);
        GRID_BAR(4);
    }
#endif
    if (IN(5)) {
        pg8::Gemm g{P_MG, P_W3T, MT, DM, DM}; pg8::StaticOrder S; S.init(MT, DM, G, bx);
        pg8::EpiRes E{P_x, P_out, P_MOD + 2 * DM};
        pg8::gemm_phase<pg8::EpiRes, pg8::StaticOrder, true, true>(lds, g, S, E);
        GRID_BAR(5);
    }
#if (REPEAT_MASK >> 5) & 1
    if (IN(5)) {
        pg8::Gemm g{P_MG, P_W3T, MT, DM, DM}; pg8::StaticOrder S; S.init(MT, DM, G, bx);
        pg8::EpiRes E{P_x, P_out, P_MOD + 2 * DM};
        pg8::gemm_phase<pg8::EpiRes, pg8::StaticOrder, true, true>(lds, g, S, E);
        GRID_BAR(5);
    }
#endif
    if (IN(6)) { modnorm_phase(P_out, P_norm_ffn_g, P_MOD, 3 * DM, 4 * DM, P_H, gw, NGW, lane); GRID_BAR(6); }
    if (IN(7)) {
        pg8::Gemm g{P_H, P_W4T, MT, N4, DM}; pg8::StaticOrder S; S.init(MT, N4, G, bx);
        pg8::Epi4 E{P_HF};
        pg8::gemm_phase<pg8::Epi4, pg8::StaticOrder, true, true>(lds, g, S, E);
        GRID_BAR(7);
    }
#if (REPEAT_MASK >> 7) & 1
    if (IN(7)) {
        pg8::Gemm g{P_H, P_W4T, MT, N4, DM}; pg8::StaticOrder S; S.init(MT, N4, G, bx);
        pg8::Epi4 E{P_HF};
        pg8::gemm_phase<pg8::Epi4, pg8::StaticOrder, true, true>(lds, g, S, E);
        GRID_BAR(7);
    }
#endif
    if (IN(8)) {
        pg8::Gemm g{P_HF, P_W5T, MT, DM, DFF}; pg8::StaticOrder S; S.init(MT, DM, G, bx);
        pg8::EpiRes E{P_out, P_out, P_MOD + 5 * DM};
        pg8::gemm_phase<pg8::EpiRes, pg8::StaticOrder, true, true>(lds, g, S, E);
    }
#undef IN
#undef BOTH
#undef GRID_BAR
}
#undef P_ws
#undef P_x
#undef P_c_in
#undef P_w_ada
#undef P_b_ada
#undef P_norm_mix_g
#undef P_w_in
#undef P_q_norm_g
#undef P_k_norm_g
#undef P_attn_sinks
#undef P_rel_bias
#undef P_w_attn_out
#undef P_conv_w
#undef P_conv_b
#undef P_conv_ln_g
#undef P_conv_ln_b
#undef P_w_conv_out
#undef P_w_mix_out
#undef P_norm_ffn_g
#undef P_w_ffn_in
#undef P_w_ffn_out
#undef P_out
#undef P_MOD
#undef P_W1T
#undef P_W2T
#undef P_W3T
#undef P_W4T
#undef P_W5T
#undef P_H
#undef P_Qb
#undef P_Kb
#undef P_Vb
#undef P_Ub
#undef P_Rb
#undef P_GCb
#undef P_A2
#undef P_MG
#undef P_HF

extern "C" void kernel_launch(void* const* d_in, const int* in_sizes, int n_in, void* d_out, int out_size, void* d_ws, size_t ws_size, hipStream_t stream) {
    static int grid = 0;
    if (grid == 0) {
        if (n_in != 20 || in_sizes[0] != MT * DM || out_size != MT * DM || ws_size < WS_END) {
            fprintf(stderr, "kernel_launch: shape/workspace mismatch (n_in %d, in0 %d, out %d, ws %zu, need %zu); nothing launched\n", n_in, n_in > 0 ? in_sizes[0] : -1, out_size, ws_size, (size_t)WS_END); grid = -1; return; }
        int dev = 0, cus = 0, per_cu = 0;
        if (hipGetDevice(&dev) != hipSuccess || hipDeviceGetAttribute(&cus, hipDeviceAttributeMultiprocessorCount, dev) != hipSuccess) { fprintf(stderr, "kernel_launch: device query failed\n"); grid = -1; return; }
        if (hipFuncSetAttribute((const void*)fwd_kernel, hipFuncAttributeMaxDynamicSharedMemorySize, LDS_BYTES) != hipSuccess) { fprintf(stderr, "kernel_launch: hipFuncSetAttribute failed\n"); grid = -1; return; }
        if (hipOccupancyMaxActiveBlocksPerMultiprocessor(&per_cu, (const void*)fwd_kernel, NWAVES * 64, LDS_BYTES) != hipSuccess || per_cu < 1) { fprintf(stderr, "kernel_launch: occupancy query says %d blocks per CU\n", per_cu); per_cu = 1; }
        (void)hipGetLastError();
        grid = cus * (per_cu < 1 ? 1 : 1);
        if (grid != 256) fprintf(stderr, "kernel_launch: note: grid = %d workgroups\n", grid);
    }
    if (grid < 0) return;
    if (hipMemsetAsync((char*)d_ws + WS_CTL, 0, CTL_ZERO_BYTES, stream) != hipSuccess) { fprintf(stderr, "kernel_launch: memset failed\n"); return; }
    Args a{};
    for (int i = 0; i < 20; ++i) a.in[i] = (const float*)d_in[i];
    a.out = (float*)d_out; a.ws = (unsigned char*)d_ws;
#if MK_PER_PHASE
    for (int ph = 0; ph < N_PHASES; ++ph) { a.ph_lo = ph; a.ph_hi = ph + 1; hipLaunchKernelGGL(fwd_kernel, dim3(grid), dim3(NWAVES * 64), LDS_BYTES, stream, a); }
#else
    a.ph_lo = 0; a.ph_hi = N_PHASES;
    void* kargs[] = {(void*)&a};
    const hipError_t e = hipLaunchCooperativeKernel((const void*)fwd_kernel, dim3(grid), dim3(NWAVES * 64), kargs, LDS_BYTES, stream);
    if (e != hipSuccess) fprintf(stderr, "kernel_launch: cooperative launch failed: %s (grid %d)\n", hipGetErrorString(e), grid);
#endif
}
```

```cpp
#include <hip/hip_runtime.h>
#include <hip/hip_cooperative_groups.h>
#include <cstdio>
#include <cstdint>
namespace cg = cooperative_groups;

#ifndef MK_PER_PHASE
#define MK_PER_PHASE 0
#endif
#ifndef MK_CG_SYNC
#define MK_CG_SYNC 0
#endif

namespace pg8 {
#define PG8_LAS __attribute__((address_space(3)))
typedef unsigned short bf16_t;
typedef short bf16x8 __attribute__((ext_vector_type(8)));
typedef float f32x4 __attribute__((ext_vector_type(4)));
typedef unsigned u32x4 __attribute__((ext_vector_type(4)));
constexpr int BM = 256, BK = 64, HALF = 128, HTB = HALF * BK * 2  , STAGE_BYTES = 8 * HTB, NXCD = 8, WGM = 8;

__host__ __device__ __forceinline__ int lds_byte(int r, int c) { const int st = (r >> 4) * 2 + (c >> 5), rr = r & 15, cc = c & 31, ob = rr * 64 + cc * 2; return st * 1024 + (ob ^ (((ob >> 9) & 1) << 5)); }
__host__ __device__ __forceinline__ void stage_rc(int b, int& R, int& C) { const int st = b / 1024, sb = b % 1024, swz = sb ^ (((sb >> 9) & 1) << 5); R = (st >> 1) * 16 + swz / 64; C = (st & 1) * 32 + (swz % 64) / 2; }
__host__ __device__ __forceinline__ int perm32(int rho) { const int n = rho >> 4, i = rho & 15; return 8 * (i >> 2) + 4 * n + (i & 3); }

struct Unit { int pm, pn; };
struct Gemm { const bf16_t* A; const bf16_t* Bt; int M, N, K; };

struct StaticOrder {
    int nM, nN, nwg, G, c;
    __host__ __device__ void init(int M, int N, int G_, int c_) { nM = M / BM; nN = N / BM; nwg = nM * nN; G = G_; c = c_; }
    __host__ __device__ bool next(int i, Unit& u) const {
        const long L = (long)i * G + c; if (L >= nwg) return false;
        int wgid = (int)L; { const int q = nwg / NXCD, r = nwg % NXCD, xcd = wgid % NXCD, off = wgid / NXCD; wgid = (xcd < r ? xcd * (q + 1) : r * (q + 1) + (xcd - r) * q) + off; }
        const int nig = WGM * nN, gid = wgid / nig, fm = gid * WGM, gsz = (nM - fm) < WGM ? (nM - fm) : WGM;
        u.pm = fm + ((wgid % nig) % gsz); u.pn = (wgid % nig) / gsz; return true;
    }
    __device__ __forceinline__ void a_ready(const Unit&) const {}
    __device__ __forceinline__ void done(const Unit&) const {}
};


__device__ __forceinline__ unsigned cvt_pk_bf16(float lo, float hi) { unsigned r; asm volatile("v_cvt_pk_bf16_f32 %0, %1, %2" : "=v"(r) : "v"(lo), "v"(hi)); return r; }
__device__ __forceinline__ float sigm(float x) { return __builtin_amdgcn_rcpf(1.0f + __builtin_amdgcn_exp2f(-1.4426950408889634f * x)); }
__device__ __forceinline__ u32x4 pack8(const f32x4& v0, const f32x4& v1) { u32x4 w; w.x = cvt_pk_bf16(v0[0], v0[1]); w.y = cvt_pk_bf16(v0[2], v0[3]); w.z = cvt_pk_bf16(v1[0], v1[1]); w.w = cvt_pk_bf16(v1[2], v1[3]); return w; }
__device__ __forceinline__ void unpack8(const u32x4& w, f32x4& v0, f32x4& v1) {
    v0[0] = __uint_as_float(w.x << 16); v0[1] = __uint_as_float(w.x & 0xffff0000u); v0[2] = __uint_as_float(w.y << 16); v0[3] = __uint_as_float(w.y & 0xffff0000u);
    v1[0] = __uint_as_float(w.z << 16); v1[1] = __uint_as_float(w.z & 0xffff0000u); v1[2] = __uint_as_float(w.w << 16); v1[3] = __uint_as_float(w.w & 0xffff0000u); }

struct Epi1 {
    static constexpr bool PERM = true, AFTER_DRAIN = false, MID = false;
    bf16_t *Q, *U, *R, *GC;
    __device__ __forceinline__ void mid(f32x4 (&)[2][2][4][2], const Unit&, int, int, int, int) const {}
    __device__ __forceinline__ void operator()(const f32x4 (&acc)[2][2][4][2], const Unit& u, int wr, int wc, int fr, int fq) const {
        const int row0 = u.pm * BM + wr * 64 + fr, cl = wc * 32 + 8 * fq;
        if (u.pn < 6) {
            const size_t boff = u.pn < 4 ? (size_t)0 : (u.pn == 4 ? (size_t)8388608 : (size_t)10485760);
            bf16_t* base = Q + boff; const int ld = u.pn < 4 ? 1024 : 256, c0 = u.pn < 4 ? u.pn * 256 : 0;
#pragma unroll
            for (int ai = 0; ai < 2; ++ai)
#pragma unroll
                for (int m = 0; m < 4; ++m) { bf16_t* rowp = base + (size_t)(row0 + ai * HALF + m * 16) * ld + c0 + cl;
#pragma unroll
                    for (int bj = 0; bj < 2; ++bj) *(u32x4*)(rowp + bj * HALF) = pack8(acc[ai][bj][m][0], acc[ai][bj][m][1]); }
        } else if (u.pn < 14) {
            const int c0 = (u.pn - 6) * 128 + cl;
#pragma unroll
            for (int ai = 0; ai < 2; ++ai)
#pragma unroll
                for (int m = 0; m < 4; ++m) { f32x4 o[2];
#pragma unroll
                    for (int n = 0; n < 2; ++n)
#pragma unroll
                        for (int e = 0; e < 4; ++e) o[n][e] = acc[ai][0][m][n][e] * sigm(acc[ai][1][m][n][e]);
                    *(u32x4*)(U + (size_t)(row0 + ai * HALF + m * 16) * 1024 + c0) = pack8(o[0], o[1]); }
        } else {
            const int c0 = (u.pn - 14) * 128 + cl;
#pragma unroll
            for (int ai = 0; ai < 2; ++ai)
#pragma unroll
                for (int m = 0; m < 4; ++m) { f32x4 r[2], g[2];
#pragma unroll
                    for (int n = 0; n < 2; ++n)
#pragma unroll
                        for (int e = 0; e < 4; ++e) { const float ea = __builtin_amdgcn_exp2f(-1.4426950408889634f * acc[ai][0][m][n][e]), ec = __builtin_amdgcn_exp2f(-1.4426950408889634f * acc[ai][1][m][n][e]);
                            g[n][e] = __builtin_amdgcn_rcpf(1.0f + ec); r[n][e] = (1.0f + ec) * __builtin_amdgcn_rcpf(1.0f + ea); }
                    const size_t off = (size_t)(row0 + ai * HALF + m * 16) * 2048 + c0;
                    *(u32x4*)(R + off) = pack8(r[0], r[1]); *(u32x4*)(GC + off) = pack8(g[0], g[1]); }
        }
    }
};
struct Epi2 {
    static constexpr bool PERM = true, AFTER_DRAIN = false, MID = true;
    const bf16_t *R, *GC; bf16_t* O;
    __device__ __forceinline__ void mid(f32x4 (&acc)[2][2][4][2], const Unit& u, int wr, int wc, int fr, int fq) const {
        asm volatile("" : "+v"(fr), "+v"(fq));
        const int row0 = u.pm * BM + wr * 64 + fr, col0 = u.pn * BM + wc * 32 + 8 * fq;
#pragma unroll
        for (int ai = 0; ai < 2; ++ai)
#pragma unroll
            for (int m = 0; m < 4; ++m) { const bf16_t* rowp = R + (size_t)(row0 + ai * HALF + m * 16) * 2048 + col0;
#pragma unroll
                for (int bj = 0; bj < 2; ++bj) { const u32x4 w = *(const u32x4*)(rowp + bj * HALF); f32x4 s0, s1; unpack8(w, s0, s1); acc[ai][bj][m][0] *= s0; acc[ai][bj][m][1] *= s1; }
                if (m & 1) asm volatile("" ::: "memory"); }
    }
    __device__ __forceinline__ void operator()(const f32x4 (&acc)[2][2][4][2], const Unit& u, int wr, int wc, int fr, int fq) const {
        const int row0 = u.pm * BM + wr * 64 + fr, col0 = u.pn * BM + wc * 32 + 8 * fq;
#pragma unroll
        for (int ai = 0; ai < 2; ++ai)
#pragma unroll
            for (int m = 0; m < 4; ++m) { const size_t off = (size_t)(row0 + ai * HALF + m * 16) * 2048 + col0;
#pragma unroll
                for (int bj = 0; bj < 2; ++bj) { const u32x4 w = *(const u32x4*)(GC + off + bj * HALF); f32x4 s0, s1; unpack8(w, s0, s1);
                    *(u32x4*)(O + off + bj * HALF) = pack8(acc[ai][bj][m][0] * s0, acc[ai][bj][m][1] * s1); }
                if (m & 1) asm volatile("" ::: "memory"); }
    }
};
struct EpiRes {
    static constexpr bool PERM = false, AFTER_DRAIN = false, MID = false;
    const float* base; float* out; const float* gate;
    __device__ __forceinline__ void mid(f32x4 (&)[2][2][4][2], const Unit&, int, int, int, int) const {}
    __device__ __forceinline__ void operator()(const f32x4 (&acc)[2][2][4][2], const Unit& u, int wr, int wc, int fr, int fq) const {
        const int row0 = u.pm * BM + wr * 64 + fr, col0 = u.pn * BM + wc * 32 + 4 * fq;
        const float* gp = gate + (size_t)(u.pm >> 3) * 12288 + col0;
        f32x4 gv[2][2];
#pragma unroll
        for (int bj = 0; bj < 2; ++bj)
#pragma unroll
            for (int n = 0; n < 2; ++n) gv[bj][n] = *(const f32x4*)(gp + bj * HALF + n * 16);
#pragma unroll
        for (int ai = 0; ai < 2; ++ai)
#pragma unroll
            for (int m = 0; m < 4; ++m) { const size_t off = (size_t)(row0 + ai * HALF + m * 16) * 2048 + col0;
#pragma unroll
                for (int bj = 0; bj < 2; ++bj)
#pragma unroll
                    for (int n = 0; n < 2; ++n) { const f32x4 b = *(const f32x4*)(base + off + bj * HALF + n * 16); *(f32x4*)(out + off + bj * HALF + n * 16) = b + gv[bj][n] * acc[ai][bj][m][n]; } }
    }
};
struct Epi4 {
    static constexpr bool PERM = true, AFTER_DRAIN = false, MID = false;
    bf16_t* HF;
    __device__ __forceinline__ void mid(f32x4 (&)[2][2][4][2], const Unit&, int, int, int, int) const {}
    __device__ __forceinline__ void operator()(const f32x4 (&acc)[2][2][4][2], const Unit& u, int wr, int wc, int fr, int fq) const {
        const int row0 = u.pm * BM + wr * 64 + fr, c0 = u.pn * 128 + wc * 32 + 8 * fq;
#pragma unroll
        for (int ai = 0; ai < 2; ++ai)
#pragma unroll
            for (int m = 0; m < 4; ++m) { f32x4 o[2];
#pragma unroll
                for (int n = 0; n < 2; ++n)
#pragma unroll
                    for (int e = 0; e < 4; ++e) { const float g = acc[ai][0][m][n][e]; o[n][e] = g * sigm(g) * acc[ai][1][m][n][e]; }
                *(u32x4*)(HF + (size_t)(row0 + ai * HALF + m * 16) * 5632 + c0) = pack8(o[0], o[1]); }
    }
};

template <class Epi, class Sched, bool ALIGN_EPI = false, bool SP2 = false>
__device__ __forceinline__ void gemm_phase(PG8_LAS unsigned char* lds, const Gemm g, const Sched& S, const Epi& E) {
    const int tid = threadIdx.x, wid = __builtin_amdgcn_readfirstlane(tid >> 6), lane = tid & 63, wr = wid >> 2, wc = wid & 3, fr = lane & 15, fq = lane >> 4;
    const int K = g.K, nt = K / BK;
    unsigned voffA[2], voffB[2];
#pragma unroll
    for (int i = 0; i < 2; ++i) { int R, C; stage_rc(tid * 16 + i * 8192, R, C); const int Rb = Epi::PERM ? ((R & ~31) + perm32(R & 31)) : R;
        voffA[i] = (unsigned)(R * K + C) * 2u; voffB[i] = (unsigned)(Rb * K + C) * 2u; }
    const size_t kstep = (size_t)(BK * 2);
    const size_t hstep = (size_t)HALF * K * 2;
    const size_t tstep = 2 * hstep;
    const unsigned ldsw = (unsigned)wid * 1024u;
    const int aoff = lds_byte(wr * 64 + fr, fq * 8), boff = lds_byte(wc * 32 + fr, fq * 8);
#define PG8_SA(b, h) (((b) * 2 + (h)) * HTB)
#define PG8_SB(b, h) ((4 + (b) * 2 + (h)) * HTB)
#define PG8_STAGE(bufoff, gbase, voff) do { _Pragma("unroll") for (int _i = 0; _i < 2; ++_i) \
        __builtin_amdgcn_global_load_lds((const unsigned*)((const char*)(gbase) + (voff)[_i]), (PG8_LAS unsigned*)(lds + (bufoff) + ldsw + _i * 8192), 16, 0, 0); } while (0)
#define PG8_LDA(dst, b, h) do { _Pragma("unroll") for (int m = 0; m < 4; ++m) _Pragma("unroll") for (int k = 0; k < 2; ++k) dst[m][k] = *(const PG8_LAS bf16x8*)(lds + PG8_SA(b, h) + aoff + m * 2048 + k * 1024); } while (0)
#define PG8_LDB(dst, b, h) do { _Pragma("unroll") for (int n = 0; n < 2; ++n) _Pragma("unroll") for (int k = 0; k < 2; ++k) dst[n][k] = *(const PG8_LAS bf16x8*)(lds + PG8_SB(b, h) + boff + n * 2048 + k * 1024); } while (0)
#define PG8_MMA(ai, bj, At, Bt) do { __builtin_amdgcn_s_setprio(1); _Pragma("unroll") for (int m = 0; m < 4; ++m) _Pragma("unroll") for (int n = 0; n < 2; ++n) _Pragma("unroll") for (int k = 0; k < 2; ++k) \
        acc[ai][bj][m][n] = __builtin_amdgcn_mfma_f32_16x16x32_bf16(Bt[n][k], At[m][k], acc[ai][bj][m][n], 0, 0, 0); __builtin_amdgcn_s_setprio(0); } while (0)
#define PG8_WAIT_V(n) asm volatile("s_waitcnt vmcnt(" #n ")" ::: "memory")
#define PG8_WAIT_L(n) asm volatile("s_waitcnt lgkmcnt(" #n ")" ::: "memory")
#define PG8_BAR __builtin_amdgcn_s_barrier()
#define PG8_SCHED __builtin_amdgcn_sched_barrier(0)
    Unit cur, nxt; int ui = 0;
    if (!S.next(0, cur)) return;
    f32x4 acc[2][2][4][2];
#pragma unroll
    for (int a = 0; a < 2; ++a)
#pragma unroll
        for (int b = 0; b < 2; ++b)
#pragma unroll
            for (int m = 0; m < 4; ++m)
#pragma unroll
                for (int n = 0; n < 2; ++n) acc[a][b][m][n] = (f32x4){0.f, 0.f, 0.f, 0.f};
    bf16x8 At[4][2], B0[2][2], B1[2][2];
    const char* cA = (const char*)g.A + (size_t)cur.pm * tstep; const char* cB = (const char*)g.Bt + (size_t)cur.pn * tstep;
    S.a_ready(cur);
    if constexpr (SP2) {
        PG8_STAGE(PG8_SB(0, 0), cB, voffB); PG8_STAGE(PG8_SB(0, 1), cB + hstep, voffB); PG8_STAGE(PG8_SA(0, 0), cA, voffA); PG8_STAGE(PG8_SA(0, 1), cA + hstep, voffA);
        if (wr == 1) PG8_BAR;
        PG8_WAIT_V(2); PG8_BAR;
        PG8_STAGE(PG8_SB(1, 0), cB + kstep, voffB); PG8_STAGE(PG8_SA(1, 0), cA + kstep, voffA); PG8_STAGE(PG8_SB(1, 1), cB + hstep + kstep, voffB);
        PG8_WAIT_V(6); PG8_BAR;
    } else {
        PG8_STAGE(PG8_SB(0, 0), cB, voffB); PG8_STAGE(PG8_SA(0, 0), cA, voffA); PG8_STAGE(PG8_SB(0, 1), cB + hstep, voffB); PG8_STAGE(PG8_SA(0, 1), cA + hstep, voffA);
        if (wr == 1) PG8_BAR;
        PG8_WAIT_V(4); PG8_BAR;
        PG8_STAGE(PG8_SB(1, 0), cB + kstep, voffB); PG8_STAGE(PG8_SA(1, 0), cA + kstep, voffA); PG8_STAGE(PG8_SB(1, 1), cB + hstep + kstep, voffB);
        PG8_WAIT_V(6); PG8_BAR;
    }
    for (;;) {
        const bool has_next = S.next(ui + 1, nxt);
        const char* nA = has_next ? (const char*)g.A + (size_t)nxt.pm * tstep : cA; const char* nB = has_next ? (const char*)g.Bt + (size_t)nxt.pn * tstep : cB;
        for (int t = 0; t < nt; t += 2) {
            const bool last = (t == nt - 2);
            const char* a1 = cA + (size_t)(t + 1) * kstep;
            const char* a2 = last ? nA : cA + (size_t)(t + 2) * kstep; const char* b2 = last ? nB : cB + (size_t)(t + 2) * kstep;
            const char* a3 = a2 + kstep; const char* b3 = b2 + kstep;
            if (last && has_next) S.a_ready(nxt);
            if constexpr (Epi::MID) { if (t == (nt >> 1)) E.mid(acc, cur, wr, wc, fr, fq); }
            if constexpr (SP2) {
            PG8_LDB(B0, 0, 0); PG8_LDB(B1, 0, 1); PG8_SCHED; PG8_LDA(At, 0, 0); PG8_STAGE(PG8_SA(1, 1), a1 + hstep, voffA);
            PG8_WAIT_V(8); PG8_WAIT_L(0); PG8_BAR; PG8_MMA(0, 0, At, B0); PG8_MMA(0, 1, At, B1); PG8_BAR; PG8_SCHED;
            PG8_LDA(At, 0, 1); PG8_STAGE(PG8_SB(0, 0), b2, voffB); PG8_STAGE(PG8_SB(0, 1), b2 + hstep, voffB); PG8_STAGE(PG8_SA(0, 0), a2, voffA);
            PG8_WAIT_V(8); PG8_WAIT_L(0); PG8_BAR; PG8_MMA(1, 0, At, B0); PG8_MMA(1, 1, At, B1); PG8_BAR; PG8_SCHED;
            PG8_LDB(B0, 1, 0); PG8_LDB(B1, 1, 1); PG8_SCHED; PG8_LDA(At, 1, 0); PG8_STAGE(PG8_SA(0, 1), a2 + hstep, voffA);
            PG8_WAIT_V(8); PG8_WAIT_L(0); PG8_BAR; PG8_MMA(0, 0, At, B0); PG8_MMA(0, 1, At, B1); PG8_BAR; PG8_SCHED;
            PG8_LDA(At, 1, 1); PG8_STAGE(PG8_SB(1, 0), b3, voffB); PG8_STAGE(PG8_SB(1, 1), b3 + hstep, voffB); PG8_STAGE(PG8_SA(1, 0), a3, voffA);
            PG8_WAIT_V(8); PG8_WAIT_L(0); PG8_BAR; PG8_MMA(1, 0, At, B0); PG8_MMA(1, 1, At, B1); PG8_BAR; PG8_SCHED;
            } else {
            PG8_LDB(B0, 0, 0); PG8_SCHED; PG8_LDA(At, 0, 0); PG8_STAGE(PG8_SA(1, 1), a1 + hstep, voffA);
            PG8_WAIT_L(8); PG8_BAR; PG8_WAIT_L(0); PG8_MMA(0, 0, At, B0); PG8_BAR; PG8_SCHED;
            PG8_LDB(B1, 0, 1); PG8_STAGE(PG8_SB(0, 0), b2, voffB);
            PG8_BAR; PG8_WAIT_L(0); PG8_MMA(0, 1, At, B1); PG8_BAR;
            PG8_LDA(At, 0, 1); PG8_STAGE(PG8_SA(0, 0), a2, voffA);
            PG8_BAR; PG8_WAIT_L(0); PG8_MMA(1, 0, At, B0); PG8_BAR; PG8_SCHED;
            PG8_STAGE(PG8_SB(0, 1), b2 + hstep, voffB);
            PG8_WAIT_V(6); PG8_BAR; PG8_MMA(1, 1, At, B1); PG8_BAR;
            PG8_LDB(B0, 1, 0); PG8_SCHED; PG8_LDA(At, 1, 0); PG8_STAGE(PG8_SA(0, 1), a2 + hstep, voffA);
            PG8_WAIT_L(8); PG8_BAR; PG8_WAIT_L(0); PG8_MMA(0, 0, At, B0); PG8_BAR; PG8_SCHED;
            PG8_LDB(B1, 1, 1); PG8_STAGE(PG8_SB(1, 0), b3, voffB);
            PG8_BAR; PG8_WAIT_L(0); PG8_MMA(0, 1, At, B1); PG8_BAR;
            PG8_LDA(At, 1, 1); PG8_STAGE(PG8_SA(1, 0), a3, voffA);
            PG8_BAR; PG8_WAIT_L(0); PG8_MMA(1, 0, At, B0); PG8_BAR; PG8_SCHED;
            PG8_STAGE(PG8_SB(1, 1), b3 + hstep, voffB);
            PG8_WAIT_V(6); PG8_BAR; PG8_MMA(1, 1, At, B1); PG8_BAR;
            }
        }
        if constexpr (ALIGN_EPI) { if (wr == 0) PG8_BAR; }
        if constexpr (!Epi::AFTER_DRAIN) { E(acc, cur, wr, wc, fr, fq); S.done(cur); }
        if (!has_next) break;
#pragma unroll
        for (int a = 0; a < 2; ++a)
#pragma unroll
            for (int b = 0; b < 2; ++b)
#pragma unroll
                for (int m = 0; m < 4; ++m)
#pragma unroll
                    for (int n = 0; n < 2; ++n) acc[a][b][m][n] = (f32x4){0.f, 0.f, 0.f, 0.f};
        cur = nxt; cA = nA; cB = nB; ++ui;
        if constexpr (ALIGN_EPI) { if (wr == 1) PG8_BAR; }
    }
    PG8_WAIT_V(0);
    if constexpr (!ALIGN_EPI) { if (wr == 0) PG8_BAR; }
    PG8_BAR;
    if constexpr (Epi::AFTER_DRAIN) { E.fused(acc, cur, wr, wc, fr, fq, lds, wid, lane); S.done(cur); }
#undef PG8_SA
#undef PG8_SB
#undef PG8_STAGE
#undef PG8_LDA
#undef PG8_LDB
#undef PG8_MMA
#undef PG8_WAIT_V
#undef PG8_WAIT_L
#undef PG8_BAR
#undef PG8_SCHED
}
}


constexpr int NWAVES = 8;
constexpr int DM = 2048, BATCH = 4, SEQ = 2048, MT = BATCH * SEQ;
constexpr int NQ = 1024, NKVW = 256, CONVC = 1024, DFF = 5632, NMOD = 6 * DM;
constexpr int N1 = 7680, N4 = 2 * DFF;
constexpr float EPS = 1e-6f, LOG2E = 1.4426950408889634f;
constexpr int N_PHASES = 9;

constexpr size_t MiB = 1u << 20;
constexpr size_t WS_CTL = 0, WS_MOD = 65536, CTL_ZERO_BYTES = 262144;
constexpr size_t WS_W1T = 1 * MiB, WS_W2T = 31 * MiB, WS_W3T = 39 * MiB, WS_W4T = 47 * MiB, WS_W5T = 91 * MiB;
constexpr size_t WS_H = 113 * MiB;
constexpr size_t WS_Q = 145 * MiB, WS_K = 161 * MiB, WS_V = 165 * MiB, WS_U = 169 * MiB, WS_R = 185 * MiB, WS_GC = 217 * MiB;
constexpr size_t WS_A2 = 249 * MiB, WS_MG = 281 * MiB, WS_END = 313 * MiB;
constexpr size_t WS_HF = 145 * MiB;
static_assert(WS_HF + (size_t)MT * DFF * 2 <= WS_A2, "HF overlay");
static_assert(WS_K - WS_Q == 2 * (size_t)8388608 && WS_V - WS_Q == 2 * (size_t)10485760, "Epi1 reaches K and V from Q by fixed element offsets");
constexpr int CW_BAR = 1024;

constexpr int RING_BYTES = 131072, LDSCTL_OFF = RING_BYTES, MISC_OFF = LDSCTL_OFF + 320, LDS_BYTES = 147456;

#define GAS __attribute__((address_space(1)))
#define LAS __attribute__((address_space(3)))
typedef unsigned short bf16;
typedef unsigned v4u __attribute__((ext_vector_type(4)));
typedef unsigned v2u __attribute__((ext_vector_type(2)));
typedef float f32x4 __attribute__((ext_vector_type(4)));
typedef float f32x2 __attribute__((ext_vector_type(2)));
typedef float f32x16 __attribute__((ext_vector_type(16)));
typedef short bf16x8 __attribute__((ext_vector_type(8)));
typedef short s16x4 __attribute__((ext_vector_type(4)));
typedef GAS unsigned gu32;
#define RLX_AGENT __ATOMIC_RELAXED, __HIP_MEMORY_SCOPE_AGENT
#define LDS_WAIT() asm volatile("s_waitcnt lgkmcnt(0)" ::: "memory")
__device__ __forceinline__ unsigned f2bf(float f) { unsigned u = __builtin_bit_cast(unsigned, f); return (u + 0x7fffu + ((u >> 16) & 1u)) >> 16; }
__device__ __forceinline__ unsigned pk2(float lo, float hi) { return f2bf(lo) | (f2bf(hi) << 16); }
__device__ __forceinline__ float bflo(unsigned w) { return __uint_as_float(w << 16); }
__device__ __forceinline__ float bfhi(unsigned w) { return __uint_as_float(w & 0xffff0000u); }
__device__ __forceinline__ float sigm(float x) { return __builtin_amdgcn_rcpf(1.0f + __builtin_amdgcn_exp2f(-LOG2E * x)); }
__device__ __forceinline__ float wave_sum(float v) {
#pragma unroll
    for (int o = 1; o < 64; o <<= 1) v += __shfl_xor(v, o);
    return v;
}

#define XB_TMO      128
#define XB_XCNT(j)  (256  + 64 * (j))
#define XB_XSUB(j)  (1280 + 64 * (j))
#define XB_XGEN(j)  (2304 + 64 * (j))
#define XB_TOP      3328
#define XB_TOPGEN   3392
#define XCD_BAR_WORDS 3456
#define XB_SPIN_CAP (1u << 18)

__device__ __forceinline__ unsigned xb_ld(unsigned* p)              { return __hip_atomic_load(p, __ATOMIC_RELAXED, __HIP_MEMORY_SCOPE_AGENT); }
__device__ __forceinline__ unsigned xb_add(unsigned* p, unsigned v) { return __hip_atomic_fetch_add(p, v, __ATOMIC_RELAXED, __HIP_MEMORY_SCOPE_AGENT); }
__device__ __forceinline__ unsigned xb_xcc_id() { return (unsigned)__builtin_amdgcn_s_getreg((3 << 11) | 20) & 0xFu; }
#define XB_SPIN(cond, bar) do { unsigned _sp = 0; while (cond) { __builtin_amdgcn_s_sleep(1); \
    if ((++_sp & 255u) == 0u) { if (xb_ld(&(bar)[XB_TMO])) break; if (_sp > XB_SPIN_CAP) { atomicAdd(&(bar)[XB_TMO], 1u); break; } } } } while (0)

struct XcdBarrier {
    unsigned* bar; unsigned x;
    volatile LAS unsigned* st;
};

__device__ __forceinline__ XcdBarrier xcd_barrier_post(unsigned* bar, volatile LAS unsigned* st) {
    XcdBarrier b; b.bar = bar; b.x = xb_xcc_id(); b.st = st;
    if (threadIdx.x == 0) (void)xb_add(&bar[XB_XCNT(b.x)], 1u);
    return b;
}
__device__ __forceinline__ void xcd_barrier_complete(unsigned* bar, unsigned x, unsigned& nloc, unsigned& nx) {
    const unsigned G = gridDim.x * gridDim.y * gridDim.z;
    unsigned sum, cnt, mine, sp = 0u;
    for (;;) {
        sum = 0u; cnt = 0u; mine = 0u;
#pragma unroll
        for (unsigned j = 0; j < 16; ++j) { const unsigned c = xb_ld(&bar[XB_XCNT(j)]); sum += c; cnt += (c > 0u) ? 1u : 0u; mine = (j == x) ? c : mine; }
        if (sum == G) break;
        __builtin_amdgcn_s_sleep(1);
        if ((++sp & 255u) == 0u) { if (xb_ld(&bar[XB_TMO])) break; if (sp > XB_SPIN_CAP) { atomicAdd(&bar[XB_TMO], 1u); break; } }
    }
    nloc = mine > 0u ? mine : 1u; nx = cnt > 0u ? cnt : 1u;
}

__device__ __forceinline__ void xcd_barrier(const XcdBarrier& b) {
    asm volatile("s_waitcnt vmcnt(0)" ::: "memory");
    __syncthreads();
    if (threadIdx.x == 0) {
        unsigned* bar = b.bar;
        __builtin_amdgcn_s_waitcnt(0);
        unsigned nloc = b.st[0], nx = b.st[1];
        if (nloc == 0u) { xcd_barrier_complete(bar, b.x, nloc, nx); b.st[0] = nloc; b.st[1] = nx; }
        const unsigned old = xb_add(&bar[XB_XSUB(b.x)], 1u);
        const unsigned gen = old / nloc;
        if (old + 1u == (gen + 1u) * nloc) {
            __builtin_amdgcn_fence(__ATOMIC_RELEASE, "agent");
            asm volatile("s_waitcnt vmcnt(0)" ::: "memory");
            const unsigned og = xb_add(&bar[XB_TOP], 1u);
            const unsigned tg = og / nx;
            if (og + 1u == (tg + 1u) * nx) xb_add(&bar[XB_TOPGEN], 1u);
            else XB_SPIN(xb_ld(&bar[XB_TOPGEN]) == tg, bar);
            __builtin_amdgcn_fence(__ATOMIC_ACQUIRE, "agent");
            xb_add(&bar[XB_XGEN(b.x)], 1u);
            asm volatile("s_waitcnt vmcnt(0)" ::: "memory");
        } else {
            XB_SPIN(xb_ld(&bar[XB_XGEN(b.x)]) == gen, bar);
            __builtin_amdgcn_fence(__ATOMIC_ACQUIRE, "agent");
            asm volatile("s_waitcnt vmcnt(0)" ::: "memory");
        }
    }
    __syncthreads();
}

__device__ __forceinline__ void p0_adaln(const float* c, const float* w_ada, const float* b_ada, float* MOD, LAS float* red, int tid, int lane, int wave) {
    const __amdgpu_buffer_rsrc_t wrsrc = __builtin_amdgcn_make_buffer_rsrc((void*)w_ada, 0, DM * NMOD * 4, 0x00020000);
    for (int it = blockIdx.x; it < 48 * 16; it += gridDim.x) {
        const int cgp = it % 48, kc = it / 48, k0 = kc * 128 + wave * 16, c0 = cgp * 256 + lane * 4;
        const float cv = c[(lane >> 4) * DM + k0 + (lane & 15)];
        const float sv = cv * sigm(cv);
        f32x4 acc[4], w4[16];
#pragma unroll
        for (int b = 0; b < 4; ++b) acc[b] = (f32x4){0.f, 0.f, 0.f, 0.f};
        const unsigned voff = (unsigned)(k0 * NMOD + c0) * 4u;
#pragma unroll
        for (int r = 0; r < 16; ++r) w4[r] = __builtin_bit_cast(f32x4, __builtin_amdgcn_raw_buffer_load_b128(wrsrc, voff, r * (NMOD * 4), 0));
#pragma unroll
        for (int r = 0; r < 16; ++r)
#pragma unroll
            for (int b = 0; b < 4; ++b) { const float sc = __uint_as_float(__builtin_amdgcn_readlane(__float_as_uint(sv), b * 16 + r)); acc[b] += w4[r] * sc; }
#pragma unroll
        for (int b = 0; b < 4; ++b) *(LAS f32x4*)(red + ((wave * 4 + b) * 256 + lane * 4)) = acc[b];
        __syncthreads();
#pragma unroll
        for (int e = 0; e < 2; ++e) { const int o = tid * 2 + e, b = o >> 8, col = o & 255; float s = 0.f;
#pragma unroll
            for (int w = 0; w < 8; ++w) s += red[(w * 4 + b) * 256 + col];
            if (kc == 0) s += b_ada[cgp * 256 + col];
            atomicAdd(MOD + b * NMOD + cgp * 256 + col, s); }
        __syncthreads();
    }
}
__device__ __forceinline__ int maprow(int mapid, int n0) {
    if (mapid == 1) {
        if (n0 < 1536) return n0;
        if (n0 < 2560) { const int t = n0 - 1536; return 1536 + ((t >> 7) << 8) + (t & 127); }
        if (n0 < 3584) { const int t = n0 - 2560; return 1536 + ((t >> 7) << 8) + 128 + (t & 127); }
        if (n0 < 5632) { const int t = n0 - 3584; return 3584 + ((t >> 7) << 8) + (t & 127); }
        const int t = n0 - 5632; return 3584 + ((t >> 7) << 8) + 128 + (t & 127);
    }
    if (mapid == 2) {
        if (n0 < DFF) return ((n0 >> 7) << 8) + (n0 & 127);
        const int t = n0 - DFF; return ((t >> 7) << 8) + 128 + (t & 127);
    }
    return n0;
}
__device__ __forceinline__ void transpose_write(const float (&v)[32], bf16* WT, int ldk, int kcol, int drow0, LAS float* scr, int lane) {
#pragma unroll
    for (int i = 0; i < 32; ++i) scr[(2 * i + (lane >> 5)) * 33 + (lane & 31)] = v[i];
    LDS_WAIT(); asm volatile("" ::: "memory");
    const int c = lane & 7;
#pragma unroll
    for (int j = 0; j < 4; ++j) { const int n = (lane >> 3) + 8 * j; const LAS float* s = scr + (8 * c) * 33 + n;
        v4u o; o.x = pk2(s[0 * 33], s[1 * 33]); o.y = pk2(s[2 * 33], s[3 * 33]); o.z = pk2(s[4 * 33], s[5 * 33]); o.w = pk2(s[6 * 33], s[7 * 33]);
        *(GAS v4u*)(WT + (size_t)(drow0 + n) * ldk + kcol + 8 * c) = o; }
    LDS_WAIT(); asm volatile("" ::: "memory");
}
template <int MAPID>
__device__ __forceinline__ void transpose_matrix(const float* W, int K, int N, bf16* WT, int ldk, int koff, int item_off, LAS float* scr, int gw, int NGW, int lane) {
    const int nblk = N / 32, nitems = (K / 64) * nblk;
    const __amdgpu_buffer_rsrc_t rsrc = __builtin_amdgcn_make_buffer_rsrc((void*)W, 0, K * N * 4, 0x00020000);
    const unsigned lane_off = (unsigned)((lane >> 5) * N + (lane & 31)) * 4u, rowstep = (unsigned)N * 8u;
    for (int it = ((gw - item_off) % NGW + NGW) % NGW; it < nitems; it += 2 * NGW) {
        const int itB = it + NGW; const bool hasB = itB < nitems;
        const int kA = 64 * (it / nblk), nA = 32 * (it % nblk), kB = hasB ? 64 * (itB / nblk) : 0, nB = hasB ? 32 * (itB % nblk) : 0;
        const unsigned offA = (unsigned)(kA * N + nA) * 4u + lane_off, offB = (unsigned)(kB * N + nB) * 4u + lane_off;
        float va[32], vb[32];
#pragma unroll
        for (int i = 0; i < 32; ++i) va[i] = __uint_as_float(__builtin_amdgcn_raw_buffer_load_b32(rsrc, offA, i * rowstep, 0));
        if (hasB) {
#pragma unroll
            for (int i = 0; i < 32; ++i) vb[i] = __uint_as_float(__builtin_amdgcn_raw_buffer_load_b32(rsrc, offB, i * rowstep, 0));
        }
        transpose_write(va, WT, ldk, koff + kA, maprow(MAPID, nA), scr, lane);
        if (hasB) transpose_write(vb, WT, ldk, koff + kB, maprow(MAPID, nB), scr, lane);
    }
}
__device__ __forceinline__ void modnorm_phase(const float* X, const float* g, const float* MOD, int sh_off, int sc_off, bf16* H, int gw, int NGW, int lane) {
    for (int it = gw; it < MT / 4; it += NGW) {
        const int row0 = it * 4, b = row0 / SEQ;
        f32x4 A[8], Bv[8];
#pragma unroll
        for (int j = 0; j < 8; ++j) { const int col = 4 * (lane + 64 * j);
            const f32x4 gg = *(const f32x4*)(g + col), sc = *(const f32x4*)(MOD + (size_t)b * NMOD + sc_off + col);
            A[j] = gg * (1.0f + sc); Bv[j] = *(const f32x4*)(MOD + (size_t)b * NMOD + sh_off + col); }
        for (int r = 0; r < 4; ++r) {
            const float* xr = X + (size_t)(row0 + r) * DM;
            f32x4 v[8]; float ss = 0.f;
#pragma unroll
            for (int j = 0; j < 8; ++j) { v[j] = *(const f32x4*)(xr + 4 * (lane + 64 * j)); ss += (v[j].x * v[j].x + v[j].y * v[j].y) + (v[j].z * v[j].z + v[j].w * v[j].w); }
            const float rstd = 1.0f / sqrtf(wave_sum(ss) * (1.0f / DM) + EPS);
            bf16* hr = H + (size_t)(row0 + r) * DM;
#pragma unroll
            for (int j = 0; j < 8; ++j) { const f32x4 o = v[j] * rstd * A[j] + Bv[j]; v2u w; w.x = pk2(o.x, o.y); w.y = pk2(o.z, o.w); *(GAS v2u*)(hr + 4 * (lane + 64 * j)) = w; }
        }
    }
}
__device__ __forceinline__ int crow(int r, int hi) { return (r & 3) + 8 * (r >> 2) + 4 * hi; }
constexpr int AT_KS = 0, AT_VT = 36864, AT_BIAS = AT_VT + 33792, AT_LSCR = AT_BIAS + 4096, AT_OSTG = AT_LSCR + 1024, AT_END = AT_OSTG + 8 * 4608;
static_assert(AT_END <= RING_BYTES, "attention LDS");
__device__ __forceinline__ float sum8_dpp(float v) {
    v += __uint_as_float(__builtin_amdgcn_update_dpp(0u, __float_as_uint(v), 0x141, 0xf, 0xf, false));
    v += __uint_as_float(__builtin_amdgcn_update_dpp(0u, __float_as_uint(v), 0xB1, 0xf, 0xf, false));
    v += __uint_as_float(__builtin_amdgcn_update_dpp(0u, __float_as_uint(v), 0x4E, 0xf, 0xf, false));
    return v;
}
__device__ __forceinline__ void attn_unit(int unit, const bf16* Qb, const bf16* Kb, const bf16* Vb, bf16* A2, const float* qg, const float* kg, const float* sinks, const float* relb,
                                          LAS unsigned char* lds, int tid, int lane, int wave) {
    const int b = unit >> 6, kvh = (unit >> 4) & 3, nb = unit & 15;
    LAS bf16* Ks = (LAS bf16*)(lds + AT_KS);
    LAS bf16* Vt = (LAS bf16*)(lds + AT_VT);
    LAS float* biasT = (LAS float*)(lds + AT_BIAS);
    LAS float* lscr = (LAS float*)(lds + AT_LSCR) + wave * 32;
    LAS bf16* ostg = (LAS bf16*)(lds + AT_OSTG) + wave * 2304;
    const int tok0 = b * SEQ + nb * 128;
    const int q = lane & 31, hi = lane >> 5;
    v4u qn[4];
    { const int pi = wave * 2, g = pi >> 2, qblk = pi & 3;
        const bf16* qrow = Qb + (size_t)(tok0 + qblk * 32 + q) * 1024 + (kvh * 4 + g) * 64 + hi * 8;
#pragma unroll
        for (int ks = 0; ks < 4; ++ks) qn[ks] = *(const v4u*)(qrow + 16 * ks); }
    v4u kw[4], vw[4];
#pragma unroll
    for (int i = 0; i < 4; ++i) { const int c = tid + 512 * i, key = c >> 3, part = c & 7;
        const bool real = (nb > 0) || (key >= 128);
        const long tok = (long)tok0 - 128 + key;
        kw[i] = (v4u){0u, 0u, 0u, 0u}; vw[i] = (v4u){0u, 0u, 0u, 0u};
        if (real) { kw[i] = *(const v4u*)(Kb + tok * 256 + kvh * 64 + part * 8); vw[i] = *(const v4u*)(Vb + tok * 256 + kvh * 64 + part * 8); } }
#pragma unroll
    for (int e = 0; e < 2; ++e) { const int idx = tid + 512 * e, g = idx >> 8, dist = (idx & 255) - 48; int bucket = dist < 0 ? 0 : (dist > 127 ? 127 : dist);
      if (bucket >= 16) { const int l = 16 + (int)(logf((float)bucket * (1.0f / 16.0f)) / 2.0794415416798357f * 16.0f); bucket = l < 31 ? l : 31; }
      biasT[idx] = (dist >= 0 && dist < 128) ? relb[bucket * 16 + kvh * 4 + g] * LOG2E : 0.f; }
    { const int part = tid & 7; const f32x4 kg0 = *(const f32x4*)(kg + part * 8), kg1 = *(const f32x4*)(kg + part * 8 + 4);
#pragma unroll
    for (int i = 0; i < 4; ++i) { const int key = (tid + 512 * i) >> 3;
        const f32x4 k0 = (f32x4){bflo(kw[i].x), bfhi(kw[i].x), bflo(kw[i].y), bfhi(kw[i].y)}, k1 = (f32x4){bflo(kw[i].z), bfhi(kw[i].z), bflo(kw[i].w), bfhi(kw[i].w)};
        const float ss = sum8_dpp((k0.x * k0.x + k0.y * k0.y) + (k0.z * k0.z + k0.w * k0.w) + (k1.x * k1.x + k1.y * k1.y) + (k1.z * k1.z + k1.w * k1.w));
        const float rstd = 1.0f / sqrtf(ss * (1.0f / 64.0f) + EPS);
        const f32x4 g0 = kg0 * rstd, g1 = kg1 * rstd;
        v4u o; o.x = pk2(k0.x * g0.x, k0.y * g0.y); o.y = pk2(k0.z * g0.z, k0.w * g0.w); o.z = pk2(k1.x * g1.x, k1.y * g1.y); o.w = pk2(k1.z * g1.z, k1.w * g1.w);
        *(LAS v4u*)(Ks + key * 72 + part * 8) = o;
        LAS bf16* vt = Vt + (part * 8) * 264 + key;
        vt[0 * 264] = (bf16)(vw[i].x & 0xffffu); vt[1 * 264] = (bf16)(vw[i].x >> 16); vt[2 * 264] = (bf16)(vw[i].y & 0xffffu); vt[3 * 264] = (bf16)(vw[i].y >> 16);
        vt[4 * 264] = (bf16)(vw[i].z & 0xffffu); vt[5 * 264] = (bf16)(vw[i].z >> 16); vt[6 * 264] = (bf16)(vw[i].w & 0xffffu); vt[7 * 264] = (bf16)(vw[i].w >> 16); } }
    __syncthreads();
#pragma unroll 1
    for (int pass = 0; pass < 2; ++pass) {
        const int pi = wave * 2 + pass, g = pi >> 2, qblk = pi & 3, h = kvh * 4 + g, q0 = qblk * 32;
        v4u qw[4];
#pragma unroll
        for (int ks = 0; ks < 4; ++ks) qw[ks] = qn[ks];
        if (pass == 0) { const int pi1 = pi + 1, g1 = pi1 >> 2, qblk1 = pi1 & 3;
            const bf16* qrow = Qb + (size_t)(tok0 + qblk1 * 32 + q) * 1024 + (kvh * 4 + g1) * 64 + hi * 8;
#pragma unroll
            for (int ks = 0; ks < 4; ++ks) qn[ks] = *(const v4u*)(qrow + 16 * ks); }
        float ss = 0.f;
#pragma unroll
        for (int ks = 0; ks < 4; ++ks) { const v4u w = qw[ks];
            const float a0 = bflo(w.x), a1 = bfhi(w.x), a2 = bflo(w.y), a3 = bfhi(w.y), a4 = bflo(w.z), a5 = bfhi(w.z), a6 = bflo(w.w), a7 = bfhi(w.w);
            ss += (a0 * a0 + a1 * a1) + (a2 * a2 + a3 * a3) + (a4 * a4 + a5 * a5) + (a6 * a6 + a7 * a7); }
        ss += __shfl_xor(ss, 32);
        const float rs = (1.0f / sqrtf(ss * (1.0f / 64.0f) + EPS)) * (0.125f * LOG2E);
        bf16x8 qf[4];
#pragma unroll
        for (int ks = 0; ks < 4; ++ks) { const v4u w = qw[ks]; const f32x4 g0 = *(const f32x4*)(qg + 16 * ks + 8 * hi) * rs, g1 = *(const f32x4*)(qg + 16 * ks + 8 * hi + 4) * rs;
            v4u o; o.x = pk2(bflo(w.x) * g0.x, bfhi(w.x) * g0.y); o.y = pk2(bflo(w.y) * g0.z, bfhi(w.y) * g0.w);
            o.z = pk2(bflo(w.z) * g1.x, bfhi(w.z) * g1.y); o.w = pk2(bflo(w.w) * g1.z, bfhi(w.w) * g1.w);
            qf[ks] = __builtin_bit_cast(bf16x8, o); }
        f32x16 s[5];
#pragma unroll
        for (int tt = 0; tt < 5; ++tt) {
            s[tt] = (f32x16){0.f, 0.f, 0.f, 0.f, 0.f, 0.f, 0.f, 0.f, 0.f, 0.f, 0.f, 0.f, 0.f, 0.f, 0.f, 0.f};
            const LAS bf16* kp = Ks + (32 * (qblk + tt) + q) * 72 + 8 * hi;
#pragma unroll
            for (int ks = 0; ks < 4; ++ks) { const bf16x8 a = *(const LAS bf16x8*)(kp + 16 * ks); s[tt] = __builtin_amdgcn_mfma_f32_32x32x16_bf16(a, qf[ks], s[tt], 0, 0, 0); }
        }
        const float sk = sinks[h] * LOG2E;
        float mx = sk;
        const LAS float* btl = biasT + g * 256 + 48 + q - 4 * hi;
#pragma unroll
        for (int tt = 0; tt < 5; ++tt)
#pragma unroll
            for (int r = 0; r < 16; ++r) { const int dist = q + 128 - 32 * tt - crow(r, hi);
                const bool valid = (dist >= 0) && (dist < 128) && ((nb > 0) || (qblk + tt >= 4));
                float v = s[tt][r] + btl[128 - 32 * tt - (r & 3) - 8 * (r >> 2)]; v = valid ? v : -INFINITY; s[tt][r] = v; mx = fmaxf(mx, v); }
        mx = fmaxf(mx, __shfl_xor(mx, 32));
        float l = 0.f;
#pragma unroll
        for (int tt = 0; tt < 5; ++tt)
#pragma unroll
            for (int r = 0; r < 16; ++r) { const float p = __builtin_amdgcn_exp2f(s[tt][r] - mx); s[tt][r] = p; l += p; }
        l += __shfl_xor(l, 32); l += __builtin_amdgcn_exp2f(sk - mx);
        f32x16 o[2];
        o[0] = (f32x16){0.f, 0.f, 0.f, 0.f, 0.f, 0.f, 0.f, 0.f, 0.f, 0.f, 0.f, 0.f, 0.f, 0.f, 0.f, 0.f}; o[1] = o[0];
#pragma unroll
        for (int tt = 0; tt < 5; ++tt)
#pragma unroll
            for (int s2 = 0; s2 < 2; ++s2) {
                v4u pw; pw.x = pk2(s[tt][8 * s2 + 0], s[tt][8 * s2 + 1]); pw.y = pk2(s[tt][8 * s2 + 2], s[tt][8 * s2 + 3]); pw.z = pk2(s[tt][8 * s2 + 4], s[tt][8 * s2 + 5]); pw.w = pk2(s[tt][8 * s2 + 6], s[tt][8 * s2 + 7]);
                const bf16x8 pa = __builtin_bit_cast(bf16x8, pw);
#pragma unroll
                for (int dt = 0; dt < 2; ++dt) { const LAS bf16* vp = Vt + (32 * dt + q) * 264 + 32 * (qblk + tt) + 16 * s2 + 4 * hi;
                    const s16x4 lo = *(const LAS s16x4*)vp, hh = *(const LAS s16x4*)(vp + 8);
                    const bf16x8 vb = (bf16x8){lo[0], lo[1], lo[2], lo[3], hh[0], hh[1], hh[2], hh[3]};
                    o[dt] = __builtin_amdgcn_mfma_f32_32x32x16_bf16(pa, vb, o[dt], 0, 0, 0); }
            }
        if (hi == 0) lscr[q] = 1.0f / l;
        LDS_WAIT();
#pragma unroll
        for (int r = 0; r < 16; ++r) { const int cr = crow(r, hi); const float li = lscr[cr];
            ostg[cr * 72 + q] = (bf16)f2bf(o[0][r] * li); ostg[cr * 72 + 32 + q] = (bf16)f2bf(o[1][r] * li); }
        LDS_WAIT();
        bf16* orow = A2 + (size_t)(tok0 + q0) * 2048 + h * 64;
#pragma unroll
        for (int i = 0; i < 4; ++i) { const int row = i * 8 + (lane >> 3), ch = lane & 7; const v4u v = *(const LAS v4u*)(ostg + row * 72 + ch * 8); *(GAS v4u*)(orow + (size_t)row * 2048 + ch * 8) = v; }
        LDS_WAIT();
    }
}
constexpr int CV_RED = RING_BYTES + 1024;
__device__ __forceinline__ void conv_unit(int unit, const bf16* U, bf16* A2, const float* cw, const float* cb, const float* lg, const float* lb, LAS unsigned char* lds, int tid, int lane, int wave) {
    const int b = unit >> 6, t0 = (unit & 63) * 32;
    LAS unsigned* Us = (LAS unsigned*)lds;
    LAS float* red = (LAS float*)(lds + CV_RED);
    const __amdgpu_buffer_rsrc_t ursrc = __builtin_amdgcn_make_buffer_rsrc((void*)(U + (size_t)b * SEQ * 1024), 0, SEQ * 1024 * 2, 0x00020000);
    const __amdgpu_buffer_rsrc_t wrsrc = __builtin_amdgcn_make_buffer_rsrc((void*)cw, 0, 31 * 1024 * 4, 0x00020000);
    const int rr0 = tid >> 7, cc = tid & 127;
    v4u st[16];
#pragma unroll
    for (int i = 0; i < 16; ++i) { const int t = t0 - 30 + rr0 + 4 * i; const unsigned voff = t >= 0 ? (unsigned)(t * 2048 + cc * 16) : 0xfffffff0u;
        st[i] = __builtin_amdgcn_raw_buffer_load_b128(ursrc, voff, 0, 0); }
    f32x2 w2[31];
#pragma unroll
    for (int j = 0; j < 31; ++j) w2[j] = __builtin_bit_cast(f32x2, __builtin_amdgcn_raw_buffer_load_b64(wrsrc, tid * 8, j * 4096, 0));
    const f32x2 bb = *(const f32x2*)(cb + 2 * tid), gg = *(const f32x2*)(lg + 2 * tid), be = *(const f32x2*)(lb + 2 * tid);
#pragma unroll
    for (int i = 0; i < 16; ++i) *(LAS v4u*)(Us + (rr0 + 4 * i) * 512 + cc * 4) = st[i];
    __syncthreads();
#pragma unroll 1
    for (int cq = 0; cq < 4; ++cq) {
        f32x2 a[8];
#pragma unroll
        for (int i = 0; i < 8; ++i) a[i] = bb;
        const LAS unsigned* up = Us + (8 * cq) * 512 + tid;
        unsigned un0 = up[0], un1 = up[512];
#pragma unroll
        for (int r = 0; r < 38; ++r) { const unsigned uu = un0; un0 = un1; if (r + 2 < 38) un1 = up[(r + 2) * 512];
            const f32x2 u2 = (f32x2){bflo(uu), bfhi(uu)};
#pragma unroll
            for (int i = 0; i < 8; ++i) { const int j = r - i; if (j >= 0 && j <= 30) a[i] += u2 * w2[j]; }
            __builtin_amdgcn_sched_barrier(0); }
        float v[16];
#pragma unroll
        for (int i = 0; i < 8; ++i) { v[i] = a[i].x + a[i].y; v[8 + i] = a[i].x * a[i].x + a[i].y * a[i].y; }
#pragma unroll
        for (int j = 0; j < 8; ++j) { const bool up_ = (lane & 32) != 0; const float send = up_ ? v[j] : v[j + 8], keep = up_ ? v[j + 8] : v[j]; v[j] = keep + __shfl_xor(send, 32); }
#pragma unroll
        for (int j = 0; j < 4; ++j) { const bool up_ = (lane & 16) != 0; const float send = up_ ? v[j] : v[j + 4], keep = up_ ? v[j + 4] : v[j]; v[j] = keep + __shfl_xor(send, 16); }
#pragma unroll
        for (int j = 0; j < 2; ++j) { const bool up_ = (lane & 8) != 0; const float send = up_ ? v[j] : v[j + 2], keep = up_ ? v[j + 2] : v[j]; v[j] = keep + __shfl_xor(send, 8); }
        { const bool up_ = (lane & 4) != 0; const float send = up_ ? v[0] : v[1], keep = up_ ? v[1] : v[0]; v[0] = keep + __shfl_xor(send, 4); }
        v[0] += __shfl_xor(v[0], 2); v[0] += __shfl_xor(v[0], 1);
        if ((lane & 3) == 0) red[(cq * 8 + wave) * 16 + ((lane >> 5) & 1) * 8 + ((lane >> 4) & 1) * 4 + ((lane >> 3) & 1) * 2 + ((lane >> 2) & 1)] = v[0];
        __syncthreads();
#pragma unroll
        for (int i = 0; i < 8; ++i) { float t1 = 0.f, t2 = 0.f;
#pragma unroll
            for (int w = 0; w < 8; ++w) { t1 += red[(cq * 8 + w) * 16 + i]; t2 += red[(cq * 8 + w) * 16 + 8 + i]; }
            const float mean = t1 * (1.0f / 1024.0f), var = t2 * (1.0f / 1024.0f) - mean * mean, rstd = 1.0f / sqrtf(var + EPS);
            float y0 = (a[i].x - mean) * rstd * gg.x + be.x, y1 = (a[i].y - mean) * rstd * gg.y + be.y;
            y0 *= sigm(y0); y1 *= sigm(y1);
            *(GAS unsigned*)(A2 + (size_t)(b * SEQ + t0 + 8 * cq + i) * 2048 + 1024 + 2 * tid) = pk2(y0, y1); }
    }
}

struct Args { const float* in[20]; float* out; unsigned char* ws; int ph_lo, ph_hi; };
__global__ void __launch_bounds__(NWAVES * 64, 2) fwd_kernel(Args args) {
    extern __shared__ __attribute__((aligned(16))) unsigned char lds_raw[];
    LAS unsigned char* lds = (LAS unsigned char*)lds_raw;
    volatile LAS unsigned* MISC = (volatile LAS unsigned*)(lds + MISC_OFF);
    const int tid = threadIdx.x, lane = tid & 63, wave = __builtin_amdgcn_readfirstlane(tid >> 6);
    const int G = gridDim.x, bx = blockIdx.x;
    const int vcu = (G % 8 == 0) ? (bx % 8) * (G / 8) + bx / 8 : bx;
    const int gw = vcu * NWAVES + wave, NGW = G * NWAVES;
#define P_ws (args.ws)
#define P_x (args.in[0])
#define P_c_in (args.in[1])
#define P_w_ada (args.in[2])
#define P_b_ada (args.in[3])
#define P_norm_mix_g (args.in[4])
#define P_w_in (args.in[5])
#define P_q_norm_g (args.in[6])
#define P_k_norm_g (args.in[7])
#define P_attn_sinks (args.in[8])
#define P_rel_bias (args.in[9])
#define P_w_attn_out (args.in[10])
#define P_conv_w (args.in[11])
#define P_conv_b (args.in[12])
#define P_conv_ln_g (args.in[13])
#define P_conv_ln_b (args.in[14])
#define P_w_conv_out (args.in[15])
#define P_w_mix_out (args.in[16])
#define P_norm_ffn_g (args.in[17])
#define P_w_ffn_in (args.in[18])
#define P_w_ffn_out (args.in[19])
#define P_out (args.out)
#define P_MOD ((float*)(P_ws + WS_MOD))
#define P_W1T ((bf16*)(P_ws + WS_W1T))
#define P_W2T ((bf16*)(P_ws + WS_W2T))
#define P_W3T ((bf16*)(P_ws + WS_W3T))
#define P_W4T ((bf16*)(P_ws + WS_W4T))
#define P_W5T ((bf16*)(P_ws + WS_W5T))
#define P_H ((bf16*)(P_ws + WS_H))
#define P_Qb ((bf16*)(P_ws + WS_Q))
#define P_Kb ((bf16*)(P_ws + WS_K))
#define P_Vb ((bf16*)(P_ws + WS_V))
#define P_Ub ((bf16*)(P_ws + WS_U))
#define P_Rb ((bf16*)(P_ws + WS_R))
#define P_GCb ((bf16*)(P_ws + WS_GC))
#define P_A2 ((bf16*)(P_ws + WS_A2))
#define P_MG ((bf16*)(P_ws + WS_MG))
#define P_HF ((bf16*)(P_ws + WS_HF))

    for (int u = tid; u < (LDS_BYTES - LDSCTL_OFF) / 4; u += NWAVES * 64) ((LAS unsigned*)(lds + LDSCTL_OFF))[u] = 0u;
    __syncthreads();
    const int lo = args.ph_lo, hi = args.ph_hi;
#if !MK_CG_SYNC
    XcdBarrier bar; bar.bar = (unsigned*)(P_ws + WS_CTL) + CW_BAR; bar.x = 0; bar.st = nullptr;
    if (hi - lo > 1) bar = xcd_barrier_post((unsigned*)(P_ws + WS_CTL) + CW_BAR, MISC + 8);
    if (lo < 0) cg::this_grid().sync();
#else
    (void)MISC;
#endif
#ifdef PHASE_MASK
#define IN(k) (((PHASE_MASK >> (k)) & 1) && lo <= (k) && (k) < hi)
#else
#define IN(k) (lo <= (k) && (k) < hi)
#endif
#define BOTH(k) (IN(k) && IN((k) + 1))
#ifndef REPEAT_MASK
#define REPEAT_MASK 0
#endif
#if MK_CG_SYNC
#define GRID_BAR(k) do { if (BOTH(k)) cg::this_grid().sync(); } while (0)
#else
#define GRID_BAR(k) do { if (BOTH(k)) xcd_barrier(bar); } while (0)
#endif

    if (IN(0)) {
        p0_adaln(P_c_in, P_w_ada, P_b_ada, P_MOD, (LAS float*)lds, tid, lane, wave);
        LAS float* scr = (LAS float*)(lds + wave * 16384);
        constexpr int I0 = 32 * 240, I1 = 16 * 64, I2 = 16 * 64, I3 = 32 * 64, I4 = 32 * 352;
        transpose_matrix<1>(P_w_in, DM, N1, P_W1T, 2048, 0, 0, scr, gw, NGW, lane);
        transpose_matrix<0>(P_w_attn_out, 1024, DM, P_W2T, 2048, 0, I0, scr, gw, NGW, lane);
        transpose_matrix<0>(P_w_conv_out, 1024, DM, P_W2T, 2048, 1024, I0 + I1, scr, gw, NGW, lane);
        transpose_matrix<0>(P_w_mix_out, DM, DM, P_W3T, 2048, 0, I0 + I1 + I2, scr, gw, NGW, lane);
        transpose_matrix<2>(P_w_ffn_in, DM, N4, P_W4T, 2048, 0, I0 + I1 + I2 + I3, scr, gw, NGW, lane);
        transpose_matrix<0>(P_w_ffn_out, DFF, DM, P_W5T, DFF, 0, I0 + I1 + I2 + I3 + I4, scr, gw, NGW, lane);
#if REPEAT_MASK & 1
        transpose_matrix<1>(P_w_in, DM, N1, P_W1T, 2048, 0, 0, scr, gw, NGW, lane);
        transpose_matrix<0>(P_w_attn_out, 1024, DM, P_W2T, 2048, 0, I0, scr, gw, NGW, lane);
        transpose_matrix<0>(P_w_conv_out, 1024, DM, P_W2T, 2048, 1024, I0 + I1, scr, gw, NGW, lane);
        transpose_matrix<0>(P_w_mix_out, DM, DM, P_W3T, 2048, 0, I0 + I1 + I2, scr, gw, NGW, lane);
        transpose_matrix<2>(P_w_ffn_in, DM, N4, P_W4T, 2048, 0, I0 + I1 + I2 + I3, scr, gw, NGW, lane);
        transpose_matrix<0>(P_w_ffn_out, DFF, DM, P_W5T, DFF, 0, I0 + I1 + I2 + I3 + I4, scr, gw, NGW, lane);
#endif
        GRID_BAR(0);
    }
#if (REPEAT_MASK >> 1) & 1
    if (IN(1)) { modnorm_phase(P_x, P_norm_mix_g, P_MOD, 0, DM, P_H, gw, NGW, lane); xcd_barrier(bar); }
#endif
    if (IN(1)) { modnorm_phase(P_x, P_norm_mix_g, P_MOD, 0, DM, P_H, gw, NGW, lane); GRID_BAR(1); }
    if (IN(2)) {
        pg8::Gemm g{P_H, P_W1T, MT, N1, DM}; pg8::StaticOrder S; S.init(MT, N1, G, bx);
        pg8::Epi1 E{P_Qb, P_Ub, P_Rb, P_GCb};
        pg8::gemm_phase<pg8::Epi1, pg8::StaticOrder, true, true>(lds, g, S, E);
        GRID_BAR(2);
    }
#if (REPEAT_MASK >> 2) & 1
    if (IN(2)) {
        pg8::Gemm g{P_H, P_W1T, MT, N1, DM}; pg8::StaticOrder S; S.init(MT, N1, G, bx);
        pg8::Epi1 E{P_Qb, P_Ub, P_Rb, P_GCb};
        pg8::gemm_phase<pg8::Epi1, pg8::StaticOrder, true, true>(lds, g, S, E);
        GRID_BAR(2);
    }
#endif
    if (IN(3)) {
#ifndef NO_ATTN
        for (int u = bx; u < 256; u += G) { attn_unit(u, P_Qb, P_Kb, P_Vb, P_A2, P_q_norm_g, P_k_norm_g, P_attn_sinks, P_rel_bias, lds, tid, lane, wave); __syncthreads(); }
#endif
#ifndef NO_CONV
        for (int u = bx; u < 256; u += G) { conv_unit(u, P_Ub, P_A2, P_conv_w, P_conv_b, P_conv_ln_g, P_conv_ln_b, lds, tid, lane, wave); __syncthreads(); }
#endif
        GRID_BAR(3);
    }
#if (REPEAT_MASK >> 3) & 1
    if (IN(3)) {
#ifndef NO_ATTN
        for (int u = bx; u < 256; u += G) { attn_unit(u, P_Qb, P_Kb, P_Vb, P_A2, P_q_norm_g, P_k_norm_g, P_attn_sinks, P_rel_bias, lds, tid, lane, wave); __syncthreads(); }
#endif
#ifndef NO_CONV
        for (int u = bx; u < 256; u += G) { conv_unit(u, P_Ub, P_A2, P_conv_w, P_conv_b, P_conv_ln_g, P_conv_ln_b, lds, tid, lane, wave); __syncthreads(); }
#endif
        GRID_BAR(3);
    }
#endif
    if (IN(4)) {
        pg8::Gemm g{P_A2, P_W2T, MT, DM, DM}; pg8::StaticOrder S; S.init(MT, DM, G, bx);
        pg8::Epi2 E{P_Rb, P_GCb, P_MG};
        pg8::gemm_phase<pg8::Epi2, pg8::StaticOrder, true, true>(lds, g, S, E);
        GRID_BAR(4);
    }
#if (REPEAT_MASK >> 4) & 1
    if (IN(4)) {
        pg8::Gemm g{P_A2, P_W2T, MT, DM, DM}; pg8::StaticOrder S; S.init(MT, DM, G, bx);
        pg8::Epi2 E{P_Rb, P_GCb, P_MG};
        pg8::gemm_phase<pg8::Epi2, pg8::StaticOrder, true, true>(lds, g, S, E);
        GRID_BAR(4);
    }
#endif
    if (IN(5)) {
        pg8::Gemm g{P_MG, P_W3T, MT, DM, DM}; pg8::StaticOrder S; S.init(MT, DM, G, bx);
        pg8::EpiRes E{P_x, P_out, P_MOD + 2 * DM};
        pg8::gemm_phase<pg8::EpiRes, pg8::StaticOrder, true, true>(lds, g, S, E);
        GRID_BAR(5);
    }
#if (REPEAT_MASK >> 5) & 1
    if (IN(5)) {
        pg8::Gemm g{P_MG, P_W3T, MT, DM, DM}; pg8::StaticOrder S; S.init(MT, DM, G, bx);
        pg8::EpiRes E{P_x, P_out, P_MOD + 2 * DM};
        pg8::gemm_phase<pg8::EpiRes, pg8::StaticOrder, true, true>(lds, g, S, E);
        GRID_BAR(5);
    }
#endif
#if (REPEAT_MASK >> 6) & 1
    if (IN(6)) { modnorm_phase(P_out, P_norm_ffn_g, P_MOD, 3 * DM, 4 * DM, P_H, gw, NGW, lane); xcd_barrier(bar); }
#endif
    if (IN(6)) { modnorm_phase(P_out, P_norm_ffn_g, P_MOD, 3 * DM, 4 * DM, P_H, gw, NGW, lane); GRID_BAR(6); }
    if (IN(7)) {
        pg8::Gemm g{P_H, P_W4T, MT, N4, DM}; pg8::StaticOrder S; S.init(MT, N4, G, bx);
        pg8::Epi4 E{P_HF};
        pg8::gemm_phase<pg8::Epi4, pg8::StaticOrder, true, true>(lds, g, S, E);
        GRID_BAR(7);
    }
#if (REPEAT_MASK >> 7) & 1
    if (IN(7)) {
        pg8::Gemm g{P_H, P_W4T, MT, N4, DM}; pg8::StaticOrder S; S.init(MT, N4, G, bx);
        pg8::Epi4 E{P_HF};
        pg8::gemm_phase<pg8::Epi4, pg8::StaticOrder, true, true>(lds, g, S, E);
        GRID_BAR(7);
    }
#endif
#if (REPEAT_MASK >> 8) & 1
    if (IN(8)) {
        pg8::Gemm g{P_HF, P_W5T, MT, DM, DFF}; pg8::StaticOrder S; S.init(MT, DM, G, bx);
        pg8::EpiRes E{P_out, (float*)(P_ws + WS_A2), P_MOD + 5 * DM};
        pg8::gemm_phase<pg8::EpiRes, pg8::StaticOrder, true, true>(lds, g, S, E);
        xcd_barrier(bar);
    }
#endif
    if (IN(8)) {
        pg8::Gemm g{P_HF, P_W5T, MT, DM, DFF}; pg8::StaticOrder S; S.init(MT, DM, G, bx);
        pg8::EpiRes E{P_out, P_out, P_MOD + 5 * DM};
        pg8::gemm_phase<pg8::EpiRes, pg8::StaticOrder, true, true>(lds, g, S, E);
    }
#undef IN
#undef BOTH
#undef GRID_BAR
}
#undef P_ws
#undef P_x
#undef P_c_in
#undef P_w_ada
#undef P_b_ada
#undef P_norm_mix_g
#undef P_w_in
#undef P_q_norm_g
#undef P_k_norm_g
#undef P_attn_sinks
#undef P_rel_bias
#undef P_w_attn_out
#undef P_conv_w
#undef P_conv_b
#undef P_conv_ln_g
#undef P_conv_ln_b
#undef P_w_conv_out
#undef P_w_mix_out
#undef P_norm_ffn_g
#undef P_w_ffn_in
#undef P_w_ffn_out
#undef P_out
#undef P_MOD
#undef P_W1T
#undef P_W2T
#undef P_W3T
#undef P_W4T
#undef P_W5T
#undef P_H
#undef P_Qb
#undef P_Kb
#undef P_Vb
#undef P_Ub
#undef P_Rb
#undef P_GCb
#undef P_A2
#undef P_MG
#undef P_HF

extern "C" void kernel_launch(void* const* d_in, const int* in_sizes, int n_in, void* d_out, int out_size, void* d_ws, size_t ws_size, hipStream_t stream) {
    static int grid = 0;
    if (grid == 0) {
        if (n_in != 20 || in_sizes[0] != MT * DM || out_size != MT * DM || ws_size < WS_END) {
            fprintf(stderr, "kernel_launch: shape/workspace mismatch (n_in %d, in0 %d, out %d, ws %zu, need %zu); nothing launched\n", n_in, n_in > 0 ? in_sizes[0] : -1, out_size, ws_size, (size_t)WS_END); grid = -1; return; }
        int dev = 0, cus = 0, per_cu = 0;
        if (hipGetDevice(&dev) != hipSuccess || hipDeviceGetAttribute(&cus, hipDeviceAttributeMultiprocessorCount, dev) != hipSuccess) { fprintf(stderr, "kernel_launch: device query failed\n"); grid = -1; return; }
        if (hipFuncSetAttribute((const void*)fwd_kernel, hipFuncAttributeMaxDynamicSharedMemorySize, LDS_BYTES) != hipSuccess) { fprintf(stderr, "kernel_launch: hipFuncSetAttribute failed\n"); grid = -1; return; }
        if (hipOccupancyMaxActiveBlocksPerMultiprocessor(&per_cu, (const void*)fwd_kernel, NWAVES * 64, LDS_BYTES) != hipSuccess || per_cu < 1) { fprintf(stderr, "kernel_launch: occupancy query says %d blocks per CU\n", per_cu); per_cu = 1; }
        (void)hipGetLastError();
        grid = cus * (per_cu < 1 ? 1 : 1);
        if (grid != 256) fprintf(stderr, "kernel_launch: note: grid = %d workgroups\n", grid);
    }
    if (grid < 0) return;
    if (hipMemsetAsync((char*)d_ws + WS_CTL, 0, CTL_ZERO_BYTES, stream) != hipSuccess) { fprintf(stderr, "kernel_launch: memset failed\n"); return; }
    Args a{};
    for (int i = 0; i < 20; ++i) a.in[i] = (const float*)d_in[i];
    a.out = (float*)d_out; a.ws = (unsigned char*)d_ws;
#if MK_PER_PHASE
    for (int ph = 0; ph < N_PHASES; ++ph) { a.ph_lo = ph; a.ph_hi = ph + 1; hipLaunchKernelGGL(fwd_kernel, dim3(grid), dim3(NWAVES * 64), LDS_BYTES, stream, a); }
#else
    a.ph_lo = 0; a.ph_hi = N_PHASES;
    void* kargs[] = {(void*)&a};
    const hipError_t e = hipLaunchCooperativeKernel((const void*)fwd_kernel, dim3(grid), dim3(NWAVES * 64), kargs, LDS_BYTES, stream);
    if (e != hipSuccess) fprintf(stderr, "kernel_launch: cooperative launch failed: %s (grid %d)\n", hipGetErrorString(e), grid);
#endif
}
```

```cpp
#include <hip/hip_runtime.h>
#include <hip/hip_cooperative_groups.h>
#include <cstdio>
#include <cstdint>
namespace cg = cooperative_groups;

#ifndef MK_PER_PHASE
#define MK_PER_PHASE 0
#endif
#ifndef MK_CG_SYNC
#define MK_CG_SYNC 0
#endif

namespace pg8 {
#define PG8_LAS __attribute__((address_space(3)))
typedef unsigned short bf16_t;
typedef short bf16x8 __attribute__((ext_vector_type(8)));
typedef float f32x4 __attribute__((ext_vector_type(4)));
typedef unsigned u32x4 __attribute__((ext_vector_type(4)));
constexpr int BM = 256, BK = 64, HALF = 128, HTB = HALF * BK * 2  , STAGE_BYTES = 8 * HTB, NXCD = 8, WGM = 8;

__host__ __device__ __forceinline__ int lds_byte(int r, int c) { const int st = (r >> 4) * 2 + (c >> 5), rr = r & 15, cc = c & 31, ob = rr * 64 + cc * 2; return st * 1024 + (ob ^ (((ob >> 9) & 1) << 5)); }
__host__ __device__ __forceinline__ void stage_rc(int b, int& R, int& C) { const int st = b / 1024, sb = b % 1024, swz = sb ^ (((sb >> 9) & 1) << 5); R = (st >> 1) * 16 + swz / 64; C = (st & 1) * 32 + (swz % 64) / 2; }
__host__ __device__ __forceinline__ int perm32(int rho) { const int n = rho >> 4, i = rho & 15; return 8 * (i >> 2) + 4 * n + (i & 3); }

struct Unit { int pm, pn; };
struct Gemm { const bf16_t* A; const bf16_t* Bt; int M, N, K; };

struct StaticOrder {
    int nM, nN, nwg, G, c;
    __host__ __device__ void init(int M, int N, int G_, int c_) { nM = M / BM; nN = N / BM; nwg = nM * nN; G = G_; c = c_; }
    __host__ __device__ bool next(int i, Unit& u) const {
        const long L = (long)i * G + c; if (L >= nwg) return false;
        int wgid = (int)L; { const int q = nwg / NXCD, r = nwg % NXCD, xcd = wgid % NXCD, off = wgid / NXCD; wgid = (xcd < r ? xcd * (q + 1) : r * (q + 1) + (xcd - r) * q) + off; }
        const int nig = WGM * nN, gid = wgid / nig, fm = gid * WGM, gsz = (nM - fm) < WGM ? (nM - fm) : WGM;
        u.pm = fm + ((wgid % nig) % gsz); u.pn = (wgid % nig) / gsz; return true;
    }
    __device__ __forceinline__ void a_ready(const Unit&) const {}
    __device__ __forceinline__ void done(const Unit&) const {}
};


__device__ __forceinline__ unsigned cvt_pk_bf16(float lo, float hi) { unsigned r; asm volatile("v_cvt_pk_bf16_f32 %0, %1, %2" : "=v"(r) : "v"(lo), "v"(hi)); return r; }
__device__ __forceinline__ float sigm(float x) { return __builtin_amdgcn_rcpf(1.0f + __builtin_amdgcn_exp2f(-1.4426950408889634f * x)); }
__device__ __forceinline__ u32x4 pack8(const f32x4& v0, const f32x4& v1) { u32x4 w; w.x = cvt_pk_bf16(v0[0], v0[1]); w.y = cvt_pk_bf16(v0[2], v0[3]); w.z = cvt_pk_bf16(v1[0], v1[1]); w.w = cvt_pk_bf16(v1[2], v1[3]); return w; }
__device__ __forceinline__ void unpack8(const u32x4& w, f32x4& v0, f32x4& v1) {
    v0[0] = __uint_as_float(w.x << 16); v0[1] = __uint_as_float(w.x & 0xffff0000u); v0[2] = __uint_as_float(w.y << 16); v0[3] = __uint_as_float(w.y & 0xffff0000u);
    v1[0] = __uint_as_float(w.z << 16); v1[1] = __uint_as_float(w.z & 0xffff0000u); v1[2] = __uint_as_float(w.w << 16); v1[3] = __uint_as_float(w.w & 0xffff0000u); }

struct Epi1 {
    static constexpr bool PERM = true, AFTER_DRAIN = false, MID = false;
    bf16_t *Q, *U, *R, *GC;
    __device__ __forceinline__ void mid(f32x4 (&)[2][2][4][2], const Unit&, int, int, int, int) const {}
    __device__ __forceinline__ void operator()(const f32x4 (&acc)[2][2][4][2], const Unit& u, int wr, int wc, int fr, int fq) const {
        const int row0 = u.pm * BM + wr * 64 + fr, cl = wc * 32 + 8 * fq;
        if (u.pn < 6) {
            const size_t boff = u.pn < 4 ? (size_t)0 : (u.pn == 4 ? (size_t)8388608 : (size_t)10485760);
            bf16_t* base = Q + boff; const int ld = u.pn < 4 ? 1024 : 256, c0 = u.pn < 4 ? u.pn * 256 : 0;
#pragma unroll
            for (int ai = 0; ai < 2; ++ai)
#pragma unroll
                for (int m = 0; m < 4; ++m) { bf16_t* rowp = base + (size_t)(row0 + ai * HALF + m * 16) * ld + c0 + cl;
#pragma unroll
                    for (int bj = 0; bj < 2; ++bj) *(u32x4*)(rowp + bj * HALF) = pack8(acc[ai][bj][m][0], acc[ai][bj][m][1]); }
        } else if (u.pn < 14) {
            const int c0 = (u.pn - 6) * 128 + cl;
#pragma unroll
            for (int ai = 0; ai < 2; ++ai)
#pragma unroll
                for (int m = 0; m < 4; ++m) { f32x4 o[2];
#pragma unroll
                    for (int n = 0; n < 2; ++n)
#pragma unroll
                        for (int e = 0; e < 4; ++e) o[n][e] = acc[ai][0][m][n][e] * sigm(acc[ai][1][m][n][e]);
                    *(u32x4*)(U + (size_t)(row0 + ai * HALF + m * 16) * 1024 + c0) = pack8(o[0], o[1]); }
        } else {
            const int c0 = (u.pn - 14) * 128 + cl;
#pragma unroll
            for (int ai = 0; ai < 2; ++ai)
#pragma unroll
                for (int m = 0; m < 4; ++m) { f32x4 r[2], g[2];
#pragma unroll
                    for (int n = 0; n < 2; ++n)
#pragma unroll
                        for (int e = 0; e < 4; ++e) { const float ea = __builtin_amdgcn_exp2f(-1.4426950408889634f * acc[ai][0][m][n][e]), ec = __builtin_amdgcn_exp2f(-1.4426950408889634f * acc[ai][1][m][n][e]);
                            g[n][e] = __builtin_amdgcn_rcpf(1.0f + ec); r[n][e] = (1.0f + ec) * __builtin_amdgcn_rcpf(1.0f + ea); }
                    const size_t off = (size_t)(row0 + ai * HALF + m * 16) * 2048 + c0;
                    *(u32x4*)(R + off) = pack8(r[0], r[1]); *(u32x4*)(GC + off) = pack8(g[0], g[1]); }
        }
    }
};
struct Epi2 {
    static constexpr bool PERM = true, AFTER_DRAIN = false, MID = true;
    const bf16_t *R, *GC; bf16_t* O;
    __device__ __forceinline__ void mid(f32x4 (&acc)[2][2][4][2], const Unit& u, int wr, int wc, int fr, int fq) const {
        asm volatile("" : "+v"(fr), "+v"(fq));
        const int row0 = u.pm * BM + wr * 64 + fr, col0 = u.pn * BM + wc * 32 + 8 * fq;
#pragma unroll
        for (int ai = 0; ai < 2; ++ai)
#pragma unroll
            for (int m = 0; m < 4; ++m) { const bf16_t* rowp = R + (size_t)(row0 + ai * HALF + m * 16) * 2048 + col0;
#pragma unroll
                for (int bj = 0; bj < 2; ++bj) { const u32x4 w = *(const u32x4*)(rowp + bj * HALF); f32x4 s0, s1; unpack8(w, s0, s1); acc[ai][bj][m][0] *= s0; acc[ai][bj][m][1] *= s1; }
                if (m & 1) asm volatile("" ::: "memory"); }
    }
    __device__ __forceinline__ void operator()(const f32x4 (&acc)[2][2][4][2], const Unit& u, int wr, int wc, int fr, int fq) const {
        const int row0 = u.pm * BM + wr * 64 + fr, col0 = u.pn * BM + wc * 32 + 8 * fq;
#pragma unroll
        for (int ai = 0; ai < 2; ++ai)
#pragma unroll
            for (int m = 0; m < 4; ++m) { const size_t off = (size_t)(row0 + ai * HALF + m * 16) * 2048 + col0;
#pragma unroll
                for (int bj = 0; bj < 2; ++bj) { const u32x4 w = *(const u32x4*)(GC + off + bj * HALF); f32x4 s0, s1; unpack8(w, s0, s1);
                    *(u32x4*)(O + off + bj * HALF) = pack8(acc[ai][bj][m][0] * s0, acc[ai][bj][m][1] * s1); }
                if (m & 1) asm volatile("" ::: "memory"); }
    }
};
struct EpiRes {
    static constexpr bool PERM = false, AFTER_DRAIN = false, MID = false;
    const float* base; float* out; const float* gate;
    __device__ __forceinline__ void mid(f32x4 (&)[2][2][4][2], const Unit&, int, int, int, int) const {}
    __device__ __forceinline__ void operator()(const f32x4 (&acc)[2][2][4][2], const Unit& u, int wr, int wc, int fr, int fq) const {
        const int row0 = u.pm * BM + wr * 64 + fr, col0 = u.pn * BM + wc * 32 + 4 * fq;
        const float* gp = gate + (size_t)(u.pm >> 3) * 12288 + col0;
        f32x4 gv[2][2];
#pragma unroll
        for (int bj = 0; bj < 2; ++bj)
#pragma unroll
            for (int n = 0; n < 2; ++n) gv[bj][n] = *(const f32x4*)(gp + bj * HALF + n * 16);
#pragma unroll
        for (int ai = 0; ai < 2; ++ai)
#pragma unroll
            for (int m = 0; m < 4; ++m) { const size_t off = (size_t)(row0 + ai * HALF + m * 16) * 2048 + col0;
#pragma unroll
                for (int bj = 0; bj < 2; ++bj)
#pragma unroll
                    for (int n = 0; n < 2; ++n) { const f32x4 b = *(const f32x4*)(base + off + bj * HALF + n * 16); *(f32x4*)(out + off + bj * HALF + n * 16) = b + gv[bj][n] * acc[ai][bj][m][n]; } }
    }
};
struct Epi4 {
    static constexpr bool PERM = true, AFTER_DRAIN = false, MID = false;
    bf16_t* HF;
    __device__ __forceinline__ void mid(f32x4 (&)[2][2][4][2], const Unit&, int, int, int, int) const {}
    __device__ __forceinline__ void operator()(const f32x4 (&acc)[2][2][4][2], const Unit& u, int wr, int wc, int fr, int fq) const {
        const int row0 = u.pm * BM + wr * 64 + fr, c0 = u.pn * 128 + wc * 32 + 8 * fq;
#pragma unroll
        for (int ai = 0; ai < 2; ++ai)
#pragma unroll
            for (int m = 0; m < 4; ++m) { f32x4 o[2];
#pragma unroll
                for (int n = 0; n < 2; ++n)
#pragma unroll
                    for (int e = 0; e < 4; ++e) { const float g = acc[ai][0][m][n][e]; o[n][e] = g * sigm(g) * acc[ai][1][m][n][e]; }
                *(u32x4*)(HF + (size_t)(row0 + ai * HALF + m * 16) * 5632 + c0) = pack8(o[0], o[1]); }
    }
};

template <class Epi, class Sched, bool ALIGN_EPI = false, bool SP2 = false>
__device__ __forceinline__ void gemm_phase(PG8_LAS unsigned char* lds, const Gemm g, const Sched& S, const Epi& E) {
    const int tid = threadIdx.x, wid = __builtin_amdgcn_readfirstlane(tid >> 6), lane = tid & 63, wr = wid >> 2, wc = wid & 3, fr = lane & 15, fq = lane >> 4;
    const int K = g.K, nt = K / BK;
    unsigned voffA[2], voffB[2];
#pragma unroll
    for (int i = 0; i < 2; ++i) { int R, C; stage_rc(tid * 16 + i * 8192, R, C); const int Rb = Epi::PERM ? ((R & ~31) + perm32(R & 31)) : R;
        voffA[i] = (unsigned)(R * K + C) * 2u; voffB[i] = (unsigned)(Rb * K + C) * 2u; }
    const size_t kstep = (size_t)(BK * 2);
    const size_t hstep = (size_t)HALF * K * 2;
    const size_t tstep = 2 * hstep;
    const unsigned ldsw = (unsigned)wid * 1024u;
    const int aoff = lds_byte(wr * 64 + fr, fq * 8), boff = lds_byte(wc * 32 + fr, fq * 8);
#define PG8_SA(b, h) (((b) * 2 + (h)) * HTB)
#define PG8_SB(b, h) ((4 + (b) * 2 + (h)) * HTB)
#define PG8_STAGE(bufoff, gbase, voff) do { _Pragma("unroll") for (int _i = 0; _i < 2; ++_i) \
        __builtin_amdgcn_global_load_lds((const unsigned*)((const char*)(gbase) + (voff)[_i]), (PG8_LAS unsigned*)(lds + (bufoff) + ldsw + _i * 8192), 16, 0, 0); } while (0)
#define PG8_LDA(dst, b, h) do { _Pragma("unroll") for (int m = 0; m < 4; ++m) _Pragma("unroll") for (int k = 0; k < 2; ++k) dst[m][k] = *(const PG8_LAS bf16x8*)(lds + PG8_SA(b, h) + aoff + m * 2048 + k * 1024); } while (0)
#define PG8_LDB(dst, b, h) do { _Pragma("unroll") for (int n = 0; n < 2; ++n) _Pragma("unroll") for (int k = 0; k < 2; ++k) dst[n][k] = *(const PG8_LAS bf16x8*)(lds + PG8_SB(b, h) + boff + n * 2048 + k * 1024); } while (0)
#define PG8_MMA(ai, bj, At, Bt) do { __builtin_amdgcn_s_setprio(1); _Pragma("unroll") for (int m = 0; m < 4; ++m) _Pragma("unroll") for (int n = 0; n < 2; ++n) _Pragma("unroll") for (int k = 0; k < 2; ++k) \
        acc[ai][bj][m][n] = __builtin_amdgcn_mfma_f32_16x16x32_bf16(Bt[n][k], At[m][k], acc[ai][bj][m][n], 0, 0, 0); __builtin_amdgcn_s_setprio(0); } while (0)
#define PG8_WAIT_V(n) asm volatile("s_waitcnt vmcnt(" #n ")" ::: "memory")
#define PG8_WAIT_L(n) asm volatile("s_waitcnt lgkmcnt(" #n ")" ::: "memory")
#define PG8_BAR __builtin_amdgcn_s_barrier()
#define PG8_SCHED __builtin_amdgcn_sched_barrier(0)
    Unit cur, nxt; int ui = 0;
    if (!S.next(0, cur)) return;
    f32x4 acc[2][2][4][2];
#pragma unroll
    for (int a = 0; a < 2; ++a)
#pragma unroll
        for (int b = 0; b < 2; ++b)
#pragma unroll
            for (int m = 0; m < 4; ++m)
#pragma unroll
                for (int n = 0; n < 2; ++n) acc[a][b][m][n] = (f32x4){0.f, 0.f, 0.f, 0.f};
    bf16x8 At[4][2], B0[2][2], B1[2][2];
    const char* cA = (const char*)g.A + (size_t)cur.pm * tstep; const char* cB = (const char*)g.Bt + (size_t)cur.pn * tstep;
    S.a_ready(cur);
    if constexpr (SP2) {
        PG8_STAGE(PG8_SB(0, 0), cB, voffB); PG8_STAGE(PG8_SB(0, 1), cB + hstep, voffB); PG8_STAGE(PG8_SA(0, 0), cA, voffA); PG8_STAGE(PG8_SA(0, 1), cA + hstep, voffA);
        if (wr == 1) PG8_BAR;
        PG8_WAIT_V(2); PG8_BAR;
        PG8_STAGE(PG8_SB(1, 0), cB + kstep, voffB); PG8_STAGE(PG8_SA(1, 0), cA + kstep, voffA); PG8_STAGE(PG8_SB(1, 1), cB + hstep + kstep, voffB);
        PG8_WAIT_V(6); PG8_BAR;
    } else {
        PG8_STAGE(PG8_SB(0, 0), cB, voffB); PG8_STAGE(PG8_SA(0, 0), cA, voffA); PG8_STAGE(PG8_SB(0, 1), cB + hstep, voffB); PG8_STAGE(PG8_SA(0, 1), cA + hstep, voffA);
        if (wr == 1) PG8_BAR;
        PG8_WAIT_V(4); PG8_BAR;
        PG8_STAGE(PG8_SB(1, 0), cB + kstep, voffB); PG8_STAGE(PG8_SA(1, 0), cA + kstep, voffA); PG8_STAGE(PG8_SB(1, 1), cB + hstep + kstep, voffB);
        PG8_WAIT_V(6); PG8_BAR;
    }
    for (;;) {
        const bool has_next = S.next(ui + 1, nxt);
        const char* nA = has_next ? (const char*)g.A + (size_t)nxt.pm * tstep : cA; const char* nB = has_next ? (const char*)g.Bt + (size_t)nxt.pn * tstep : cB;
        for (int t = 0; t < nt; t += 2) {
            const bool last = (t == nt - 2);
            const char* a1 = cA + (size_t)(t + 1) * kstep;
            const char* a2 = last ? nA : cA + (size_t)(t + 2) * kstep; const char* b2 = last ? nB : cB + (size_t)(t + 2) * kstep;
            const char* a3 = a2 + kstep; const char* b3 = b2 + kstep;
            if (last && has_next) S.a_ready(nxt);
            if constexpr (Epi::MID) { if (t == (nt >> 1)) E.mid(acc, cur, wr, wc, fr, fq); }
            if constexpr (SP2) {
            PG8_LDB(B0, 0, 0); PG8_LDB(B1, 0, 1); PG8_SCHED; PG8_LDA(At, 0, 0); PG8_STAGE(PG8_SA(1, 1), a1 + hstep, voffA);
            PG8_WAIT_V(8); PG8_WAIT_L(0); PG8_BAR; PG8_MMA(0, 0, At, B0); PG8_MMA(0, 1, At, B1); PG8_BAR; PG8_SCHED;
            PG8_LDA(At, 0, 1); PG8_STAGE(PG8_SB(0, 0), b2, voffB); PG8_STAGE(PG8_SB(0, 1), b2 + hstep, voffB); PG8_STAGE(PG8_SA(0, 0), a2, voffA);
            PG8_WAIT_V(8); PG8_WAIT_L(0); PG8_BAR; PG8_MMA(1, 0, At, B0); PG8_MMA(1, 1, At, B1); PG8_BAR; PG8_SCHED;
            PG8_LDB(B0, 1, 0); PG8_LDB(B1, 1, 1); PG8_SCHED; PG8_LDA(At, 1, 0); PG8_STAGE(PG8_SA(0, 1), a2 + hstep, voffA);
            PG8_WAIT_V(8); PG8_WAIT_L(0); PG8_BAR; PG8_MMA(0, 0, At, B0); PG8_MMA(0, 1, At, B1); PG8_BAR; PG8_SCHED;
            PG8_LDA(At, 1, 1); PG8_STAGE(PG8_SB(1, 0), b3, voffB); PG8_STAGE(PG8_SB(1, 1), b3 + hstep, voffB); PG8_STAGE(PG8_SA(1, 0), a3, voffA);
            PG8_WAIT_V(8); PG8_WAIT_L(0); PG8_BAR; PG8_MMA(1, 0, At, B0); PG8_MMA(1, 1, At, B1); PG8_BAR; PG8_SCHED;
            } else {
            PG8_LDB(B0, 0, 0); PG8_SCHED; PG8_LDA(At, 0, 0); PG8_STAGE(PG8_SA(1, 1), a1 + hstep, voffA);
            PG8_WAIT_L(8); PG8_BAR; PG8_WAIT_L(0); PG8_MMA(0, 0, At, B0); PG8_BAR; PG8_SCHED;
            PG8_LDB(B1, 0, 1); PG8_STAGE(PG8_SB(0, 0), b2, voffB);
            PG8_BAR; PG8_WAIT_L(0); PG8_MMA(0, 1, At, B1); PG8_BAR;
            PG8_LDA(At, 0, 1); PG8_STAGE(PG8_SA(0, 0), a2, voffA);
            PG8_BAR; PG8_WAIT_L(0); PG8_MMA(1, 0, At, B0); PG8_BAR; PG8_SCHED;
            PG8_STAGE(PG8_SB(0, 1), b2 + hstep, voffB);
            PG8_WAIT_V(6); PG8_BAR; PG8_MMA(1, 1, At, B1); PG8_BAR;
            PG8_LDB(B0, 1, 0); PG8_SCHED; PG8_LDA(At, 1, 0); PG8_STAGE(PG8_SA(0, 1), a2 + hstep, voffA);
            PG8_WAIT_L(8); PG8_BAR; PG8_WAIT_L(0); PG8_MMA(0, 0, At, B0); PG8_BAR; PG8_SCHED;
            PG8_LDB(B1, 1, 1); PG8_STAGE(PG8_SB(1, 0), b3, voffB);
            PG8_BAR; PG8_WAIT_L(0); PG8_MMA(0, 1, At, B1); PG8_BAR;
            PG8_LDA(At, 1, 1); PG8_STAGE(PG8_SA(1, 0), a3, voffA);
            PG8_BAR; PG8_WAIT_L(0); PG8_MMA(1, 0, At, B0); PG8_BAR; PG8_SCHED;
            PG8_STAGE(PG8_SB(1, 1), b3 + hstep, voffB);
            PG8_WAIT_V(6); PG8_BAR; PG8_MMA(1, 1, At, B1); PG8_BAR;
            }
        }
        if constexpr (ALIGN_EPI) { if (wr == 0) PG8_BAR; }
        if constexpr (!Epi::AFTER_DRAIN) { E(acc, cur, wr, wc, fr, fq); S.done(cur); }
        if (!has_next) break;
#pragma unroll
        for (int a = 0; a < 2; ++a)
#pragma unroll
            for (int b = 0; b < 2; ++b)
#pragma unroll
                for (int m = 0; m < 4; ++m)
#pragma unroll
                    for (int n = 0; n < 2; ++n) acc[a][b][m][n] = (f32x4){0.f, 0.f, 0.f, 0.f};
        cur = nxt; cA = nA; cB = nB; ++ui;
        if constexpr (ALIGN_EPI) { if (wr == 1) PG8_BAR; }
    }
    PG8_WAIT_V(0);
    if constexpr (!ALIGN_EPI) { if (wr == 0) PG8_BAR; }
    PG8_BAR;
    if constexpr (Epi::AFTER_DRAIN) { E.fused(acc, cur, wr, wc, fr, fq, lds, wid, lane); S.done(cur); }
#undef PG8_SA
#undef PG8_SB
#undef PG8_STAGE
#undef PG8_LDA
#undef PG8_LDB
#undef PG8_MMA
#undef PG8_WAIT_V
#undef PG8_WAIT_L
#undef PG8_BAR
#undef PG8_SCHED
}
}


constexpr int NWAVES = 8;
constexpr int DM = 2048, BATCH = 4, SEQ = 2048, MT = BATCH * SEQ;
constexpr int NQ = 1024, NKVW = 256, CONVC = 1024, DFF = 5632, NMOD = 6 * DM;
constexpr int N1 = 7680, N4 = 2 * DFF;
constexpr float EPS = 1e-6f, LOG2E = 1.4426950408889634f;
constexpr int N_PHASES = 9;

constexpr size_t MiB = 1u << 20;
constexpr size_t WS_CTL = 0, WS_MOD = 65536, CTL_ZERO_BYTES = 262144;
constexpr size_t WS_W1T = 1 * MiB, WS_W2T = 31 * MiB, WS_W3T = 39 * MiB, WS_W4T = 47 * MiB, WS_W5T = 91 * MiB;
constexpr size_t WS_H = 113 * MiB;
constexpr size_t WS_Q = 145 * MiB, WS_K = 161 * MiB, WS_V = 165 * MiB, WS_U = 169 * MiB, WS_R = 185 * MiB, WS_GC = 217 * MiB;
constexpr size_t WS_A2 = 249 * MiB, WS_MG = 281 * MiB, WS_END = 313 * MiB;
constexpr size_t WS_HF = 145 * MiB;
static_assert(WS_HF + (size_t)MT * DFF * 2 <= WS_A2, "HF overlay");
static_assert(WS_K - WS_Q == 2 * (size_t)8388608 && WS_V - WS_Q == 2 * (size_t)10485760, "Epi1 reaches K and V from Q by fixed element offsets");
constexpr int CW_BAR = 1024;

constexpr int RING_BYTES = 131072, LDSCTL_OFF = RING_BYTES, MISC_OFF = LDSCTL_OFF + 320, LDS_BYTES = 147456;

#define GAS __attribute__((address_space(1)))
#define LAS __attribute__((address_space(3)))
typedef unsigned short bf16;
typedef unsigned v4u __attribute__((ext_vector_type(4)));
typedef unsigned v2u __attribute__((ext_vector_type(2)));
typedef float f32x4 __attribute__((ext_vector_type(4)));
typedef float f32x2 __attribute__((ext_vector_type(2)));
typedef float f32x16 __attribute__((ext_vector_type(16)));
typedef short bf16x8 __attribute__((ext_vector_type(8)));
typedef short s16x4 __attribute__((ext_vector_type(4)));
typedef GAS unsigned gu32;
#define RLX_AGENT __ATOMIC_RELAXED, __HIP_MEMORY_SCOPE_AGENT
#define LDS_WAIT() asm volatile("s_waitcnt lgkmcnt(0)" ::: "memory")
__device__ __forceinline__ unsigned f2bf(float f) { unsigned u = __builtin_bit_cast(unsigned, f); return (u + 0x7fffu + ((u >> 16) & 1u)) >> 16; }
__device__ __forceinline__ unsigned pk2(float lo, float hi) { return f2bf(lo) | (f2bf(hi) << 16); }
__device__ __forceinline__ float bflo(unsigned w) { return __uint_as_float(w << 16); }
__device__ __forceinline__ float bfhi(unsigned w) { return __uint_as_float(w & 0xffff0000u); }
__device__ __forceinline__ float sigm(float x) { return __builtin_amdgcn_rcpf(1.0f + __builtin_amdgcn_exp2f(-LOG2E * x)); }
__device__ __forceinline__ float wave_sum(float v) {
#pragma unroll
    for (int o = 1; o < 64; o <<= 1) v += __shfl_xor(v, o);
    return v;
}

#define XB_TMO      128
#define XB_XCNT(j)  (256  + 64 * (j))
#define XB_XSUB(j)  (1280 + 64 * (j))
#define XB_XGEN(j)  (2304 + 64 * (j))
#define XB_TOP      3328
#define XB_TOPGEN   3392
#define XCD_BAR_WORDS 3456
#define XB_SPIN_CAP (1u << 18)

__device__ __forceinline__ unsigned xb_ld(unsigned* p)              { return __hip_atomic_load(p, __ATOMIC_RELAXED, __HIP_MEMORY_SCOPE_AGENT); }
__device__ __forceinline__ unsigned xb_add(unsigned* p, unsigned v) { return __hip_atomic_fetch_add(p, v, __ATOMIC_RELAXED, __HIP_MEMORY_SCOPE_AGENT); }
__device__ __forceinline__ unsigned xb_xcc_id() { return (unsigned)__builtin_amdgcn_s_getreg((3 << 11) | 20) & 0xFu; }
#define XB_SPIN(cond, bar) do { unsigned _sp = 0; while (cond) { __builtin_amdgcn_s_sleep(1); \
    if ((++_sp & 255u) == 0u) { if (xb_ld(&(bar)[XB_TMO])) break; if (_sp > XB_SPIN_CAP) { atomicAdd(&(bar)[XB_TMO], 1u); break; } } } } while (0)

struct XcdBarrier {
    unsigned* bar; unsigned x;
    volatile LAS unsigned* st;
};

__device__ __forceinline__ XcdBarrier xcd_barrier_post(unsigned* bar, volatile LAS unsigned* st) {
    XcdBarrier b; b.bar = bar; b.x = xb_xcc_id(); b.st = st;
    if (threadIdx.x == 0) (void)xb_add(&bar[XB_XCNT(b.x)], 1u);
    return b;
}
__device__ __forceinline__ void xcd_barrier_complete(unsigned* bar, unsigned x, unsigned& nloc, unsigned& nx) {
    const unsigned G = gridDim.x * gridDim.y * gridDim.z;
    unsigned sum, cnt, mine, sp = 0u;
    for (;;) {
        sum = 0u; cnt = 0u; mine = 0u;
#pragma unroll
        for (unsigned j = 0; j < 16; ++j) { const unsigned c = xb_ld(&bar[XB_XCNT(j)]); sum += c; cnt += (c > 0u) ? 1u : 0u; mine = (j == x) ? c : mine; }
        if (sum == G) break;
        __builtin_amdgcn_s_sleep(1);
        if ((++sp & 255u) == 0u) { if (xb_ld(&bar[XB_TMO])) break; if (sp > XB_SPIN_CAP) { atomicAdd(&bar[XB_TMO], 1u); break; } }
    }
    nloc = mine > 0u ? mine : 1u; nx = cnt > 0u ? cnt : 1u;
}

__device__ __forceinline__ void xcd_barrier(const XcdBarrier& b) {
    asm volatile("s_waitcnt vmcnt(0)" ::: "memory");
    __syncthreads();
    if (threadIdx.x == 0) {
        unsigned* bar = b.bar;
        __builtin_amdgcn_s_waitcnt(0);
        unsigned nloc = b.st[0], nx = b.st[1];
        if (nloc == 0u) { xcd_barrier_complete(bar, b.x, nloc, nx); b.st[0] = nloc; b.st[1] = nx; }
        const unsigned old = xb_add(&bar[XB_XSUB(b.x)], 1u);
        const unsigned gen = old / nloc;
        if (old + 1u == (gen + 1u) * nloc) {
            __builtin_amdgcn_fence(__ATOMIC_RELEASE, "agent");
            asm volatile("s_waitcnt vmcnt(0)" ::: "memory");
            const unsigned og = xb_add(&bar[XB_TOP], 1u);
            const unsigned tg = og / nx;
            if (og + 1u == (tg + 1u) * nx) xb_add(&bar[XB_TOPGEN], 1u);
            else XB_SPIN(xb_ld(&bar[XB_TOPGEN]) == tg, bar);
            __builtin_amdgcn_fence(__ATOMIC_ACQUIRE, "agent");
            xb_add(&bar[XB_XGEN(b.x)], 1u);
            asm volatile("s_waitcnt vmcnt(0)" ::: "memory");
        } else {
            XB_SPIN(xb_ld(&bar[XB_XGEN(b.x)]) == gen, bar);
            __builtin_amdgcn_fence(__ATOMIC_ACQUIRE, "agent");
            asm volatile("s_waitcnt vmcnt(0)" ::: "memory");
        }
    }
    __syncthreads();
}

__device__ __forceinline__ void p0_adaln(const float* c, const float* w_ada, const float* b_ada, float* MOD, LAS float* red, int tid, int lane, int wave) {
    const __amdgpu_buffer_rsrc_t wrsrc = __builtin_amdgcn_make_buffer_rsrc((void*)w_ada, 0, DM * NMOD * 4, 0x00020000);
    for (int it = blockIdx.x; it < 48 * 16; it += gridDim.x) {
        const int cgp = it % 48, kc = it / 48, k0 = kc * 128 + wave * 16, c0 = cgp * 256 + lane * 4;
        const float cv = c[(lane >> 4) * DM + k0 + (lane & 15)];
        const float sv = cv * sigm(cv);
        f32x4 acc[4], w4[16];
#pragma unroll
        for (int b = 0; b < 4; ++b) acc[b] = (f32x4){0.f, 0.f, 0.f, 0.f};
        const unsigned voff = (unsigned)(k0 * NMOD + c0) * 4u;
#pragma unroll
        for (int r = 0; r < 16; ++r) w4[r] = __builtin_bit_cast(f32x4, __builtin_amdgcn_raw_buffer_load_b128(wrsrc, voff, r * (NMOD * 4), 0));
#pragma unroll
        for (int r = 0; r < 16; ++r)
#pragma unroll
            for (int b = 0; b < 4; ++b) { const float sc = __uint_as_float(__builtin_amdgcn_readlane(__float_as_uint(sv), b * 16 + r)); acc[b] += w4[r] * sc; }
#pragma unroll
        for (int b = 0; b < 4; ++b) *(LAS f32x4*)(red + ((wave * 4 + b) * 256 + lane * 4)) = acc[b];
        __syncthreads();
#pragma unroll
        for (int e = 0; e < 2; ++e) { const int o = tid * 2 + e, b = o >> 8, col = o & 255; float s = 0.f;
#pragma unroll
            for (int w = 0; w < 8; ++w) s += red[(w * 4 + b) * 256 + col];
            if (kc == 0) s += b_ada[cgp * 256 + col];
            atomicAdd(MOD + b * NMOD + cgp * 256 + col, s); }
        __syncthreads();
    }
}
__device__ __forceinline__ int maprow(int mapid, int n0) {
    if (mapid == 1) {
        if (n0 < 1536) return n0;
        if (n0 < 2560) { const int t = n0 - 1536; return 1536 + ((t >> 7) << 8) + (t & 127); }
        if (n0 < 3584) { const int t = n0 - 2560; return 1536 + ((t >> 7) << 8) + 128 + (t & 127); }
        if (n0 < 5632) { const int t = n0 - 3584; return 3584 + ((t >> 7) << 8) + (t & 127); }
        const int t = n0 - 5632; return 3584 + ((t >> 7) << 8) + 128 + (t & 127);
    }
    if (mapid == 2) {
        if (n0 < DFF) return ((n0 >> 7) << 8) + (n0 & 127);
        const int t = n0 - DFF; return ((t >> 7) << 8) + 128 + (t & 127);
    }
    return n0;
}
__device__ __forceinline__ void transpose_write(const float (&v)[32], bf16* WT, int ldk, int kcol, int drow0, LAS float* scr, int lane) {
#pragma unroll
    for (int i = 0; i < 32; ++i) scr[(2 * i + (lane >> 5)) * 33 + (lane & 31)] = v[i];
    LDS_WAIT(); asm volatile("" ::: "memory");
    const int c = lane & 7;
#pragma unroll
    for (int j = 0; j < 4; ++j) { const int n = (lane >> 3) + 8 * j; const LAS float* s = scr + (8 * c) * 33 + n;
        v4u o; o.x = pk2(s[0 * 33], s[1 * 33]); o.y = pk2(s[2 * 33], s[3 * 33]); o.z = pk2(s[4 * 33], s[5 * 33]); o.w = pk2(s[6 * 33], s[7 * 33]);
        *(GAS v4u*)(WT + (size_t)(drow0 + n) * ldk + kcol + 8 * c) = o; }
    LDS_WAIT(); asm volatile("" ::: "memory");
}
template <int MAPID>
__device__ __forceinline__ void transpose_matrix(const float* W, int K, int N, bf16* WT, int ldk, int koff, int item_off, LAS float* scr, int gw, int NGW, int lane) {
    const int nblk = N / 32, nitems = (K / 64) * nblk;
    const __amdgpu_buffer_rsrc_t rsrc = __builtin_amdgcn_make_buffer_rsrc((void*)W, 0, K * N * 4, 0x00020000);
    const unsigned lane_off = (unsigned)((lane >> 5) * N + (lane & 31)) * 4u, rowstep = (unsigned)N * 8u;
    for (int it = ((gw - item_off) % NGW + NGW) % NGW; it < nitems; it += 2 * NGW) {
        const int itB = it + NGW; const bool hasB = itB < nitems;
        const int kA = 64 * (it / nblk), nA = 32 * (it % nblk), kB = hasB ? 64 * (itB / nblk) : 0, nB = hasB ? 32 * (itB % nblk) : 0;
        const unsigned offA = (unsigned)(kA * N + nA) * 4u + lane_off, offB = (unsigned)(kB * N + nB) * 4u + lane_off;
        float va[32], vb[32];
#pragma unroll
        for (int i = 0; i < 32; ++i) va[i] = __uint_as_float(__builtin_amdgcn_raw_buffer_load_b32(rsrc, offA, i * rowstep, 0));
        if (hasB) {
#pragma unroll
            for (int i = 0; i < 32; ++i) vb[i] = __uint_as_float(__builtin_amdgcn_raw_buffer_load_b32(rsrc, offB, i * rowstep, 0));
        }
        transpose_write(va, WT, ldk, koff + kA, maprow(MAPID, nA), scr, lane);
        if (hasB) transpose_write(vb, WT, ldk, koff + kB, maprow(MAPID, nB), scr, lane);
    }
}
__device__ __forceinline__ void modnorm_phase(const float* X, const float* g, const float* MOD, int sh_off, int sc_off, bf16* H, int gw, int NGW, int lane) {
    for (int it = gw; it < MT / 4; it += NGW) {
        const int row0 = it * 4, b = row0 / SEQ;
        f32x4 A[8], Bv[8];
#pragma unroll
        for (int j = 0; j < 8; ++j) { const int col = 4 * (lane + 64 * j);
            const f32x4 gg = *(const f32x4*)(g + col), sc = *(const f32x4*)(MOD + (size_t)b * NMOD + sc_off + col);
            A[j] = gg * (1.0f + sc); Bv[j] = *(const f32x4*)(MOD + (size_t)b * NMOD + sh_off + col); }
        for (int r = 0; r < 4; ++r) {
            const float* xr = X + (size_t)(row0 + r) * DM;
            f32x4 v[8]; float ss = 0.f;
#pragma unroll
            for (int j = 0; j < 8; ++j) { v[j] = *(const f32x4*)(xr + 4 * (lane + 64 * j)); ss += (v[j].x * v[j].x + v[j].y * v[j].y) + (v[j].z * v[j].z + v[j].w * v[j].w); }
            const float rstd = 1.0f / sqrtf(wave_sum(ss) * (1.0f / DM) + EPS);
            bf16* hr = H + (size_t)(row0 + r) * DM;
#pragma unroll
            for (int j = 0; j < 8; ++j) { const f32x4 o = v[j] * rstd * A[j] + Bv[j]; v2u w; w.x = pk2(o.x, o.y); w.y = pk2(o.z, o.w); *(GAS v2u*)(hr + 4 * (lane + 64 * j)) = w; }
        }
    }
}
__device__ __forceinline__ int crow(int r, int hi) { return (r & 3) + 8 * (r >> 2) + 4 * hi; }
constexpr int AT_KS = 0, AT_VT = 36864, AT_BIAS = AT_VT + 33792, AT_LSCR = AT_BIAS + 4096, AT_OSTG = AT_LSCR + 1024, AT_END = AT_OSTG + 8 * 4608;
static_assert(AT_END <= RING_BYTES, "attention LDS");
__device__ __forceinline__ float sum8_dpp(float v) {
    v += __uint_as_float(__builtin_amdgcn_update_dpp(0u, __float_as_uint(v), 0x141, 0xf, 0xf, false));
    v += __uint_as_float(__builtin_amdgcn_update_dpp(0u, __float_as_uint(v), 0xB1, 0xf, 0xf, false));
    v += __uint_as_float(__builtin_amdgcn_update_dpp(0u, __float_as_uint(v), 0x4E, 0xf, 0xf, false));
    return v;
}
__device__ __forceinline__ void attn_unit(int unit, const bf16* Qb, const bf16* Kb, const bf16* Vb, bf16* A2, const float* qg, const float* kg, const float* sinks, const float* relb,
                                          LAS unsigned char* lds, int tid, int lane, int wave) {
    const int b = unit >> 6, kvh = (unit >> 4) & 3, nb = unit & 15;
    LAS bf16* Ks = (LAS bf16*)(lds + AT_KS);
    LAS bf16* Vt = (LAS bf16*)(lds + AT_VT);
    LAS float* biasT = (LAS float*)(lds + AT_BIAS);
    LAS float* lscr = (LAS float*)(lds + AT_LSCR) + wave * 32;
    LAS bf16* ostg = (LAS bf16*)(lds + AT_OSTG) + wave * 2304;
    const int tok0 = b * SEQ + nb * 128;
    const int q = lane & 31, hi = lane >> 5;
    v4u qn[4];
    { const int pi = wave * 2, g = pi >> 2, qblk = pi & 3;
        const bf16* qrow = Qb + (size_t)(tok0 + qblk * 32 + q) * 1024 + (kvh * 4 + g) * 64 + hi * 8;
#pragma unroll
        for (int ks = 0; ks < 4; ++ks) qn[ks] = *(const v4u*)(qrow + 16 * ks); }
    v4u kw[4], vw[4];
#pragma unroll
    for (int i = 0; i < 4; ++i) { const int c = tid + 512 * i, key = c >> 3, part = c & 7;
        const bool real = (nb > 0) || (key >= 128);
        const long tok = (long)tok0 - 128 + key;
        kw[i] = (v4u){0u, 0u, 0u, 0u}; vw[i] = (v4u){0u, 0u, 0u, 0u};
        if (real) { kw[i] = *(const v4u*)(Kb + tok * 256 + kvh * 64 + part * 8); vw[i] = *(const v4u*)(Vb + tok * 256 + kvh * 64 + part * 8); } }
#pragma unroll
    for (int e = 0; e < 2; ++e) { const int idx = tid + 512 * e, g = idx >> 8, dist = (idx & 255) - 48; int bucket = dist < 0 ? 0 : (dist > 127 ? 127 : dist);
      if (bucket >= 16) { const int l = 16 + (int)(logf((float)bucket * (1.0f / 16.0f)) / 2.0794415416798357f * 16.0f); bucket = l < 31 ? l : 31; }
      biasT[idx] = (dist >= 0 && dist < 128) ? relb[bucket * 16 + kvh * 4 + g] * LOG2E : -INFINITY; }
    { const int part = tid & 7; const f32x4 kg0 = *(const f32x4*)(kg + part * 8), kg1 = *(const f32x4*)(kg + part * 8 + 4);
#pragma unroll
    for (int i = 0; i < 4; ++i) { const int key = (tid + 512 * i) >> 3;
        const f32x4 k0 = (f32x4){bflo(kw[i].x), bfhi(kw[i].x), bflo(kw[i].y), bfhi(kw[i].y)}, k1 = (f32x4){bflo(kw[i].z), bfhi(kw[i].z), bflo(kw[i].w), bfhi(kw[i].w)};
        const float ss = sum8_dpp((k0.x * k0.x + k0.y * k0.y) + (k0.z * k0.z + k0.w * k0.w) + (k1.x * k1.x + k1.y * k1.y) + (k1.z * k1.z + k1.w * k1.w));
        const float rstd = __builtin_amdgcn_rsqf(ss * (1.0f / 64.0f) + EPS);
        const f32x4 g0 = kg0 * rstd, g1 = kg1 * rstd;
        v4u o; o.x = pk2(k0.x * g0.x, k0.y * g0.y); o.y = pk2(k0.z * g0.z, k0.w * g0.w); o.z = pk2(k1.x * g1.x, k1.y * g1.y); o.w = pk2(k1.z * g1.z, k1.w * g1.w);
        *(LAS v4u*)(Ks + key * 72 + part * 8) = o;
        LAS bf16* vt = Vt + (part * 8) * 264 + key;
        vt[0 * 264] = (bf16)(vw[i].x & 0xffffu); vt[1 * 264] = (bf16)(vw[i].x >> 16); vt[2 * 264] = (bf16)(vw[i].y & 0xffffu); vt[3 * 264] = (bf16)(vw[i].y >> 16);
        vt[4 * 264] = (bf16)(vw[i].z & 0xffffu); vt[5 * 264] = (bf16)(vw[i].z >> 16); vt[6 * 264] = (bf16)(vw[i].w & 0xffffu); vt[7 * 264] = (bf16)(vw[i].w >> 16); } }
    __syncthreads();
#pragma unroll 1
    for (int pass = 0; pass < 2; ++pass) {
        const int pi = wave * 2 + pass, g = pi >> 2, qblk = pi & 3, h = kvh * 4 + g, q0 = qblk * 32;
        v4u qw[4];
#pragma unroll
        for (int ks = 0; ks < 4; ++ks) qw[ks] = qn[ks];
        if (pass == 0) { const int pi1 = pi + 1, g1 = pi1 >> 2, qblk1 = pi1 & 3;
            const bf16* qrow = Qb + (size_t)(tok0 + qblk1 * 32 + q) * 1024 + (kvh * 4 + g1) * 64 + hi * 8;
#pragma unroll
            for (int ks = 0; ks < 4; ++ks) qn[ks] = *(const v4u*)(qrow + 16 * ks); }
        float ss = 0.f;
#pragma unroll
        for (int ks = 0; ks < 4; ++ks) { const v4u w = qw[ks];
            const float a0 = bflo(w.x), a1 = bfhi(w.x), a2 = bflo(w.y), a3 = bfhi(w.y), a4 = bflo(w.z), a5 = bfhi(w.z), a6 = bflo(w.w), a7 = bfhi(w.w);
            ss += (a0 * a0 + a1 * a1) + (a2 * a2 + a3 * a3) + (a4 * a4 + a5 * a5) + (a6 * a6 + a7 * a7); }
        ss += __shfl_xor(ss, 32);
        const float rs = __builtin_amdgcn_rsqf(ss * (1.0f / 64.0f) + EPS) * (0.125f * LOG2E);
        bf16x8 qf[4];
#pragma unroll
        for (int ks = 0; ks < 4; ++ks) { const v4u w = qw[ks]; const f32x4 g0 = *(const f32x4*)(qg + 16 * ks + 8 * hi) * rs, g1 = *(const f32x4*)(qg + 16 * ks + 8 * hi + 4) * rs;
            v4u o; o.x = pk2(bflo(w.x) * g0.x, bfhi(w.x) * g0.y); o.y = pk2(bflo(w.y) * g0.z, bfhi(w.y) * g0.w);
            o.z = pk2(bflo(w.z) * g1.x, bfhi(w.z) * g1.y); o.w = pk2(bflo(w.w) * g1.z, bfhi(w.w) * g1.w);
            qf[ks] = __builtin_bit_cast(bf16x8, o); }
        f32x16 s[5];
#pragma unroll
        for (int tt = 0; tt < 5; ++tt) {
            s[tt] = (f32x16){0.f, 0.f, 0.f, 0.f, 0.f, 0.f, 0.f, 0.f, 0.f, 0.f, 0.f, 0.f, 0.f, 0.f, 0.f, 0.f};
            const LAS bf16* kp = Ks + (32 * (qblk + tt) + q) * 72 + 8 * hi;
#pragma unroll
            for (int ks = 0; ks < 4; ++ks) { const bf16x8 a = *(const LAS bf16x8*)(kp + 16 * ks); s[tt] = __builtin_amdgcn_mfma_f32_32x32x16_bf16(a, qf[ks], s[tt], 0, 0, 0); }
        }
        const float sk = sinks[h] * LOG2E;
        float mx = sk;
        const LAS float* btl = biasT + g * 256 + 48 + q - 4 * hi;
#pragma unroll
        for (int tt = 0; tt < 5; ++tt)
#pragma unroll
            for (int r = 0; r < 16; ++r) { const bool dead = (nb == 0) && (qblk + tt < 4);
                float v = s[tt][r] + btl[128 - 32 * tt - (r & 3) - 8 * (r >> 2)]; v = dead ? -INFINITY : v; s[tt][r] = v; mx = fmaxf(mx, v); }
        mx = fmaxf(mx, __shfl_xor(mx, 32));
        float l = 0.f;
#pragma unroll
        for (int tt = 0; tt < 5; ++tt)
#pragma unroll
            for (int r = 0; r < 16; ++r) { const float p = __builtin_amdgcn_exp2f(s[tt][r] - mx); s[tt][r] = p; l += p; }
        l += __shfl_xor(l, 32); l += __builtin_amdgcn_exp2f(sk - mx);
        f32x16 o[2];
        o[0] = (f32x16){0.f, 0.f, 0.f, 0.f, 0.f, 0.f, 0.f, 0.f, 0.f, 0.f, 0.f, 0.f, 0.f, 0.f, 0.f, 0.f}; o[1] = o[0];
#pragma unroll
        for (int tt = 0; tt < 5; ++tt)
#pragma unroll
            for (int s2 = 0; s2 < 2; ++s2) {
                v4u pw; pw.x = pk2(s[tt][8 * s2 + 0], s[tt][8 * s2 + 1]); pw.y = pk2(s[tt][8 * s2 + 2], s[tt][8 * s2 + 3]); pw.z = pk2(s[tt][8 * s2 + 4], s[tt][8 * s2 + 5]); pw.w = pk2(s[tt][8 * s2 + 6], s[tt][8 * s2 + 7]);
                const bf16x8 pa = __builtin_bit_cast(bf16x8, pw);
#pragma unroll
                for (int dt = 0; dt < 2; ++dt) { const LAS bf16* vp = Vt + (32 * dt + q) * 264 + 32 * (qblk + tt) + 16 * s2 + 4 * hi;
                    const s16x4 lo = *(const LAS s16x4*)vp, hh = *(const LAS s16x4*)(vp + 8);
                    const bf16x8 vb = (bf16x8){lo[0], lo[1], lo[2], lo[3], hh[0], hh[1], hh[2], hh[3]};
                    o[dt] = __builtin_amdgcn_mfma_f32_32x32x16_bf16(pa, vb, o[dt], 0, 0, 0); }
            }
        if (hi == 0) lscr[q] = __builtin_amdgcn_rcpf(l);
        LDS_WAIT();
#pragma unroll
        for (int r = 0; r < 16; ++r) { const int cr = crow(r, hi); const float li = lscr[cr];
            ostg[cr * 72 + q] = (bf16)f2bf(o[0][r] * li); ostg[cr * 72 + 32 + q] = (bf16)f2bf(o[1][r] * li); }
        LDS_WAIT();
        bf16* orow = A2 + (size_t)(tok0 + q0) * 2048 + h * 64;
#pragma unroll
        for (int i = 0; i < 4; ++i) { const int row = i * 8 + (lane >> 3), ch = lane & 7; const v4u v = *(const LAS v4u*)(ostg + row * 72 + ch * 8); *(GAS v4u*)(orow + (size_t)row * 2048 + ch * 8) = v; }
        LDS_WAIT();
    }
}
constexpr int CV_RED = RING_BYTES + 1024;
__device__ __forceinline__ void conv_unit(int unit, const bf16* U, bf16* A2, const float* cw, const float* cb, const float* lg, const float* lb, LAS unsigned char* lds, int tid, int lane, int wave) {
    const int b = unit >> 6, t0 = (unit & 63) * 32;
    LAS unsigned* Us = (LAS unsigned*)lds;
    LAS float* red = (LAS float*)(lds + CV_RED);
    const __amdgpu_buffer_rsrc_t ursrc = __builtin_amdgcn_make_buffer_rsrc((void*)(U + (size_t)b * SEQ * 1024), 0, SEQ * 1024 * 2, 0x00020000);
    const __amdgpu_buffer_rsrc_t wrsrc = __builtin_amdgcn_make_buffer_rsrc((void*)cw, 0, 31 * 1024 * 4, 0x00020000);
    const int rr0 = tid >> 7, cc = tid & 127;
    v4u st[16];
#pragma unroll
    for (int i = 0; i < 16; ++i) { const int t = t0 - 30 + rr0 + 4 * i; const unsigned voff = t >= 0 ? (unsigned)(t * 2048 + cc * 16) : 0xfffffff0u;
        st[i] = __builtin_amdgcn_raw_buffer_load_b128(ursrc, voff, 0, 0); }
    f32x2 w2[31];
#pragma unroll
    for (int j = 0; j < 31; ++j) w2[j] = __builtin_bit_cast(f32x2, __builtin_amdgcn_raw_buffer_load_b64(wrsrc, tid * 8, j * 4096, 0));
    const f32x2 bb = *(const f32x2*)(cb + 2 * tid), gg = *(const f32x2*)(lg + 2 * tid), be = *(const f32x2*)(lb + 2 * tid);
    if (tid < 64) red[tid] = 0.f;
#pragma unroll
    for (int i = 0; i < 16; ++i) *(LAS v4u*)(Us + (rr0 + 4 * i) * 512 + cc * 4) = st[i];
    __syncthreads();
#pragma unroll 1
    for (int cq = 0; cq < 2; ++cq) {
        f32x2 a[16];
#pragma unroll
        for (int i = 0; i < 16; ++i) a[i] = bb;
        const LAS unsigned* up = Us + (16 * cq) * 512 + tid;
#pragma unroll
        for (int r = 0; r < 46; ++r) { const unsigned uu = up[r * 512]; const f32x2 u2 = (f32x2){bflo(uu), bfhi(uu)};
#pragma unroll
            for (int i = 0; i < 16; ++i) { const int j = r - i; if (j >= 0 && j <= 30) a[i] += u2 * w2[j]; } }
        float v[32];
#pragma unroll
        for (int i = 0; i < 16; ++i) { v[i] = a[i].x + a[i].y; v[16 + i] = a[i].x * a[i].x + a[i].y * a[i].y; }
#pragma unroll
        for (int j = 0; j < 16; ++j) { const bool up_ = (lane & 32) != 0; const float send = up_ ? v[j] : v[j + 16], keep = up_ ? v[j + 16] : v[j]; v[j] = keep + __shfl_xor(send, 32); }
#pragma unroll
        for (int j = 0; j < 8; ++j) { const bool up_ = (lane & 16) != 0; const float send = up_ ? v[j] : v[j + 8], keep = up_ ? v[j + 8] : v[j]; v[j] = keep + __shfl_xor(send, 16); }
#pragma unroll
        for (int j = 0; j < 4; ++j) { const bool up_ = (lane & 8) != 0; const float send = up_ ? v[j] : v[j + 4], keep = up_ ? v[j + 4] : v[j]; v[j] = keep + __shfl_xor(send, 8); }
#pragma unroll
        for (int j = 0; j < 2; ++j) { const bool up_ = (lane & 4) != 0; const float send = up_ ? v[j] : v[j + 2], keep = up_ ? v[j + 2] : v[j]; v[j] = keep + __shfl_xor(send, 4); }
        { const bool up_ = (lane & 2) != 0; const float send = up_ ? v[0] : v[1], keep = up_ ? v[1] : v[0]; v[0] = keep + __shfl_xor(send, 2); }
        v[0] += __shfl_xor(v[0], 1);
        if ((lane & 1) == 0) __hip_atomic_fetch_add(red + cq * 32 + ((lane >> 5) & 1) * 16 + ((lane >> 4) & 1) * 8 + ((lane >> 3) & 1) * 4 + ((lane >> 2) & 1) * 2 + ((lane >> 1) & 1), v[0], __ATOMIC_RELAXED, __HIP_MEMORY_SCOPE_WORKGROUP);
        __syncthreads();
        f32x4 tt[8];
#pragma unroll
        for (int i = 0; i < 8; ++i) tt[i] = *(const LAS f32x4*)(red + cq * 32 + 4 * i);
#pragma unroll
        for (int i = 0; i < 16; ++i) { const float mean = tt[i >> 2][i & 3] * (1.0f / 1024.0f), var = tt[4 + (i >> 2)][i & 3] * (1.0f / 1024.0f) - mean * mean, rstd = __builtin_amdgcn_rsqf(var + EPS);
            float y0 = (a[i].x - mean) * rstd * gg.x + be.x, y1 = (a[i].y - mean) * rstd * gg.y + be.y;
            y0 *= sigm(y0); y1 *= sigm(y1);
            *(GAS unsigned*)(A2 + (size_t)(b * SEQ + t0 + 16 * cq + i) * 2048 + 1024 + 2 * tid) = pk2(y0, y1); }
    }
}

struct Args { const float* in[20]; float* out; unsigned char* ws; int ph_lo, ph_hi; };
__global__ void __launch_bounds__(NWAVES * 64, 2) fwd_kernel(Args args) {
    extern __shared__ __attribute__((aligned(16))) unsigned char lds_raw[];
    LAS unsigned char* lds = (LAS unsigned char*)lds_raw;
    volatile LAS unsigned* MISC = (volatile LAS unsigned*)(lds + MISC_OFF);
    const int tid = threadIdx.x, lane = tid & 63, wave = __builtin_amdgcn_readfirstlane(tid >> 6);
    const int G = gridDim.x, bx = blockIdx.x;
    const int vcu = (G % 8 == 0) ? (bx % 8) * (G / 8) + bx / 8 : bx;
    const int gw = vcu * NWAVES + wave, NGW = G * NWAVES;
#define P_ws (args.ws)
#define P_x (args.in[0])
#define P_c_in (args.in[1])
#define P_w_ada (args.in[2])
#define P_b_ada (args.in[3])
#define P_norm_mix_g (args.in[4])
#define P_w_in (args.in[5])
#define P_q_norm_g (args.in[6])
#define P_k_norm_g (args.in[7])
#define P_attn_sinks (args.in[8])
#define P_rel_bias (args.in[9])
#define P_w_attn_out (args.in[10])
#define P_conv_w (args.in[11])
#define P_conv_b (args.in[12])
#define P_conv_ln_g (args.in[13])
#define P_conv_ln_b (args.in[14])
#define P_w_conv_out (args.in[15])
#define P_w_mix_out (args.in[16])
#define P_norm_ffn_g (args.in[17])
#define P_w_ffn_in (args.in[18])
#define P_w_ffn_out (args.in[19])
#define P_out (args.out)
#define P_MOD ((float*)(P_ws + WS_MOD))
#define P_W1T ((bf16*)(P_ws + WS_W1T))
#define P_W2T ((bf16*)(P_ws + WS_W2T))
#define P_W3T ((bf16*)(P_ws + WS_W3T))
#define P_W4T ((bf16*)(P_ws + WS_W4T))
#define P_W5T ((bf16*)(P_ws + WS_W5T))
#define P_H ((bf16*)(P_ws + WS_H))
#define P_Qb ((bf16*)(P_ws + WS_Q))
#define P_Kb ((bf16*)(P_ws + WS_K))
#define P_Vb ((bf16*)(P_ws + WS_V))
#define P_Ub ((bf16*)(P_ws + WS_U))
#define P_Rb ((bf16*)(P_ws + WS_R))
#define P_GCb ((bf16*)(P_ws + WS_GC))
#define P_A2 ((bf16*)(P_ws + WS_A2))
#define P_MG ((bf16*)(P_ws + WS_MG))
#define P_HF ((bf16*)(P_ws + WS_HF))

    for (int u = tid; u < (LDS_BYTES - LDSCTL_OFF) / 4; u += NWAVES * 64) ((LAS unsigned*)(lds + LDSCTL_OFF))[u] = 0u;
    __syncthreads();
    const int lo = args.ph_lo, hi = args.ph_hi;
#if !MK_CG_SYNC
    XcdBarrier bar; bar.bar = (unsigned*)(P_ws + WS_CTL) + CW_BAR; bar.x = 0; bar.st = nullptr;
    if (hi - lo > 1) bar = xcd_barrier_post((unsigned*)(P_ws + WS_CTL) + CW_BAR, MISC + 8);
    if (lo < 0) cg::this_grid().sync();
#else
    (void)MISC;
#endif
#ifdef PHASE_MASK
#define IN(k) (((PHASE_MASK >> (k)) & 1) && lo <= (k) && (k) < hi)
#else
#define IN(k) (lo <= (k) && (k) < hi)
#endif
#define BOTH(k) (IN(k) && IN((k) + 1))
#ifndef REPEAT_MASK
#define REPEAT_MASK 0
#endif
#if MK_CG_SYNC
#define GRID_BAR(k) do { if (BOTH(k)) cg::this_grid().sync(); } while (0)
#else
#define GRID_BAR(k) do { if (BOTH(k)) xcd_barrier(bar); } while (0)
#endif

    if (IN(0)) {
        p0_adaln(P_c_in, P_w_ada, P_b_ada, P_MOD, (LAS float*)lds, tid, lane, wave);
        LAS float* scr = (LAS float*)(lds + wave * 16384);
        constexpr int I0 = 32 * 240, I1 = 16 * 64, I2 = 16 * 64, I3 = 32 * 64, I4 = 32 * 352;
        transpose_matrix<1>(P_w_in, DM, N1, P_W1T, 2048, 0, 0, scr, gw, NGW, lane);
        transpose_matrix<0>(P_w_attn_out, 1024, DM, P_W2T, 2048, 0, I0, scr, gw, NGW, lane);
        transpose_matrix<0>(P_w_conv_out, 1024, DM, P_W2T, 2048, 1024, I0 + I1, scr, gw, NGW, lane);
        transpose_matrix<0>(P_w_mix_out, DM, DM, P_W3T, 2048, 0, I0 + I1 + I2, scr, gw, NGW, lane);
        transpose_matrix<2>(P_w_ffn_in, DM, N4, P_W4T, 2048, 0, I0 + I1 + I2 + I3, scr, gw, NGW, lane);
        transpose_matrix<0>(P_w_ffn_out, DFF, DM, P_W5T, DFF, 0, I0 + I1 + I2 + I3 + I4, scr, gw, NGW, lane);
#if REPEAT_MASK & 1
        transpose_matrix<1>(P_w_in, DM, N1, P_W1T, 2048, 0, 0, scr, gw, NGW, lane);
        transpose_matrix<0>(P_w_attn_out, 1024, DM, P_W2T, 2048, 0, I0, scr, gw, NGW, lane);
        transpose_matrix<0>(P_w_conv_out, 1024, DM, P_W2T, 2048, 1024, I0 + I1, scr, gw, NGW, lane);
        transpose_matrix<0>(P_w_mix_out, DM, DM, P_W3T, 2048, 0, I0 + I1 + I2, scr, gw, NGW, lane);
        transpose_matrix<2>(P_w_ffn_in, DM, N4, P_W4T, 2048, 0, I0 + I1 + I2 + I3, scr, gw, NGW, lane);
        transpose_matrix<0>(P_w_ffn_out, DFF, DM, P_W5T, DFF, 0, I0 + I1 + I2 + I3 + I4, scr, gw, NGW, lane);
#endif
        GRID_BAR(0);
    }
#if (REPEAT_MASK >> 1) & 1
    if (IN(1)) { modnorm_phase(P_x, P_norm_mix_g, P_MOD, 0, DM, P_H, gw, NGW, lane); xcd_barrier(bar); }
#endif
    if (IN(1)) { modnorm_phase(P_x, P_norm_mix_g, P_MOD, 0, DM, P_H, gw, NGW, lane); GRID_BAR(1); }
    if (IN(2)) {
        pg8::Gemm g{P_H, P_W1T, MT, N1, DM}; pg8::StaticOrder S; S.init(MT, N1, G, bx);
        pg8::Epi1 E{P_Qb, P_Ub, P_Rb, P_GCb};
        pg8::gemm_phase<pg8::Epi1, pg8::StaticOrder, true, true>(lds, g, S, E);
        GRID_BAR(2);
    }
#if (REPEAT_MASK >> 2) & 1
    if (IN(2)) {
        pg8::Gemm g{P_H, P_W1T, MT, N1, DM}; pg8::StaticOrder S; S.init(MT, N1, G, bx);
        pg8::Epi1 E{P_Qb, P_Ub, P_Rb, P_GCb};
        pg8::gemm_phase<pg8::Epi1, pg8::StaticOrder, true, true>(lds, g, S, E);
        GRID_BAR(2);
    }
#endif
    if (IN(3)) {
#ifndef NO_ATTN
        for (int u = bx; u < 256; u += G) { attn_unit(u, P_Qb, P_Kb, P_Vb, P_A2, P_q_norm_g, P_k_norm_g, P_attn_sinks, P_rel_bias, lds, tid, lane, wave); __syncthreads(); }
#endif
#ifndef NO_CONV
        for (int u = bx; u < 256; u += G) { conv_unit(u, P_Ub, P_A2, P_conv_w, P_conv_b, P_conv_ln_g, P_conv_ln_b, lds, tid, lane, wave); __syncthreads(); }
#endif
        GRID_BAR(3);
    }
#if (REPEAT_MASK >> 3) & 1
    if (IN(3)) {
#ifndef NO_ATTN
        for (int u = bx; u < 256; u += G) { attn_unit(u, P_Qb, P_Kb, P_Vb, P_A2, P_q_norm_g, P_k_norm_g, P_attn_sinks, P_rel_bias, lds, tid, lane, wave); __syncthreads(); }
#endif
#ifndef NO_CONV
        for (int u = bx; u < 256; u += G) { conv_unit(u, P_Ub, P_A2, P_conv_w, P_conv_b, P_conv_ln_g, P_conv_ln_b, lds, tid, lane, wave); __syncthreads(); }
#endif
        GRID_BAR(3);
    }
#endif
    if (IN(4)) {
        pg8::Gemm g{P_A2, P_W2T, MT, DM, DM}; pg8::StaticOrder S; S.init(MT, DM, G, bx);
        pg8::Epi2 E{P_Rb, P_GCb, P_MG};
        pg8::gemm_phase<pg8::Epi2, pg8::StaticOrder, true, true>(lds, g, S, E);
        GRID_BAR(4);
    }
#if (REPEAT_MASK >> 4) & 1
    if (IN(4)) {
        pg8::Gemm g{P_A2, P_W2T, MT, DM, DM}; pg8::StaticOrder S; S.init(MT, DM, G, bx);
        pg8::Epi2 E{P_Rb, P_GCb, P_MG};
        pg8::gemm_phase<pg8::Epi2, pg8::StaticOrder, true, true>(lds, g, S, E);
        GRID_BAR(4);
    }
#endif
    if (IN(5)) {
        pg8::Gemm g{P_MG, P_W3T, MT, DM, DM}; pg8::StaticOrder S; S.init(MT, DM, G, bx);
        pg8::EpiRes E{P_x, P_out, P_MOD + 2 * DM};
        pg8::gemm_phase<pg8::EpiRes, pg8::StaticOrder, true, true>(lds, g, S, E);
        GRID_BAR(5);
    }
#if (REPEAT_MASK >> 5) & 1
    if (IN(5)) {
        pg8::Gemm g{P_MG, P_W3T, MT, DM, DM}; pg8::StaticOrder S; S.init(MT, DM, G, bx);
        pg8::EpiRes E{P_x, P_out, P_MOD + 2 * DM};
        pg8::gemm_phase<pg8::EpiRes, pg8::StaticOrder, true, true>(lds, g, S, E);
        GRID_BAR(5);
    }
#endif
#if (REPEAT_MASK >> 6) & 1
    if (IN(6)) { modnorm_phase(P_out, P_norm_ffn_g, P_MOD, 3 * DM, 4 * DM, P_H, gw, NGW, lane); xcd_barrier(bar); }
#endif
    if (IN(6)) { modnorm_phase(P_out, P_norm_ffn_g, P_MOD, 3 * DM, 4 * DM, P_H, gw, NGW, lane); GRID_BAR(6); }
    if (IN(7)) {
        pg8::Gemm g{P_H, P_W4T, MT, N4, DM}; pg8::StaticOrder S; S.init(MT, N4, G, bx);
        pg8::Epi4 E{P_HF};
        pg8::gemm_phase<pg8::Epi4, pg8::StaticOrder, true, true>(lds, g, S, E);
        GRID_BAR(7);
    }
#if (REPEAT_MASK >> 7) & 1
    if (IN(7)) {
        pg8::Gemm g{P_H, P_W4T, MT, N4, DM}; pg8::StaticOrder S; S.init(MT, N4, G, bx);
        pg8::Epi4 E{P_HF};
        pg8::gemm_phase<pg8::Epi4, pg8::StaticOrder, true, true>(lds, g, S, E);
        GRID_BAR(7);
    }
#endif
#if (REPEAT_MASK >> 8) & 1
    if (IN(8)) {
        pg8::Gemm g{P_HF, P_W5T, MT, DM, DFF}; pg8::StaticOrder S; S.init(MT, DM, G, bx);
        pg8::EpiRes E{P_out, (float*)(P_ws + WS_A2), P_MOD + 5 * DM};
        pg8::gemm_phase<pg8::EpiRes, pg8::StaticOrder, true, true>(lds, g, S, E);
        xcd_barrier(bar);
    }
#endif
    if (IN(8)) {
        pg8::Gemm g{P_HF, P_W5T, MT, DM, DFF}; pg8::StaticOrder S; S.init(MT, DM, G, bx);
        pg8::EpiRes E{P_out, P_out, P_MOD + 5 * DM};
        pg8::gemm_phase<pg8::EpiRes, pg8::StaticOrder, true, true>(lds, g, S, E);
    }
#undef IN
#undef BOTH
#undef GRID_BAR
}
#undef P_ws
#undef P_x
#undef P_c_in
#undef P_w_ada
#undef P_b_ada
#undef P_norm_mix_g
#undef P_w_in
#undef P_q_norm_g
#undef P_k_norm_g
#undef P_attn_sinks
#undef P_rel_bias
#undef P_w_attn_out
#undef P_conv_w
#undef P_conv_b
#undef P_conv_ln_g
#undef P_conv_ln_b
#undef P_w_conv_out
#undef P_w_mix_out
#undef P_norm_ffn_g
#undef P_w_ffn_in
#undef P_w_ffn_out
#undef P_out
#undef P_MOD
#undef P_W1T
#undef P_W2T
#undef P_W3T
#undef P_W4T
#undef P_W5T
#undef P_H
#undef P_Qb
#undef P_Kb
#undef P_Vb
#undef P_Ub
#undef P_Rb
#undef P_GCb
#undef P_A2
#undef P_MG
#undef P_HF

extern "C" void kernel_launch(void* const* d_in, const int* in_sizes, int n_in, void* d_out, int out_size, void* d_ws, size_t ws_size, hipStream_t stream) {
    static int grid = 0;
    if (grid == 0) {
        if (n_in != 20 || in_sizes[0] != MT * DM || out_size != MT * DM || ws_size < WS_END) {
            fprintf(stderr, "kernel_launch: shape/workspace mismatch (n_in %d, in0 %d, out %d, ws %zu, need %zu); nothing launched\n", n_in, n_in > 0 ? in_sizes[0] : -1, out_size, ws_size, (size_t)WS_END); grid = -1; return; }
        int dev = 0, cus = 0, per_cu = 0;
        if (hipGetDevice(&dev) != hipSuccess || hipDeviceGetAttribute(&cus, hipDeviceAttributeMultiprocessorCount, dev) != hipSuccess) { fprintf(stderr, "kernel_launch: device query failed\n"); grid = -1; return; }
        if (hipFuncSetAttribute((const void*)fwd_kernel, hipFuncAttributeMaxDynamicSharedMemorySize, LDS_BYTES) != hipSuccess) { fprintf(stderr, "kernel_launch: hipFuncSetAttribute failed\n"); grid = -1; return; }
        if (hipOccupancyMaxActiveBlocksPerMultiprocessor(&per_cu, (const void*)fwd_kernel, NWAVES * 64, LDS_BYTES) != hipSuccess || per_cu < 1) { fprintf(stderr, "kernel_launch: occupancy query says %d blocks per CU\n", per_cu); per_cu = 1; }
        (void)hipGetLastError();
        grid = cus * (per_cu < 1 ? 1 : 1);
        if (grid != 256) fprintf(stderr, "kernel_launch: note: grid = %d workgroups\n", grid);
    }
    if (grid < 0) return;
    if (hipMemsetAsync((char*)d_ws + WS_CTL, 0, CTL_ZERO_BYTES, stream) != hipSuccess) { fprintf(stderr, "kernel_launch: memset failed\n"); return; }
    Args a{};
    for (int i = 0; i < 20; ++i) a.in[i] = (const float*)d_in[i];
    a.out = (float*)d_out; a.ws = (unsigned char*)d_ws;
#if MK_PER_PHASE
    for (int ph = 0; ph < N_PHASES; ++ph) { a.ph_lo = ph; a.ph_hi = ph + 1; hipLaunchKernelGGL(fwd_kernel, dim3(grid), dim3(NWAVES * 64), LDS_BYTES, stream, a); }
#else
    a.ph_lo = 0; a.ph_hi = N_PHASES;
    void* kargs[] = {(void*)&a};
    const hipError_t e = hipLaunchCooperativeKernel((const void*)fwd_kernel, dim3(grid), dim3(NWAVES * 64), kargs, LDS_BYTES, stream);
    if (e != hipSuccess) fprintf(stderr, "kernel_launch: cooperative launch failed: %s (grid %d)\n", hipGetErrorString(e), grid);
#endif
}
```

```cpp
#include <hip/hip_runtime.h>
#include <hip/hip_cooperative_groups.h>
#include <cstdio>
#include <cstdint>
namespace cg = cooperative_groups;

#ifndef MK_PER_PHASE
#define MK_PER_PHASE 0
#endif
#ifndef MK_CG_SYNC
#define MK_CG_SYNC 0
#endif

namespace pg8 {
#define PG8_LAS __attribute__((address_space(3)))
typedef unsigned short bf16_t;
typedef short bf16x8 __attribute__((ext_vector_type(8)));
typedef float f32x4 __attribute__((ext_vector_type(4)));
typedef unsigned u32x4 __attribute__((ext_vector_type(4)));
constexpr int BM = 256, BK = 64, HALF = 128, HTB = HALF * BK * 2  , STAGE_BYTES = 8 * HTB, NXCD = 8, WGM = 8;

__host__ __device__ __forceinline__ int lds_byte(int r, int c) { const int st = (r >> 4) * 2 + (c >> 5), rr = r & 15, cc = c & 31, ob = rr * 64 + cc * 2; return st * 1024 + (ob ^ (((ob >> 9) & 1) << 5)); }
__host__ __device__ __forceinline__ void stage_rc(int b, int& R, int& C) { const int st = b / 1024, sb = b % 1024, swz = sb ^ (((sb >> 9) & 1) << 5); R = (st >> 1) * 16 + swz / 64; C = (st & 1) * 32 + (swz % 64) / 2; }
__host__ __device__ __forceinline__ int perm32(int rho) { const int n = rho >> 4, i = rho & 15; return 8 * (i >> 2) + 4 * n + (i & 3); }

struct Unit { int pm, pn; };
struct Gemm { const bf16_t* A; const bf16_t* Bt; int M, N, K; };

struct StaticOrder {
    int nM, nN, nwg, G, c;
    __host__ __device__ void init(int M, int N, int G_, int c_) { nM = M / BM; nN = N / BM; nwg = nM * nN; G = G_; c = c_; }
    __host__ __device__ bool next(int i, Unit& u) const {
        const long L = (long)i * G + c; if (L >= nwg) return false;
        int wgid = (int)L; { const int q = nwg / NXCD, r = nwg % NXCD, xcd = wgid % NXCD, off = wgid / NXCD; wgid = (xcd < r ? xcd * (q + 1) : r * (q + 1) + (xcd - r) * q) + off; }
        const int nig = WGM * nN, gid = wgid / nig, fm = gid * WGM, gsz = (nM - fm) < WGM ? (nM - fm) : WGM;
        u.pm = fm + ((wgid % nig) % gsz); u.pn = (wgid % nig) / gsz; return true;
    }
    __device__ __forceinline__ void a_ready(const Unit&) const {}
    __device__ __forceinline__ void done(const Unit&) const {}
};


__device__ __forceinline__ unsigned cvt_pk_bf16(float lo, float hi) { unsigned r; asm volatile("v_cvt_pk_bf16_f32 %0, %1, %2" : "=v"(r) : "v"(lo), "v"(hi)); return r; }
__device__ __forceinline__ float sigm(float x) { return __builtin_amdgcn_rcpf(1.0f + __builtin_amdgcn_exp2f(-1.4426950408889634f * x)); }
__device__ __forceinline__ u32x4 pack8(const f32x4& v0, const f32x4& v1) { u32x4 w; w.x = cvt_pk_bf16(v0[0], v0[1]); w.y = cvt_pk_bf16(v0[2], v0[3]); w.z = cvt_pk_bf16(v1[0], v1[1]); w.w = cvt_pk_bf16(v1[2], v1[3]); return w; }
__device__ __forceinline__ void unpack8(const u32x4& w, f32x4& v0, f32x4& v1) {
    v0[0] = __uint_as_float(w.x << 16); v0[1] = __uint_as_float(w.x & 0xffff0000u); v0[2] = __uint_as_float(w.y << 16); v0[3] = __uint_as_float(w.y & 0xffff0000u);
    v1[0] = __uint_as_float(w.z << 16); v1[1] = __uint_as_float(w.z & 0xffff0000u); v1[2] = __uint_as_float(w.w << 16); v1[3] = __uint_as_float(w.w & 0xffff0000u); }

struct Epi1 {
    static constexpr bool PERM = true, AFTER_DRAIN = false, MID = false;
    bf16_t *Q, *U, *R, *GC;
    __device__ __forceinline__ void mid(f32x4 (&)[2][2][4][2], const Unit&, int, int, int, int) const {}
    __device__ __forceinline__ void operator()(const f32x4 (&acc)[2][2][4][2], const Unit& u, int wr, int wc, int fr, int fq) const {
        const int row0 = u.pm * BM + wr * 64 + fr, cl = wc * 32 + 8 * fq;
        if (u.pn < 6) {
            const size_t boff = u.pn < 4 ? (size_t)0 : (u.pn == 4 ? (size_t)8388608 : (size_t)10485760);
            bf16_t* base = Q + boff; const int ld = u.pn < 4 ? 1024 : 256, c0 = u.pn < 4 ? u.pn * 256 : 0;
#pragma unroll
            for (int ai = 0; ai < 2; ++ai)
#pragma unroll
                for (int m = 0; m < 4; ++m) { bf16_t* rowp = base + (size_t)(row0 + ai * HALF + m * 16) * ld + c0 + cl;
#pragma unroll
                    for (int bj = 0; bj < 2; ++bj) *(u32x4*)(rowp + bj * HALF) = pack8(acc[ai][bj][m][0], acc[ai][bj][m][1]); }
        } else if (u.pn < 14) {
            const int c0 = (u.pn - 6) * 128 + cl;
#pragma unroll
            for (int ai = 0; ai < 2; ++ai)
#pragma unroll
                for (int m = 0; m < 4; ++m) { f32x4 o[2];
#pragma unroll
                    for (int n = 0; n < 2; ++n)
#pragma unroll
                        for (int e = 0; e < 4; ++e) o[n][e] = acc[ai][0][m][n][e] * sigm(acc[ai][1][m][n][e]);
                    *(u32x4*)(U + (size_t)(row0 + ai * HALF + m * 16) * 1024 + c0) = pack8(o[0], o[1]); }
        } else {
            const int c0 = (u.pn - 14) * 128 + cl;
#pragma unroll
            for (int ai = 0; ai < 2; ++ai)
#pragma unroll
                for (int m = 0; m < 4; ++m) { f32x4 r[2], g[2];
#pragma unroll
                    for (int n = 0; n < 2; ++n)
#pragma unroll
                        for (int e = 0; e < 4; ++e) { const float ea = __builtin_amdgcn_exp2f(-1.4426950408889634f * acc[ai][0][m][n][e]), ec = __builtin_amdgcn_exp2f(-1.4426950408889634f * acc[ai][1][m][n][e]);
                            g[n][e] = __builtin_amdgcn_rcpf(1.0f + ec); r[n][e] = (1.0f + ec) * __builtin_amdgcn_rcpf(1.0f + ea); }
                    const size_t off = (size_t)(row0 + ai * HALF + m * 16) * 2048 + c0;
                    *(u32x4*)(R + off) = pack8(r[0], r[1]); *(u32x4*)(GC + off) = pack8(g[0], g[1]); }
        }
    }
};
struct Epi2 {
    static constexpr bool PERM = true, AFTER_DRAIN = false, MID = true;
    const bf16_t *R, *GC; bf16_t* O;
    __device__ __forceinline__ void mid(f32x4 (&acc)[2][2][4][2], const Unit& u, int wr, int wc, int fr, int fq) const {
        asm volatile("" : "+v"(fr), "+v"(fq));
        const int row0 = u.pm * BM + wr * 64 + fr, col0 = u.pn * BM + wc * 32 + 8 * fq;
#pragma unroll
        for (int ai = 0; ai < 2; ++ai)
#pragma unroll
            for (int m = 0; m < 4; ++m) { const bf16_t* rowp = R + (size_t)(row0 + ai * HALF + m * 16) * 2048 + col0;
#pragma unroll
                for (int bj = 0; bj < 2; ++bj) { const u32x4 w = *(const u32x4*)(rowp + bj * HALF); f32x4 s0, s1; unpack8(w, s0, s1); acc[ai][bj][m][0] *= s0; acc[ai][bj][m][1] *= s1; }
                if (m & 1) asm volatile("" ::: "memory"); }
    }
    __device__ __forceinline__ void operator()(const f32x4 (&acc)[2][2][4][2], const Unit& u, int wr, int wc, int fr, int fq) const {
        const int row0 = u.pm * BM + wr * 64 + fr, col0 = u.pn * BM + wc * 32 + 8 * fq;
#pragma unroll
        for (int ai = 0; ai < 2; ++ai)
#pragma unroll
            for (int m = 0; m < 4; ++m) { const size_t off = (size_t)(row0 + ai * HALF + m * 16) * 2048 + col0;
#pragma unroll
                for (int bj = 0; bj < 2; ++bj) { const u32x4 w = *(const u32x4*)(GC + off + bj * HALF); f32x4 s0, s1; unpack8(w, s0, s1);
                    *(u32x4*)(O + off + bj * HALF) = pack8(acc[ai][bj][m][0] * s0, acc[ai][bj][m][1] * s1); }
                if (m & 1) asm volatile("" ::: "memory"); }
    }
};
struct EpiRes {
    static constexpr bool PERM = false, AFTER_DRAIN = false, MID = false;
    const float* base; float* out; const float* gate;
    __device__ __forceinline__ void mid(f32x4 (&)[2][2][4][2], const Unit&, int, int, int, int) const {}
    __device__ __forceinline__ void operator()(const f32x4 (&acc)[2][2][4][2], const Unit& u, int wr, int wc, int fr, int fq) const {
        const int row0 = u.pm * BM + wr * 64 + fr, col0 = u.pn * BM + wc * 32 + 4 * fq;
        const float* gp = gate + (size_t)(u.pm >> 3) * 12288 + col0;
        f32x4 gv[2][2];
#pragma unroll
        for (int bj = 0; bj < 2; ++bj)
#pragma unroll
            for (int n = 0; n < 2; ++n) gv[bj][n] = *(const f32x4*)(gp + bj * HALF + n * 16);
#pragma unroll
        for (int ai = 0; ai < 2; ++ai)
#pragma unroll
            for (int m = 0; m < 4; ++m) { const size_t off = (size_t)(row0 + ai * HALF + m * 16) * 2048 + col0;
#pragma unroll
                for (int bj = 0; bj < 2; ++bj)
#pragma unroll
                    for (int n = 0; n < 2; ++n) { const f32x4 b = *(const f32x4*)(base + off + bj * HALF + n * 16); *(f32x4*)(out + off + bj * HALF + n * 16) = b + gv[bj][n] * acc[ai][bj][m][n]; } }
    }
};
struct Epi4 {
    static constexpr bool PERM = true, AFTER_DRAIN = false, MID = false;
    bf16_t* HF;
    __device__ __forceinline__ void mid(f32x4 (&)[2][2][4][2], const Unit&, int, int, int, int) const {}
    __device__ __forceinline__ void operator()(const f32x4 (&acc)[2][2][4][2], const Unit& u, int wr, int wc, int fr, int fq) const {
        const int row0 = u.pm * BM + wr * 64 + fr, c0 = u.pn * 128 + wc * 32 + 8 * fq;
#pragma unroll
        for (int ai = 0; ai < 2; ++ai)
#pragma unroll
            for (int m = 0; m < 4; ++m) { f32x4 o[2];
#pragma unroll
                for (int n = 0; n < 2; ++n)
#pragma unroll
                    for (int e = 0; e < 4; ++e) { const float g = acc[ai][0][m][n][e]; o[n][e] = g * sigm(g) * acc[ai][1][m][n][e]; }
                *(u32x4*)(HF + (size_t)(row0 + ai * HALF + m * 16) * 5632 + c0) = pack8(o[0], o[1]); }
    }
};

template <class Epi, class Sched, bool ALIGN_EPI = false, bool SP2 = false>
__device__ __forceinline__ void gemm_phase(PG8_LAS unsigned char* lds, const Gemm g, const Sched& S, const Epi& E) {
    const int tid = threadIdx.x, wid = __builtin_amdgcn_readfirstlane(tid >> 6), lane = tid & 63, wr = wid >> 2, wc = wid & 3, fr = lane & 15, fq = lane >> 4;
    const int K = g.K, nt = K / BK;
    unsigned voffA[2], voffB[2];
#pragma unroll
    for (int i = 0; i < 2; ++i) { int R, C; stage_rc(tid * 16 + i * 8192, R, C); const int Rb = Epi::PERM ? ((R & ~31) + perm32(R & 31)) : R;
        voffA[i] = (unsigned)(R * K + C) * 2u; voffB[i] = (unsigned)(Rb * K + C) * 2u; }
    const size_t kstep = (size_t)(BK * 2);
    const size_t hstep = (size_t)HALF * K * 2;
    const size_t tstep = 2 * hstep;
    const unsigned ldsw = (unsigned)wid * 1024u;
    const int aoff = lds_byte(wr * 64 + fr, fq * 8), boff = lds_byte(wc * 32 + fr, fq * 8);
#define PG8_SA(b, h) (((b) * 2 + (h)) * HTB)
#define PG8_SB(b, h) ((4 + (b) * 2 + (h)) * HTB)
#define PG8_STAGE(bufoff, gbase, voff) do { _Pragma("unroll") for (int _i = 0; _i < 2; ++_i) \
        __builtin_amdgcn_global_load_lds((const unsigned*)((const char*)(gbase) + (voff)[_i]), (PG8_LAS unsigned*)(lds + (bufoff) + ldsw + _i * 8192), 16, 0, 0); } while (0)
#define PG8_LDA(dst, b, h) do { _Pragma("unroll") for (int m = 0; m < 4; ++m) _Pragma("unroll") for (int k = 0; k < 2; ++k) dst[m][k] = *(const PG8_LAS bf16x8*)(lds + PG8_SA(b, h) + aoff + m * 2048 + k * 1024); } while (0)
#define PG8_LDB(dst, b, h) do { _Pragma("unroll") for (int n = 0; n < 2; ++n) _Pragma("unroll") for (int k = 0; k < 2; ++k) dst[n][k] = *(const PG8_LAS bf16x8*)(lds + PG8_SB(b, h) + boff + n * 2048 + k * 1024); } while (0)
#define PG8_MMA(ai, bj, At, Bt) do { __builtin_amdgcn_s_setprio(1); _Pragma("unroll") for (int m = 0; m < 4; ++m) _Pragma("unroll") for (int n = 0; n < 2; ++n) _Pragma("unroll") for (int k = 0; k < 2; ++k) \
        acc[ai][bj][m][n] = __builtin_amdgcn_mfma_f32_16x16x32_bf16(Bt[n][k], At[m][k], acc[ai][bj][m][n], 0, 0, 0); __builtin_amdgcn_s_setprio(0); } while (0)
#define PG8_WAIT_V(n) asm volatile("s_waitcnt vmcnt(" #n ")" ::: "memory")
#define PG8_WAIT_L(n) asm volatile("s_waitcnt lgkmcnt(" #n ")" ::: "memory")
#define PG8_BAR __builtin_amdgcn_s_barrier()
#define PG8_SCHED __builtin_amdgcn_sched_barrier(0)
    Unit cur, nxt; int ui = 0;
    if (!S.next(0, cur)) return;
    f32x4 acc[2][2][4][2];
#pragma unroll
    for (int a = 0; a < 2; ++a)
#pragma unroll
        for (int b = 0; b < 2; ++b)
#pragma unroll
            for (int m = 0; m < 4; ++m)
#pragma unroll
                for (int n = 0; n < 2; ++n) acc[a][b][m][n] = (f32x4){0.f, 0.f, 0.f, 0.f};
    bf16x8 At[4][2], B0[2][2], B1[2][2];
    const char* cA = (const char*)g.A + (size_t)cur.pm * tstep; const char* cB = (const char*)g.Bt + (size_t)cur.pn * tstep;
    S.a_ready(cur);
    if constexpr (SP2) {
        PG8_STAGE(PG8_SB(0, 0), cB, voffB); PG8_STAGE(PG8_SB(0, 1), cB + hstep, voffB); PG8_STAGE(PG8_SA(0, 0), cA, voffA); PG8_STAGE(PG8_SA(0, 1), cA + hstep, voffA);
        if (wr == 1) PG8_BAR;
        PG8_WAIT_V(2); PG8_BAR;
        PG8_STAGE(PG8_SB(1, 0), cB + kstep, voffB); PG8_STAGE(PG8_SA(1, 0), cA + kstep, voffA); PG8_STAGE(PG8_SB(1, 1), cB + hstep + kstep, voffB);
        PG8_WAIT_V(6); PG8_BAR;
    } else {
        PG8_STAGE(PG8_SB(0, 0), cB, voffB); PG8_STAGE(PG8_SA(0, 0), cA, voffA); PG8_STAGE(PG8_SB(0, 1), cB + hstep, voffB); PG8_STAGE(PG8_SA(0, 1), cA + hstep, voffA);
        if (wr == 1) PG8_BAR;
        PG8_WAIT_V(4); PG8_BAR;
        PG8_STAGE(PG8_SB(1, 0), cB + kstep, voffB); PG8_STAGE(PG8_SA(1, 0), cA + kstep, voffA); PG8_STAGE(PG8_SB(1, 1), cB + hstep + kstep, voffB);
        PG8_WAIT_V(6); PG8_BAR;
    }
    for (;;) {
        const bool has_next = S.next(ui + 1, nxt);
        const char* nA = has_next ? (const char*)g.A + (size_t)nxt.pm * tstep : cA; const char* nB = has_next ? (const char*)g.Bt + (size_t)nxt.pn * tstep : cB;
        for (int t = 0; t < nt; t += 2) {
            const bool last = (t == nt - 2);
            const char* a1 = cA + (size_t)(t + 1) * kstep;
            const char* a2 = last ? nA : cA + (size_t)(t + 2) * kstep; const char* b2 = last ? nB : cB + (size_t)(t + 2) * kstep;
            const char* a3 = a2 + kstep; const char* b3 = b2 + kstep;
            if (last && has_next) S.a_ready(nxt);
            if constexpr (Epi::MID) { if (t == (nt >> 1)) E.mid(acc, cur, wr, wc, fr, fq); }
            if constexpr (SP2) {
            PG8_LDB(B0, 0, 0); PG8_LDB(B1, 0, 1); PG8_SCHED; PG8_LDA(At, 0, 0); PG8_STAGE(PG8_SA(1, 1), a1 + hstep, voffA);
            PG8_WAIT_V(8); PG8_WAIT_L(0); PG8_BAR; PG8_MMA(0, 0, At, B0); PG8_MMA(0, 1, At, B1); PG8_BAR; PG8_SCHED;
            PG8_LDA(At, 0, 1); PG8_STAGE(PG8_SB(0, 0), b2, voffB); PG8_STAGE(PG8_SB(0, 1), b2 + hstep, voffB); PG8_STAGE(PG8_SA(0, 0), a2, voffA);
            PG8_WAIT_V(8); PG8_WAIT_L(0); PG8_BAR; PG8_MMA(1, 0, At, B0); PG8_MMA(1, 1, At, B1); PG8_BAR; PG8_SCHED;
            PG8_LDB(B0, 1, 0); PG8_LDB(B1, 1, 1); PG8_SCHED; PG8_LDA(At, 1, 0); PG8_STAGE(PG8_SA(0, 1), a2 + hstep, voffA);
            PG8_WAIT_V(8); PG8_WAIT_L(0); PG8_BAR; PG8_MMA(0, 0, At, B0); PG8_MMA(0, 1, At, B1); PG8_BAR; PG8_SCHED;
            PG8_LDA(At, 1, 1); PG8_STAGE(PG8_SB(1, 0), b3, voffB); PG8_STAGE(PG8_SB(1, 1), b3 + hstep, voffB); PG8_STAGE(PG8_SA(1, 0), a3, voffA);
            PG8_WAIT_V(8); PG8_WAIT_L(0); PG8_BAR; PG8_MMA(1, 0, At, B0); PG8_MMA(1, 1, At, B1); PG8_BAR; PG8_SCHED;
            } else {
            PG8_LDB(B0, 0, 0); PG8_SCHED; PG8_LDA(At, 0, 0); PG8_STAGE(PG8_SA(1, 1), a1 + hstep, voffA);
            PG8_WAIT_L(8); PG8_BAR; PG8_WAIT_L(0); PG8_MMA(0, 0, At, B0); PG8_BAR; PG8_SCHED;
            PG8_LDB(B1, 0, 1); PG8_STAGE(PG8_SB(0, 0), b2, voffB);
            PG8_BAR; PG8_WAIT_L(0); PG8_MMA(0, 1, At, B1); PG8_BAR;
            PG8_LDA(At, 0, 1); PG8_STAGE(PG8_SA(0, 0), a2, voffA);
            PG8_BAR; PG8_WAIT_L(0); PG8_MMA(1, 0, At, B0); PG8_BAR; PG8_SCHED;
            PG8_STAGE(PG8_SB(0, 1), b2 + hstep, voffB);
            PG8_WAIT_V(6); PG8_BAR; PG8_MMA(1, 1, At, B1); PG8_BAR;
            PG8_LDB(B0, 1, 0); PG8_SCHED; PG8_LDA(At, 1, 0); PG8_STAGE(PG8_SA(0, 1), a2 + hstep, voffA);
            PG8_WAIT_L(8); PG8_BAR; PG8_WAIT_L(0); PG8_MMA(0, 0, At, B0); PG8_BAR; PG8_SCHED;
            PG8_LDB(B1, 1, 1); PG8_STAGE(PG8_SB(1, 0), b3, voffB);
            PG8_BAR; PG8_WAIT_L(0); PG8_MMA(0, 1, At, B1); PG8_BAR;
            PG8_LDA(At, 1, 1); PG8_STAGE(PG8_SA(1, 0), a3, voffA);
            PG8_BAR; PG8_WAIT_L(0); PG8_MMA(1, 0, At, B0); PG8_BAR; PG8_SCHED;
            PG8_STAGE(PG8_SB(1, 1), b3 + hstep, voffB);
            PG8_WAIT_V(6); PG8_BAR; PG8_MMA(1, 1, At, B1); PG8_BAR;
            }
        }
        if constexpr (ALIGN_EPI) { if (wr == 0) PG8_BAR; }
        if constexpr (!Epi::AFTER_DRAIN) { E(acc, cur, wr, wc, fr, fq); S.done(cur); }
        if (!has_next) break;
#pragma unroll
        for (int a = 0; a < 2; ++a)
#pragma unroll
            for (int b = 0; b < 2; ++b)
#pragma unroll
                for (int m = 0; m < 4; ++m)
#pragma unroll
                    for (int n = 0; n < 2; ++n) acc[a][b][m][n] = (f32x4){0.f, 0.f, 0.f, 0.f};
        cur = nxt; cA = nA; cB = nB; ++ui;
        if constexpr (ALIGN_EPI) { if (wr == 1) PG8_BAR; }
    }
    PG8_WAIT_V(0);
    if constexpr (!ALIGN_EPI) { if (wr == 0) PG8_BAR; }
    PG8_BAR;
    if constexpr (Epi::AFTER_DRAIN) { E.fused(acc, cur, wr, wc, fr, fq, lds, wid, lane); S.done(cur); }
#undef PG8_SA
#undef PG8_SB
#undef PG8_STAGE
#undef PG8_LDA
#undef PG8_LDB
#undef PG8_MMA
#undef PG8_WAIT_V
#undef PG8_WAIT_L
#undef PG8_BAR
#undef PG8_SCHED
}
}


constexpr int NWAVES = 8;
constexpr int DM = 2048, BATCH = 4, SEQ = 2048, MT = BATCH * SEQ;
constexpr int NQ = 1024, NKVW = 256, CONVC = 1024, DFF = 5632, NMOD = 6 * DM;
constexpr int N1 = 7680, N4 = 2 * DFF;
constexpr float EPS = 1e-6f, LOG2E = 1.4426950408889634f;
constexpr int N_PHASES = 9;

constexpr size_t MiB = 1u << 20;
constexpr size_t WS_CTL = 0, WS_MOD = 65536, CTL_ZERO_BYTES = 262144;
constexpr size_t WS_W1T = 1 * MiB, WS_W2T = 31 * MiB, WS_W3T = 39 * MiB, WS_W4T = 47 * MiB, WS_W5T = 91 * MiB;
constexpr size_t WS_H = 113 * MiB;
constexpr size_t WS_Q = 145 * MiB, WS_K = 161 * MiB, WS_V = 165 * MiB, WS_U = 169 * MiB, WS_R = 185 * MiB, WS_GC = 217 * MiB;
constexpr size_t WS_A2 = 249 * MiB, WS_MG = 281 * MiB, WS_END = 313 * MiB;
constexpr size_t WS_HF = 145 * MiB;
static_assert(WS_HF + (size_t)MT * DFF * 2 <= WS_A2, "HF overlay");
static_assert(WS_K - WS_Q == 2 * (size_t)8388608 && WS_V - WS_Q == 2 * (size_t)10485760, "Epi1 reaches K and V from Q by fixed element offsets");
constexpr int CW_BAR = 1024;

constexpr int RING_BYTES = 131072, LDSCTL_OFF = RING_BYTES, MISC_OFF = LDSCTL_OFF + 320, LDS_BYTES = 147456;

#define GAS __attribute__((address_space(1)))
#define LAS __attribute__((address_space(3)))
typedef unsigned short bf16;
typedef unsigned v4u __attribute__((ext_vector_type(4)));
typedef unsigned v2u __attribute__((ext_vector_type(2)));
typedef float f32x4 __attribute__((ext_vector_type(4)));
typedef float f32x2 __attribute__((ext_vector_type(2)));
typedef float f32x16 __attribute__((ext_vector_type(16)));
typedef short bf16x8 __attribute__((ext_vector_type(8)));
typedef short s16x4 __attribute__((ext_vector_type(4)));
typedef GAS unsigned gu32;
#define RLX_AGENT __ATOMIC_RELAXED, __HIP_MEMORY_SCOPE_AGENT
#define LDS_WAIT() asm volatile("s_waitcnt lgkmcnt(0)" ::: "memory")
__device__ __forceinline__ unsigned f2bf(float f) { unsigned u = __builtin_bit_cast(unsigned, f); return (u + 0x7fffu + ((u >> 16) & 1u)) >> 16; }
__device__ __forceinline__ unsigned pk2(float lo, float hi) { return f2bf(lo) | (f2bf(hi) << 16); }
__device__ __forceinline__ float bflo(unsigned w) { return __uint_as_float(w << 16); }
__device__ __forceinline__ float bfhi(unsigned w) { return __uint_as_float(w & 0xffff0000u); }
__device__ __forceinline__ float sigm(float x) { return __builtin_amdgcn_rcpf(1.0f + __builtin_amdgcn_exp2f(-LOG2E * x)); }
__device__ __forceinline__ float wave_sum(float v) {
#pragma unroll
    for (int o = 1; o < 64; o <<= 1) v += __shfl_xor(v, o);
    return v;
}

#define XB_TMO      128
#define XB_XCNT(j)  (256  + 64 * (j))
#define XB_XSUB(j)  (1280 + 64 * (j))
#define XB_XGEN(j)  (2304 + 64 * (j))
#define XB_TOP      3328
#define XB_TOPGEN   3392
#define XCD_BAR_WORDS 3456
#define XB_SPIN_CAP (1u << 18)

__device__ __forceinline__ unsigned xb_ld(unsigned* p)              { return __hip_atomic_load(p, __ATOMIC_RELAXED, __HIP_MEMORY_SCOPE_AGENT); }
__device__ __forceinline__ unsigned xb_add(unsigned* p, unsigned v) { return __hip_atomic_fetch_add(p, v, __ATOMIC_RELAXED, __HIP_MEMORY_SCOPE_AGENT); }
__device__ __forceinline__ unsigned xb_xcc_id() { return (unsigned)__builtin_amdgcn_s_getreg((3 << 11) | 20) & 0xFu; }
#define XB_SPIN(cond, bar) do { unsigned _sp = 0; while (cond) { __builtin_amdgcn_s_sleep(1); \
    if ((++_sp & 255u) == 0u) { if (xb_ld(&(bar)[XB_TMO])) break; if (_sp > XB_SPIN_CAP) { atomicAdd(&(bar)[XB_TMO], 1u); break; } } } } while (0)

struct XcdBarrier {
    unsigned* bar; unsigned x;
    volatile LAS unsigned* st;
};

__device__ __forceinline__ XcdBarrier xcd_barrier_post(unsigned* bar, volatile LAS unsigned* st) {
    XcdBarrier b; b.bar = bar; b.x = xb_xcc_id(); b.st = st;
    if (threadIdx.x == 0) (void)xb_add(&bar[XB_XCNT(b.x)], 1u);
    return b;
}
__device__ __forceinline__ void xcd_barrier_complete(unsigned* bar, unsigned x, unsigned& nloc, unsigned& nx) {
    const unsigned G = gridDim.x * gridDim.y * gridDim.z;
    unsigned sum, cnt, mine, sp = 0u;
    for (;;) {
        sum = 0u; cnt = 0u; mine = 0u;
#pragma unroll
        for (unsigned j = 0; j < 16; ++j) { const unsigned c = xb_ld(&bar[XB_XCNT(j)]); sum += c; cnt += (c > 0u) ? 1u : 0u; mine = (j == x) ? c : mine; }
        if (sum == G) break;
        __builtin_amdgcn_s_sleep(1);
        if ((++sp & 255u) == 0u) { if (xb_ld(&bar[XB_TMO])) break; if (sp > XB_SPIN_CAP) { atomicAdd(&bar[XB_TMO], 1u); break; } }
    }
    nloc = mine > 0u ? mine : 1u; nx = cnt > 0u ? cnt : 1u;
}

__device__ __forceinline__ void xcd_barrier(const XcdBarrier& b) {
    asm volatile("s_waitcnt vmcnt(0)" ::: "memory");
    __syncthreads();
    if (threadIdx.x == 0) {
        unsigned* bar = b.bar;
        __builtin_amdgcn_s_waitcnt(0);
        unsigned nloc = b.st[0], nx = b.st[1];
        if (nloc == 0u) { xcd_barrier_complete(bar, b.x, nloc, nx); b.st[0] = nloc; b.st[1] = nx; }
        const unsigned old = xb_add(&bar[XB_XSUB(b.x)], 1u);
        const unsigned gen = old / nloc;
        if (old + 1u == (gen + 1u) * nloc) {
            __builtin_amdgcn_fence(__ATOMIC_RELEASE, "agent");
            asm volatile("s_waitcnt vmcnt(0)" ::: "memory");
            const unsigned og = xb_add(&bar[XB_TOP], 1u);
            const unsigned tg = og / nx;
            if (og + 1u == (tg + 1u) * nx) xb_add(&bar[XB_TOPGEN], 1u);
            else XB_SPIN(xb_ld(&bar[XB_TOPGEN]) == tg, bar);
            __builtin_amdgcn_fence(__ATOMIC_ACQUIRE, "agent");
            xb_add(&bar[XB_XGEN(b.x)], 1u);
            asm volatile("s_waitcnt vmcnt(0)" ::: "memory");
        } else {
            XB_SPIN(xb_ld(&bar[XB_XGEN(b.x)]) == gen, bar);
            __builtin_amdgcn_fence(__ATOMIC_ACQUIRE, "agent");
            asm volatile("s_waitcnt vmcnt(0)" ::: "memory");
        }
    }
    __syncthreads();
}

__device__ __forceinline__ void p0_adaln(const float* c, const float* w_ada, const float* b_ada, float* MOD, LAS float* red, int tid, int lane, int wave) {
    const __amdgpu_buffer_rsrc_t wrsrc = __builtin_amdgcn_make_buffer_rsrc((void*)w_ada, 0, DM * NMOD * 4, 0x00020000);
    for (int it = blockIdx.x; it < 48 * 16; it += gridDim.x) {
        const int cgp = it % 48, kc = it / 48, k0 = kc * 128 + wave * 16, c0 = cgp * 256 + lane * 4;
        const float cv = c[(lane >> 4) * DM + k0 + (lane & 15)];
        const float sv = cv * sigm(cv);
        f32x4 acc[4], w4[16];
#pragma unroll
        for (int b = 0; b < 4; ++b) acc[b] = (f32x4){0.f, 0.f, 0.f, 0.f};
        const unsigned voff = (unsigned)(k0 * NMOD + c0) * 4u;
#pragma unroll
        for (int r = 0; r < 16; ++r) w4[r] = __builtin_bit_cast(f32x4, __builtin_amdgcn_raw_buffer_load_b128(wrsrc, voff, r * (NMOD * 4), 0));
#pragma unroll
        for (int r = 0; r < 16; ++r)
#pragma unroll
            for (int b = 0; b < 4; ++b) { const float sc = __uint_as_float(__builtin_amdgcn_readlane(__float_as_uint(sv), b * 16 + r)); acc[b] += w4[r] * sc; }
#pragma unroll
        for (int b = 0; b < 4; ++b) *(LAS f32x4*)(red + ((wave * 4 + b) * 256 + lane * 4)) = acc[b];
        __syncthreads();
#pragma unroll
        for (int e = 0; e < 2; ++e) { const int o = tid * 2 + e, b = o >> 8, col = o & 255; float s = 0.f;
#pragma unroll
            for (int w = 0; w < 8; ++w) s += red[(w * 4 + b) * 256 + col];
            if (kc == 0) s += b_ada[cgp * 256 + col];
            atomicAdd(MOD + b * NMOD + cgp * 256 + col, s); }
        __syncthreads();
    }
}
__device__ __forceinline__ int maprow(int mapid, int n0) {
    if (mapid == 1) {
        if (n0 < 1536) return n0;
        if (n0 < 2560) { const int t = n0 - 1536; return 1536 + ((t >> 7) << 8) + (t & 127); }
        if (n0 < 3584) { const int t = n0 - 2560; return 1536 + ((t >> 7) << 8) + 128 + (t & 127); }
        if (n0 < 5632) { const int t = n0 - 3584; return 3584 + ((t >> 7) << 8) + (t & 127); }
        const int t = n0 - 5632; return 3584 + ((t >> 7) << 8) + 128 + (t & 127);
    }
    if (mapid == 2) {
        if (n0 < DFF) return ((n0 >> 7) << 8) + (n0 & 127);
        const int t = n0 - DFF; return ((t >> 7) << 8) + 128 + (t & 127);
    }
    return n0;
}
__device__ __forceinline__ void transpose_write(const float (&v)[32], bf16* WT, int ldk, int kcol, int drow0, LAS float* scr, int lane) {
#pragma unroll
    for (int i = 0; i < 32; ++i) scr[(2 * i + (lane >> 5)) * 33 + (lane & 31)] = v[i];
    LDS_WAIT(); asm volatile("" ::: "memory");
    const int c = lane & 7;
#pragma unroll
    for (int j = 0; j < 4; ++j) { const int n = (lane >> 3) + 8 * j; const LAS float* s = scr + (8 * c) * 33 + n;
        v4u o; o.x = pk2(s[0 * 33], s[1 * 33]); o.y = pk2(s[2 * 33], s[3 * 33]); o.z = pk2(s[4 * 33], s[5 * 33]); o.w = pk2(s[6 * 33], s[7 * 33]);
        *(GAS v4u*)(WT + (size_t)(drow0 + n) * ldk + kcol + 8 * c) = o; }
    LDS_WAIT(); asm volatile("" ::: "memory");
}
template <int MAPID>
__device__ __forceinline__ void transpose_matrix(const float* W, int K, int N, bf16* WT, int ldk, int koff, int item_off, LAS float* scr, int gw, int NGW, int lane) {
    const int nblk = N / 32, nitems = (K / 64) * nblk;
    const __amdgpu_buffer_rsrc_t rsrc = __builtin_amdgcn_make_buffer_rsrc((void*)W, 0, K * N * 4, 0x00020000);
    const unsigned lane_off = (unsigned)((lane >> 5) * N + (lane & 31)) * 4u, rowstep = (unsigned)N * 8u;
    for (int it = ((gw - item_off) % NGW + NGW) % NGW; it < nitems; it += 2 * NGW) {
        const int itB = it + NGW; const bool hasB = itB < nitems;
        const int kA = 64 * (it / nblk), nA = 32 * (it % nblk), kB = hasB ? 64 * (itB / nblk) : 0, nB = hasB ? 32 * (itB % nblk) : 0;
        const unsigned offA = (unsigned)(kA * N + nA) * 4u + lane_off, offB = (unsigned)(kB * N + nB) * 4u + lane_off;
        float va[32], vb[32];
#pragma unroll
        for (int i = 0; i < 32; ++i) va[i] = __uint_as_float(__builtin_amdgcn_raw_buffer_load_b32(rsrc, offA, i * rowstep, 0));
        if (hasB) {
#pragma unroll
            for (int i = 0; i < 32; ++i) vb[i] = __uint_as_float(__builtin_amdgcn_raw_buffer_load_b32(rsrc, offB, i * rowstep, 0));
        }
        transpose_write(va, WT, ldk, koff + kA, maprow(MAPID, nA), scr, lane);
        if (hasB) transpose_write(vb, WT, ldk, koff + kB, maprow(MAPID, nB), scr, lane);
    }
}
__device__ __forceinline__ void modnorm_phase(const float* X, const float* g, const float* MOD, int sh_off, int sc_off, bf16* H, int gw, int NGW, int lane) {
    for (int it = gw; it < MT / 4; it += NGW) {
        const int row0 = it * 4, b = row0 / SEQ;
        f32x4 A[8], Bv[8];
#pragma unroll
        for (int j = 0; j < 8; ++j) { const int col = 4 * (lane + 64 * j);
            const f32x4 gg = *(const f32x4*)(g + col), sc = *(const f32x4*)(MOD + (size_t)b * NMOD + sc_off + col);
            A[j] = gg * (1.0f + sc); Bv[j] = *(const f32x4*)(MOD + (size_t)b * NMOD + sh_off + col); }
        for (int r = 0; r < 4; ++r) {
            const float* xr = X + (size_t)(row0 + r) * DM;
            f32x4 v[8]; float ss = 0.f;
#pragma unroll
            for (int j = 0; j < 8; ++j) { v[j] = *(const f32x4*)(xr + 4 * (lane + 64 * j)); ss += (v[j].x * v[j].x + v[j].y * v[j].y) + (v[j].z * v[j].z + v[j].w * v[j].w); }
            const float rstd = 1.0f / sqrtf(wave_sum(ss) * (1.0f / DM) + EPS);
            bf16* hr = H + (size_t)(row0 + r) * DM;
#pragma unroll
            for (int j = 0; j < 8; ++j) { const f32x4 o = v[j] * rstd * A[j] + Bv[j]; v2u w; w.x = pk2(o.x, o.y); w.y = pk2(o.z, o.w); *(GAS v2u*)(hr + 4 * (lane + 64 * j)) = w; }
        }
    }
}
__device__ __forceinline__ int crow(int r, int hi) { return (r & 3) + 8 * (r >> 2) + 4 * hi; }
constexpr int AT_KS = 0, AT_VT = 36864, AT_BIAS = AT_VT + 33792, AT_LSCR = AT_BIAS + 4096, AT_OSTG = AT_LSCR + 1024, AT_END = AT_OSTG + 8 * 4608;
static_assert(AT_END <= RING_BYTES, "attention LDS");
__device__ __forceinline__ float sum8_dpp(float v) {
    v += __uint_as_float(__builtin_amdgcn_update_dpp(0u, __float_as_uint(v), 0x141, 0xf, 0xf, false));
    v += __uint_as_float(__builtin_amdgcn_update_dpp(0u, __float_as_uint(v), 0xB1, 0xf, 0xf, false));
    v += __uint_as_float(__builtin_amdgcn_update_dpp(0u, __float_as_uint(v), 0x4E, 0xf, 0xf, false));
    return v;
}
__device__ __forceinline__ void attn_unit(int unit, const bf16* Qb, const bf16* Kb, const bf16* Vb, bf16* A2, const float* qg, const float* kg, const float* sinks, const float* relb,
                                          LAS unsigned char* lds, int tid, int lane, int wave) {
    const int b = unit >> 6, kvh = (unit >> 4) & 3, nb = unit & 15;
    LAS bf16* Ks = (LAS bf16*)(lds + AT_KS);
    LAS bf16* Vt = (LAS bf16*)(lds + AT_VT);
    LAS float* biasT = (LAS float*)(lds + AT_BIAS);
    LAS float* lscr = (LAS float*)(lds + AT_LSCR) + wave * 32;
    LAS bf16* ostg = (LAS bf16*)(lds + AT_OSTG) + wave * 2304;
    const int tok0 = b * SEQ + nb * 128;
    const int q = lane & 31, hi = lane >> 5;
    v4u qn[4];
    { const int pi = wave * 2, g = pi >> 2, qblk = pi & 3;
        const bf16* qrow = Qb + (size_t)(tok0 + qblk * 32 + q) * 1024 + (kvh * 4 + g) * 64 + hi * 8;
#pragma unroll
        for (int ks = 0; ks < 4; ++ks) qn[ks] = *(const v4u*)(qrow + 16 * ks); }
    v4u kw[4], vw[4];
#pragma unroll
    for (int i = 0; i < 4; ++i) { const int c = tid + 512 * i, key = c >> 3, part = c & 7;
        const bool real = (nb > 0) || (key >= 128);
        const long tok = (long)tok0 - 128 + key;
        kw[i] = (v4u){0u, 0u, 0u, 0u}; vw[i] = (v4u){0u, 0u, 0u, 0u};
        if (real) { kw[i] = *(const v4u*)(Kb + tok * 256 + kvh * 64 + part * 8); vw[i] = *(const v4u*)(Vb + tok * 256 + kvh * 64 + part * 8); } }
#pragma unroll
    for (int e = 0; e < 2; ++e) { const int idx = tid + 512 * e, g = idx >> 8, dist = (idx & 255) - 48; int bucket = dist < 0 ? 0 : (dist > 127 ? 127 : dist);
      if (bucket >= 16) { const int l = 16 + (int)(logf((float)bucket * (1.0f / 16.0f)) / 2.0794415416798357f * 16.0f); bucket = l < 31 ? l : 31; }
      biasT[idx] = (dist >= 0 && dist < 128) ? relb[bucket * 16 + kvh * 4 + g] * LOG2E : -INFINITY; }
    { const int part = tid & 7; const f32x4 kg0 = *(const f32x4*)(kg + part * 8), kg1 = *(const f32x4*)(kg + part * 8 + 4);
#pragma unroll
    for (int i = 0; i < 4; ++i) { const int key = (tid + 512 * i) >> 3;
        const f32x4 k0 = (f32x4){bflo(kw[i].x), bfhi(kw[i].x), bflo(kw[i].y), bfhi(kw[i].y)}, k1 = (f32x4){bflo(kw[i].z), bfhi(kw[i].z), bflo(kw[i].w), bfhi(kw[i].w)};
        const float ss = sum8_dpp((k0.x * k0.x + k0.y * k0.y) + (k0.z * k0.z + k0.w * k0.w) + (k1.x * k1.x + k1.y * k1.y) + (k1.z * k1.z + k1.w * k1.w));
        const float rstd = __builtin_amdgcn_rsqf(ss * (1.0f / 64.0f) + EPS);
        const f32x4 g0 = kg0 * rstd, g1 = kg1 * rstd;
        v4u o; o.x = pk2(k0.x * g0.x, k0.y * g0.y); o.y = pk2(k0.z * g0.z, k0.w * g0.w); o.z = pk2(k1.x * g1.x, k1.y * g1.y); o.w = pk2(k1.z * g1.z, k1.w * g1.w);
        *(LAS v4u*)(Ks + key * 72 + part * 8) = o;
        LAS bf16* vt = Vt + (part * 8) * 264 + key;
        vt[0 * 264] = (bf16)(vw[i].x & 0xffffu); vt[1 * 264] = (bf16)(vw[i].x >> 16); vt[2 * 264] = (bf16)(vw[i].y & 0xffffu); vt[3 * 264] = (bf16)(vw[i].y >> 16);
        vt[4 * 264] = (bf16)(vw[i].z & 0xffffu); vt[5 * 264] = (bf16)(vw[i].z >> 16); vt[6 * 264] = (bf16)(vw[i].w & 0xffffu); vt[7 * 264] = (bf16)(vw[i].w >> 16); } }
    __syncthreads();
#pragma unroll 1
    for (int pass = 0; pass < 2; ++pass) {
        const int pi = wave * 2 + pass, g = pi >> 2, qblk = pi & 3, h = kvh * 4 + g, q0 = qblk * 32;
        v4u qw[4];
#pragma unroll
        for (int ks = 0; ks < 4; ++ks) qw[ks] = qn[ks];
        if (pass == 0) { const int pi1 = pi + 1, g1 = pi1 >> 2, qblk1 = pi1 & 3;
            const bf16* qrow = Qb + (size_t)(tok0 + qblk1 * 32 + q) * 1024 + (kvh * 4 + g1) * 64 + hi * 8;
#pragma unroll
            for (int ks = 0; ks < 4; ++ks) qn[ks] = *(const v4u*)(qrow + 16 * ks); }
        float ss = 0.f;
#pragma unroll
        for (int ks = 0; ks < 4; ++ks) { const v4u w = qw[ks];
            const float a0 = bflo(w.x), a1 = bfhi(w.x), a2 = bflo(w.y), a3 = bfhi(w.y), a4 = bflo(w.z), a5 = bfhi(w.z), a6 = bflo(w.w), a7 = bfhi(w.w);
            ss += (a0 * a0 + a1 * a1) + (a2 * a2 + a3 * a3) + (a4 * a4 + a5 * a5) + (a6 * a6 + a7 * a7); }
        ss += __shfl_xor(ss, 32);
        const float rs = __builtin_amdgcn_rsqf(ss * (1.0f / 64.0f) + EPS) * (0.125f * LOG2E);
        bf16x8 qf[4];
#pragma unroll
        for (int ks = 0; ks < 4; ++ks) { const v4u w = qw[ks]; const f32x4 g0 = *(const f32x4*)(qg + 16 * ks + 8 * hi) * rs, g1 = *(const f32x4*)(qg + 16 * ks + 8 * hi + 4) * rs;
            v4u o; o.x = pk2(bflo(w.x) * g0.x, bfhi(w.x) * g0.y); o.y = pk2(bflo(w.y) * g0.z, bfhi(w.y) * g0.w);
            o.z = pk2(bflo(w.z) * g1.x, bfhi(w.z) * g1.y); o.w = pk2(bflo(w.w) * g1.z, bfhi(w.w) * g1.w);
            qf[ks] = __builtin_bit_cast(bf16x8, o); }
        f32x16 s[5];
#pragma unroll
        for (int tt = 0; tt < 5; ++tt) {
            s[tt] = (f32x16){0.f, 0.f, 0.f, 0.f, 0.f, 0.f, 0.f, 0.f, 0.f, 0.f, 0.f, 0.f, 0.f, 0.f, 0.f, 0.f};
            const LAS bf16* kp = Ks + (32 * (qblk + tt) + q) * 72 + 8 * hi;
#pragma unroll
            for (int ks = 0; ks < 4; ++ks) { const bf16x8 a = *(const LAS bf16x8*)(kp + 16 * ks); s[tt] = __builtin_amdgcn_mfma_f32_32x32x16_bf16(a, qf[ks], s[tt], 0, 0, 0); }
        }
        const float sk = sinks[h] * LOG2E;
        float mx = sk;
        const LAS float* btl = biasT + g * 256 + 48 + q - 4 * hi;
#pragma unroll
        for (int tt = 0; tt < 5; ++tt)
#pragma unroll
            for (int r = 0; r < 16; ++r) { const bool dead = (nb == 0) && (qblk + tt < 4);
                float v = s[tt][r] + btl[128 - 32 * tt - (r & 3) - 8 * (r >> 2)]; v = dead ? -INFINITY : v; s[tt][r] = v; mx = fmaxf(mx, v); }
        mx = fmaxf(mx, __shfl_xor(mx, 32));
        float l = 0.f;
#pragma unroll
        for (int tt = 0; tt < 5; ++tt)
#pragma unroll
            for (int r = 0; r < 16; ++r) { const float p = __builtin_amdgcn_exp2f(s[tt][r] - mx); s[tt][r] = p; l += p; }
        l += __shfl_xor(l, 32); l += __builtin_amdgcn_exp2f(sk - mx);
        f32x16 o[2];
        o[0] = (f32x16){0.f, 0.f, 0.f, 0.f, 0.f, 0.f, 0.f, 0.f, 0.f, 0.f, 0.f, 0.f, 0.f, 0.f, 0.f, 0.f}; o[1] = o[0];
#pragma unroll
        for (int tt = 0; tt < 5; ++tt)
#pragma unroll
            for (int s2 = 0; s2 < 2; ++s2) {
                v4u pw; pw.x = pk2(s[tt][8 * s2 + 0], s[tt][8 * s2 + 1]); pw.y = pk2(s[tt][8 * s2 + 2], s[tt][8 * s2 + 3]); pw.z = pk2(s[tt][8 * s2 + 4], s[tt][8 * s2 + 5]); pw.w = pk2(s[tt][8 * s2 + 6], s[tt][8 * s2 + 7]);
                const bf16x8 pa = __builtin_bit_cast(bf16x8, pw);
#pragma unroll
                for (int dt = 0; dt < 2; ++dt) { const LAS bf16* vp = Vt + (32 * dt + q) * 264 + 32 * (qblk + tt) + 16 * s2 + 4 * hi;
                    const s16x4 lo = *(const LAS s16x4*)vp, hh = *(const LAS s16x4*)(vp + 8);
                    const bf16x8 vb = (bf16x8){lo[0], lo[1], lo[2], lo[3], hh[0], hh[1], hh[2], hh[3]};
                    o[dt] = __builtin_amdgcn_mfma_f32_32x32x16_bf16(pa, vb, o[dt], 0, 0, 0); }
            }
        if (hi == 0) lscr[q] = __builtin_amdgcn_rcpf(l);
        LDS_WAIT();
#pragma unroll
        for (int r = 0; r < 16; ++r) { const int cr = crow(r, hi); const float li = lscr[cr];
            ostg[cr * 72 + q] = (bf16)f2bf(o[0][r] * li); ostg[cr * 72 + 32 + q] = (bf16)f2bf(o[1][r] * li); }
        LDS_WAIT();
        bf16* orow = A2 + (size_t)(tok0 + q0) * 2048 + h * 64;
#pragma unroll
        for (int i = 0; i < 4; ++i) { const int row = i * 8 + (lane >> 3), ch = lane & 7; const v4u v = *(const LAS v4u*)(ostg + row * 72 + ch * 8); *(GAS v4u*)(orow + (size_t)row * 2048 + ch * 8) = v; }
        LDS_WAIT();
    }
}
constexpr int CV_RED = RING_BYTES + 1024;
__device__ __forceinline__ void conv_unit(int unit, const bf16* U, bf16* A2, const float* cw, const float* cb, const float* lg, const float* lb, LAS unsigned char* lds, int tid, int lane, int wave) {
    const int b = unit >> 6, t0 = (unit & 63) * 32;
    LAS unsigned* Us = (LAS unsigned*)lds;
    LAS float* red = (LAS float*)(lds + CV_RED);
    const __amdgpu_buffer_rsrc_t ursrc = __builtin_amdgcn_make_buffer_rsrc((void*)(U + (size_t)b * SEQ * 1024), 0, SEQ * 1024 * 2, 0x00020000);
    const __amdgpu_buffer_rsrc_t wrsrc = __builtin_amdgcn_make_buffer_rsrc((void*)cw, 0, 31 * 1024 * 4, 0x00020000);
    const int rr0 = tid >> 7, cc = tid & 127;
    v4u st[16];
#pragma unroll
    for (int i = 0; i < 16; ++i) { const int t = t0 - 30 + rr0 + 4 * i; const unsigned voff = t >= 0 ? (unsigned)(t * 2048 + cc * 16) : 0xfffffff0u;
        st[i] = __builtin_amdgcn_raw_buffer_load_b128(ursrc, voff, 0, 0); }
    f32x2 w2[31];
#pragma unroll
    for (int j = 0; j < 31; ++j) w2[j] = __builtin_bit_cast(f32x2, __builtin_amdgcn_raw_buffer_load_b64(wrsrc, tid * 8, j * 4096, 0));
    const f32x2 bb = *(const f32x2*)(cb + 2 * tid), gg = *(const f32x2*)(lg + 2 * tid), be = *(const f32x2*)(lb + 2 * tid);
    if (tid < 64) red[tid] = 0.f;
#pragma unroll
    for (int i = 0; i < 16; ++i) *(LAS v4u*)(Us + (rr0 + 4 * i) * 512 + cc * 4) = st[i];
    __syncthreads();
#pragma unroll 1
    for (int cq = 0; cq < 2; ++cq) {
        f32x2 a[16];
#pragma unroll
        for (int i = 0; i < 16; ++i) a[i] = bb;
        const LAS unsigned* up = Us + (16 * cq) * 512 + tid;
#pragma unroll
        for (int r = 0; r < 46; ++r) { const unsigned uu = up[r * 512]; const f32x2 u2 = (f32x2){bflo(uu), bfhi(uu)};
#pragma unroll
            for (int i = 0; i < 16; ++i) { const int j = r - i; if (j >= 0 && j <= 30) a[i] += u2 * w2[j]; } }
        float v[32];
#pragma unroll
        for (int i = 0; i < 16; ++i) { v[i] = a[i].x + a[i].y; v[16 + i] = a[i].x * a[i].x + a[i].y * a[i].y; }
#pragma unroll
        for (int j = 0; j < 16; ++j) { const bool up_ = (lane & 32) != 0; const float send = up_ ? v[j] : v[j + 16], keep = up_ ? v[j + 16] : v[j]; v[j] = keep + __shfl_xor(send, 32); }
#pragma unroll
        for (int j = 0; j < 8; ++j) { const bool up_ = (lane & 16) != 0; const float send = up_ ? v[j] : v[j + 8], keep = up_ ? v[j + 8] : v[j]; v[j] = keep + __shfl_xor(send, 16); }
#pragma unroll
        for (int j = 0; j < 4; ++j) { const bool up_ = (lane & 8) != 0; const float send = up_ ? v[j] : v[j + 4], keep = up_ ? v[j + 4] : v[j]; v[j] = keep + __shfl_xor(send, 8); }
#pragma unroll
        for (int j = 0; j < 2; ++j) { const bool up_ = (lane & 4) != 0; const float send = up_ ? v[j] : v[j + 2], keep = up_ ? v[j + 2] : v[j]; v[j] = keep + __shfl_xor(send, 4); }
        { const bool up_ = (lane & 2) != 0; const float send = up_ ? v[0] : v[1], keep = up_ ? v[1] : v[0]; v[0] = keep + __shfl_xor(send, 2); }
        v[0] += __shfl_xor(v[0], 1);
        if ((lane & 1) == 0) __hip_atomic_fetch_add(red + cq * 32 + ((lane >> 5) & 1) * 16 + ((lane >> 4) & 1) * 8 + ((lane >> 3) & 1) * 4 + ((lane >> 2) & 1) * 2 + ((lane >> 1) & 1), v[0], __ATOMIC_RELAXED, __HIP_MEMORY_SCOPE_WORKGROUP);
        __syncthreads();
        f32x4 tt[8];
#pragma unroll
        for (int i = 0; i < 8; ++i) tt[i] = *(const LAS f32x4*)(red + cq * 32 + 4 * i);
#pragma unroll
        for (int i = 0; i < 16; ++i) { const float mean = tt[i >> 2][i & 3] * (1.0f / 1024.0f), var = tt[4 + (i >> 2)][i & 3] * (1.0f / 1024.0f) - mean * mean, rstd = __builtin_amdgcn_rsqf(var + EPS);
            float y0 = (a[i].x - mean) * rstd * gg.x + be.x, y1 = (a[i].y - mean) * rstd * gg.y + be.y;
            y0 *= sigm(y0); y1 *= sigm(y1);
            *(GAS unsigned*)(A2 + (size_t)(b * SEQ + t0 + 16 * cq + i) * 2048 + 1024 + 2 * tid) = pk2(y0, y1); }
    }
}

struct Args { const float* in[20]; float* out; unsigned char* ws; int ph_lo, ph_hi; };
__global__ void __launch_bounds__(NWAVES * 64, 2) fwd_kernel(Args args) {
    extern __shared__ __attribute__((aligned(16))) unsigned char lds_raw[];
    LAS unsigned char* lds = (LAS unsigned char*)lds_raw;
    volatile LAS unsigned* MISC = (volatile LAS unsigned*)(lds + MISC_OFF);
    const int tid = threadIdx.x, lane = tid & 63, wave = __builtin_amdgcn_readfirstlane(tid >> 6);
    const int G = gridDim.x, bx = blockIdx.x;
    const int vcu = (G % 8 == 0) ? (bx % 8) * (G / 8) + bx / 8 : bx;
    const int gw = vcu * NWAVES + wave, NGW = G * NWAVES;
#define P_ws (args.ws)
#define P_x (args.in[0])
#define P_c_in (args.in[1])
#define P_w_ada (args.in[2])
#define P_b_ada (args.in[3])
#define P_norm_mix_g (args.in[4])
#define P_w_in (args.in[5])
#define P_q_norm_g (args.in[6])
#define P_k_norm_g (args.in[7])
#define P_attn_sinks (args.in[8])
#define P_rel_bias (args.in[9])
#define P_w_attn_out (args.in[10])
#define P_conv_w (args.in[11])
#define P_conv_b (args.in[12])
#define P_conv_ln_g (args.in[13])
#define P_conv_ln_b (args.in[14])
#define P_w_conv_out (args.in[15])
#define P_w_mix_out (args.in[16])
#define P_norm_ffn_g (args.in[17])
#define P_w_ffn_in (args.in[18])
#define P_w_ffn_out (args.in[19])
#define P_out (args.out)
#define P_MOD ((float*)(P_ws + WS_MOD))
#define P_W1T ((bf16*)(P_ws + WS_W1T))
#define P_W2T ((bf16*)(P_ws + WS_W2T))
#define P_W3T ((bf16*)(P_ws + WS_W3T))
#define P_W4T ((bf16*)(P_ws + WS_W4T))
#define P_W5T ((bf16*)(P_ws + WS_W5T))
#define P_H ((bf16*)(P_ws + WS_H))
#define P_Qb ((bf16*)(P_ws + WS_Q))
#define P_Kb ((bf16*)(P_ws + WS_K))
#define P_Vb ((bf16*)(P_ws + WS_V))
#define P_Ub ((bf16*)(P_ws + WS_U))
#define P_Rb ((bf16*)(P_ws + WS_R))
#define P_GCb ((bf16*)(P_ws + WS_GC))
#define P_A2 ((bf16*)(P_ws + WS_A2))
#define P_MG ((bf16*)(P_ws + WS_MG))
#define P_HF ((bf16*)(P_ws + WS_HF))

    for (int u = tid; u < (LDS_BYTES - LDSCTL_OFF) / 4; u += NWAVES * 64) ((LAS unsigned*)(lds + LDSCTL_OFF))[u] = 0u;
    __syncthreads();
    const int lo = args.ph_lo, hi = args.ph_hi;
#if !MK_CG_SYNC
    XcdBarrier bar; bar.bar = (unsigned*)(P_ws + WS_CTL) + CW_BAR; bar.x = 0; bar.st = nullptr;
    if (hi - lo > 1) bar = xcd_barrier_post((unsigned*)(P_ws + WS_CTL) + CW_BAR, MISC + 8);
    if (lo < 0) cg::this_grid().sync();
#else
    (void)MISC;
#endif
#ifdef PHASE_MASK
#define IN(k) (((PHASE_MASK >> (k)) & 1) && lo <= (k) && (k) < hi)
#else
#define IN(k) (lo <= (k) && (k) < hi)
#endif
#define BOTH(k) (IN(k) && IN((k) + 1))
#ifndef REPEAT_MASK
#define REPEAT_MASK 0
#endif
#if MK_CG_SYNC
#define GRID_BAR(k) do { if (BOTH(k)) cg::this_grid().sync(); } while (0)
#else
#define GRID_BAR(k) do { if (BOTH(k)) xcd_barrier(bar); } while (0)
#endif

    if (IN(0)) {
        p0_adaln(P_c_in, P_w_ada, P_b_ada, P_MOD, (LAS float*)lds, tid, lane, wave);
        LAS float* scr = (LAS float*)(lds + wave * 16384);
        transpose_matrix<1>(P_w_in, DM, N1, P_W1T, 2048, 0, 0, scr, gw, NGW, lane);
#if REPEAT_MASK & 1
        transpose_matrix<1>(P_w_in, DM, N1, P_W1T, 2048, 0, 0, scr, gw, NGW, lane);
#endif
        GRID_BAR(0);
    }
#if (REPEAT_MASK >> 1) & 1
    if (IN(1)) { modnorm_phase(P_x, P_norm_mix_g, P_MOD, 0, DM, P_H, gw, NGW, lane); xcd_barrier(bar); }
#endif
    if (IN(1)) { modnorm_phase(P_x, P_norm_mix_g, P_MOD, 0, DM, P_H, gw, NGW, lane); GRID_BAR(1); }
    if (IN(2)) {
        pg8::Gemm g{P_H, P_W1T, MT, N1, DM}; pg8::StaticOrder S; S.init(MT, N1, G, bx);
        pg8::Epi1 E{P_Qb, P_Ub, P_Rb, P_GCb};
        pg8::gemm_phase<pg8::Epi1, pg8::StaticOrder, true, true>(lds, g, S, E);
        {
            const int nfull = (MT / 256) * (N1 / 256) - (((MT / 256) * (N1 / 256)) / G) * G;
            if (nfull > 0 ? bx >= nfull : true) {
                const int nconv = nfull > 0 ? G - nfull : G, cw_ = ((nfull > 0 ? bx - nfull : bx)) * NWAVES + wave, ncw = nconv * NWAVES;
                LAS float* scr = (LAS float*)(lds + wave * 16384);
                constexpr int J1 = 16 * 64, J2 = 16 * 64, J3 = 32 * 64;
                transpose_matrix<0>(P_w_attn_out, 1024, DM, P_W2T, 2048, 0, 0, scr, cw_, ncw, lane);
                transpose_matrix<0>(P_w_conv_out, 1024, DM, P_W2T, 2048, 1024, J1, scr, cw_, ncw, lane);
                transpose_matrix<0>(P_w_mix_out, DM, DM, P_W3T, 2048, 0, J1 + J2, scr, cw_, ncw, lane);
                transpose_matrix<2>(P_w_ffn_in, DM, N4, P_W4T, 2048, 0, J1 + J2 + J3, scr, cw_, ncw, lane);
            }
        }
        GRID_BAR(2);
    }
#if (REPEAT_MASK >> 2) & 1
    if (IN(2)) {
        pg8::Gemm g{P_H, P_W1T, MT, N1, DM}; pg8::StaticOrder S; S.init(MT, N1, G, bx);
        pg8::Epi1 E{P_Qb, P_Ub, P_Rb, P_GCb};
        pg8::gemm_phase<pg8::Epi1, pg8::StaticOrder, true, true>(lds, g, S, E);
        GRID_BAR(2);
    }
#endif
    if (IN(3)) {
#ifndef NO_ATTN
        for (int u = bx; u < 256; u += G) { attn_unit(u, P_Qb, P_Kb, P_Vb, P_A2, P_q_norm_g, P_k_norm_g, P_attn_sinks, P_rel_bias, lds, tid, lane, wave); __syncthreads(); }
#endif
#ifndef NO_CONV
        for (int u = bx; u < 256; u += G) { conv_unit(u, P_Ub, P_A2, P_conv_w, P_conv_b, P_conv_ln_g, P_conv_ln_b, lds, tid, lane, wave); __syncthreads(); }
#endif
        GRID_BAR(3);
    }
#if (REPEAT_MASK >> 3) & 1
    if (IN(3)) {
#ifndef NO_ATTN
        for (int u = bx; u < 256; u += G) { attn_unit(u, P_Qb, P_Kb, P_Vb, P_A2, P_q_norm_g, P_k_norm_g, P_attn_sinks, P_rel_bias, lds, tid, lane, wave); __syncthreads(); }
#endif
#ifndef NO_CONV
        for (int u = bx; u < 256; u += G) { conv_unit(u, P_Ub, P_A2, P_conv_w, P_conv_b, P_conv_ln_g, P_conv_ln_b, lds, tid, lane, wave); __syncthreads(); }
#endif
        GRID_BAR(3);
    }
#endif
    if (IN(4)) {
        pg8::Gemm g{P_A2, P_W2T, MT, DM, DM}; pg8::StaticOrder S; S.init(MT, DM, G, bx);
        pg8::Epi2 E{P_Rb, P_GCb, P_MG};
        pg8::gemm_phase<pg8::Epi2, pg8::StaticOrder, true, true>(lds, g, S, E);
        GRID_BAR(4);
    }
#if (REPEAT_MASK >> 4) & 1
    if (IN(4)) {
        pg8::Gemm g{P_A2, P_W2T, MT, DM, DM}; pg8::StaticOrder S; S.init(MT, DM, G, bx);
        pg8::Epi2 E{P_Rb, P_GCb, P_MG};
        pg8::gemm_phase<pg8::Epi2, pg8::StaticOrder, true, true>(lds, g, S, E);
        GRID_BAR(4);
    }
#endif
    if (IN(5)) {
        pg8::Gemm g{P_MG, P_W3T, MT, DM, DM}; pg8::StaticOrder S; S.init(MT, DM, G, bx);
        pg8::EpiRes E{P_x, P_out, P_MOD + 2 * DM};
        pg8::gemm_phase<pg8::EpiRes, pg8::StaticOrder, true, true>(lds, g, S, E);
        GRID_BAR(5);
    }
#if (REPEAT_MASK >> 5) & 1
    if (IN(5)) {
        pg8::Gemm g{P_MG, P_W3T, MT, DM, DM}; pg8::StaticOrder S; S.init(MT, DM, G, bx);
        pg8::EpiRes E{P_x, P_out, P_MOD + 2 * DM};
        pg8::gemm_phase<pg8::EpiRes, pg8::StaticOrder, true, true>(lds, g, S, E);
        GRID_BAR(5);
    }
#endif
#if (REPEAT_MASK >> 6) & 1
    if (IN(6)) { modnorm_phase(P_out, P_norm_ffn_g, P_MOD, 3 * DM, 4 * DM, P_H, gw, NGW, lane); xcd_barrier(bar); }
#endif
    if (IN(6)) { modnorm_phase(P_out, P_norm_ffn_g, P_MOD, 3 * DM, 4 * DM, P_H, gw, NGW, lane); GRID_BAR(6); }
    if (IN(7)) {
        pg8::Gemm g{P_H, P_W4T, MT, N4, DM}; pg8::StaticOrder S; S.init(MT, N4, G, bx);
        pg8::Epi4 E{P_HF};
        pg8::gemm_phase<pg8::Epi4, pg8::StaticOrder, true, true>(lds, g, S, E);
        {
            const int nfull = (MT / 256) * (N4 / 256) - (((MT / 256) * (N4 / 256)) / G) * G;
            if (nfull > 0 ? bx >= nfull : true) {
                const int nconv = nfull > 0 ? G - nfull : G, cw_ = ((nfull > 0 ? bx - nfull : bx)) * NWAVES + wave, ncw = nconv * NWAVES;
                LAS float* scr = (LAS float*)(lds + wave * 16384);
                transpose_matrix<0>(P_w_ffn_out, DFF, DM, P_W5T, DFF, 0, 0, scr, cw_, ncw, lane);
            }
        }
        GRID_BAR(7);
    }
#if (REPEAT_MASK >> 7) & 1
    if (IN(7)) {
        pg8::Gemm g{P_H, P_W4T, MT, N4, DM}; pg8::StaticOrder S; S.init(MT, N4, G, bx);
        pg8::Epi4 E{P_HF};
        pg8::gemm_phase<pg8::Epi4, pg8::StaticOrder, true, true>(lds, g, S, E);
        GRID_BAR(7);
    }
#endif
#if (REPEAT_MASK >> 8) & 1
    if (IN(8)) {
        pg8::Gemm g{P_HF, P_W5T, MT, DM, DFF}; pg8::StaticOrder S; S.init(MT, DM, G, bx);
        pg8::EpiRes E{P_out, (float*)(P_ws + WS_A2), P_MOD + 5 * DM};
        pg8::gemm_phase<pg8::EpiRes, pg8::StaticOrder, true, true>(lds, g, S, E);
        xcd_barrier(bar);
    }
#endif
    if (IN(8)) {
        pg8::Gemm g{P_HF, P_W5T, MT, DM, DFF}; pg8::StaticOrder S; S.init(MT, DM, G, bx);
        pg8::EpiRes E{P_out, P_out, P_MOD + 5 * DM};
        pg8::gemm_phase<pg8::EpiRes, pg8::StaticOrder, true, true>(lds, g, S, E);
    }
#undef IN
#undef BOTH
#undef GRID_BAR
}
#undef P_ws
#undef P_x
#undef P_c_in
#undef P_w_ada
#undef P_b_ada
#undef P_norm_mix_g
#undef P_w_in
#undef P_q_norm_g
#undef P_k_norm_g
#undef P_attn_sinks
#undef P_rel_bias
#undef P_w_attn_out
#undef P_conv_w
#undef P_conv_b
#undef P_conv_ln_g
#undef P_conv_ln_b
#undef P_w_conv_out
#undef P_w_mix_out
#undef P_norm_ffn_g
#undef P_w_ffn_in
#undef P_w_ffn_out
#undef P_out
#undef P_MOD
#undef P_W1T
#undef P_W2T
#undef P_W3T
#undef P_W4T
#undef P_W5T
#undef P_H
#undef P_Qb
#undef P_Kb
#undef P_Vb
#undef P_Ub
#undef P_Rb
#undef P_GCb
#undef P_A2
#undef P_MG
#undef P_HF

extern "C" void kernel_launch(void* const* d_in, const int* in_sizes, int n_in, void* d_out, int out_size, void* d_ws, size_t ws_size, hipStream_t stream) {
    static int grid = 0;
    if (grid == 0) {
        if (n_in != 20 || in_sizes[0] != MT * DM || out_size != MT * DM || ws_size < WS_END) {
            fprintf(stderr, "kernel_launch: shape/workspace mismatch (n_in %d, in0 %d, out %d, ws %zu, need %zu); nothing launched\n", n_in, n_in > 0 ? in_sizes[0] : -1, out_size, ws_size, (size_t)WS_END); grid = -1; return; }
        int dev = 0, cus = 0, per_cu = 0;
        if (hipGetDevice(&dev) != hipSuccess || hipDeviceGetAttribute(&cus, hipDeviceAttributeMultiprocessorCount, dev) != hipSuccess) { fprintf(stderr, "kernel_launch: device query failed\n"); grid = -1; return; }
        if (hipFuncSetAttribute((const void*)fwd_kernel, hipFuncAttributeMaxDynamicSharedMemorySize, LDS_BYTES) != hipSuccess) { fprintf(stderr, "kernel_launch: hipFuncSetAttribute failed\n"); grid = -1; return; }
        if (hipOccupancyMaxActiveBlocksPerMultiprocessor(&per_cu, (const void*)fwd_kernel, NWAVES * 64, LDS_BYTES) != hipSuccess || per_cu < 1) { fprintf(stderr, "kernel_launch: occupancy query says %d blocks per CU\n", per_cu); per_cu = 1; }
        (void)hipGetLastError();
        grid = cus * (per_cu < 1 ? 1 : 1);
        if (grid != 256) fprintf(stderr, "kernel_launch: note: grid = %d workgroups\n", grid);
    }
    if (grid < 0) return;
    if (hipMemsetAsync((char*)d_ws + WS_CTL, 0, CTL_ZERO_BYTES, stream) != hipSuccess) { fprintf(stderr, "kernel_launch: memset failed\n"); return; }
    Args a{};
    for (int i = 0; i < 20; ++i) a.in[i] = (const float*)d_in[i];
    a.out = (float*)d_out; a.ws = (unsigned char*)d_ws;
#if MK_PER_PHASE
    for (int ph = 0; ph < N_PHASES; ++ph) { a.ph_lo = ph; a.ph_hi = ph + 1; hipLaunchKernelGGL(fwd_kernel, dim3(grid), dim3(NWAVES * 64), LDS_BYTES, stream, a); }
#else
    a.ph_lo = 0; a.ph_hi = N_PHASES;
    void* kargs[] = {(void*)&a};
    const hipError_t e = hipLaunchCooperativeKernel((const void*)fwd_kernel, dim3(grid), dim3(NWAVES * 64), kargs, LDS_BYTES, stream);
    if (e != hipSuccess) fprintf(stderr, "kernel_launch: cooperative launch failed: %s (grid %d)\n", hipGetErrorString(e), grid);
#endif
}
```

```cpp
#include <hip/hip_runtime.h>
#include <hip/hip_cooperative_groups.h>
#include <cstdio>
#include <cstdint>
namespace cg = cooperative_groups;

#ifndef MK_PER_PHASE
#define MK_PER_PHASE 0
#endif
#ifndef MK_CG_SYNC
#define MK_CG_SYNC 0
#endif

namespace pg8 {
#define PG8_LAS __attribute__((address_space(3)))
typedef unsigned short bf16_t;
typedef short bf16x8 __attribute__((ext_vector_type(8)));
typedef float f32x4 __attribute__((ext_vector_type(4)));
typedef unsigned u32x4 __attribute__((ext_vector_type(4)));
constexpr int BM = 256, BK = 64, HALF = 128, HTB = HALF * BK * 2  , STAGE_BYTES = 8 * HTB, NXCD = 8, WGM = 8;

__host__ __device__ __forceinline__ int lds_byte(int r, int c) { const int st = (r >> 4) * 2 + (c >> 5), rr = r & 15, cc = c & 31, ob = rr * 64 + cc * 2; return st * 1024 + (ob ^ (((ob >> 9) & 1) << 5)); }
__host__ __device__ __forceinline__ void stage_rc(int b, int& R, int& C) { const int st = b / 1024, sb = b % 1024, swz = sb ^ (((sb >> 9) & 1) << 5); R = (st >> 1) * 16 + swz / 64; C = (st & 1) * 32 + (swz % 64) / 2; }
__host__ __device__ __forceinline__ int perm32(int rho) { const int n = rho >> 4, i = rho & 15; return 8 * (i >> 2) + 4 * n + (i & 3); }

struct Unit { int pm, pn; };
struct Gemm { const bf16_t* A; const bf16_t* Bt; int M, N, K; };

struct StaticOrder {
    int nM, nN, nwg, G, c;
    __host__ __device__ void init(int M, int N, int G_, int c_) { nM = M / BM; nN = N / BM; nwg = nM * nN; G = G_; c = c_; }
    __host__ __device__ bool next(int i, Unit& u) const {
        const long L = (long)i * G + c; if (L >= nwg) return false;
        int wgid = (int)L; { const int q = nwg / NXCD, r = nwg % NXCD, xcd = wgid % NXCD, off = wgid / NXCD; wgid = (xcd < r ? xcd * (q + 1) : r * (q + 1) + (xcd - r) * q) + off; }
        const int nig = WGM * nN, gid = wgid / nig, fm = gid * WGM, gsz = (nM - fm) < WGM ? (nM - fm) : WGM;
        u.pm = fm + ((wgid % nig) % gsz); u.pn = (wgid % nig) / gsz; return true;
    }
    __device__ __forceinline__ void a_ready(const Unit&) const {}
    __device__ __forceinline__ void done(const Unit&) const {}
};


__device__ __forceinline__ unsigned cvt_pk_bf16(float lo, float hi) { unsigned r; asm volatile("v_cvt_pk_bf16_f32 %0, %1, %2" : "=v"(r) : "v"(lo), "v"(hi)); return r; }
__device__ __forceinline__ float sigm(float x) { return __builtin_amdgcn_rcpf(1.0f + __builtin_amdgcn_exp2f(-1.4426950408889634f * x)); }
__device__ __forceinline__ u32x4 pack8(const f32x4& v0, const f32x4& v1) { u32x4 w; w.x = cvt_pk_bf16(v0[0], v0[1]); w.y = cvt_pk_bf16(v0[2], v0[3]); w.z = cvt_pk_bf16(v1[0], v1[1]); w.w = cvt_pk_bf16(v1[2], v1[3]); return w; }
__device__ __forceinline__ void unpack8(const u32x4& w, f32x4& v0, f32x4& v1) {
    v0[0] = __uint_as_float(w.x << 16); v0[1] = __uint_as_float(w.x & 0xffff0000u); v0[2] = __uint_as_float(w.y << 16); v0[3] = __uint_as_float(w.y & 0xffff0000u);
    v1[0] = __uint_as_float(w.z << 16); v1[1] = __uint_as_float(w.z & 0xffff0000u); v1[2] = __uint_as_float(w.w << 16); v1[3] = __uint_as_float(w.w & 0xffff0000u); }

struct Epi1 {
    static constexpr bool PERM = true, AFTER_DRAIN = false, MID = false;
    bf16_t *Q, *U, *R, *GC;
    __device__ __forceinline__ void mid(f32x4 (&)[2][2][4][2], const Unit&, int, int, int, int) const {}
    __device__ __forceinline__ void operator()(const f32x4 (&acc)[2][2][4][2], const Unit& u, int wr, int wc, int fr, int fq) const {
        const int row0 = u.pm * BM + wr * 64 + fr, cl = wc * 32 + 8 * fq;
        if (u.pn < 6) {
            const size_t boff = u.pn < 4 ? (size_t)0 : (u.pn == 4 ? (size_t)8388608 : (size_t)10485760);
            bf16_t* base = Q + boff; const int ld = u.pn < 4 ? 1024 : 256, c0 = u.pn < 4 ? u.pn * 256 : 0;
#pragma unroll
            for (int ai = 0; ai < 2; ++ai)
#pragma unroll
                for (int m = 0; m < 4; ++m) { bf16_t* rowp = base + (size_t)(row0 + ai * HALF + m * 16) * ld + c0 + cl;
#pragma unroll
                    for (int bj = 0; bj < 2; ++bj) *(u32x4*)(rowp + bj * HALF) = pack8(acc[ai][bj][m][0], acc[ai][bj][m][1]); }
        } else if (u.pn < 14) {
            const int c0 = (u.pn - 6) * 128 + cl;
#pragma unroll
            for (int ai = 0; ai < 2; ++ai)
#pragma unroll
                for (int m = 0; m < 4; ++m) { f32x4 o[2];
#pragma unroll
                    for (int n = 0; n < 2; ++n)
#pragma unroll
                        for (int e = 0; e < 4; ++e) o[n][e] = acc[ai][0][m][n][e] * sigm(acc[ai][1][m][n][e]);
                    *(u32x4*)(U + (size_t)(row0 + ai * HALF + m * 16) * 1024 + c0) = pack8(o[0], o[1]); }
        } else {
            const int c0 = (u.pn - 14) * 128 + cl;
#pragma unroll
            for (int ai = 0; ai < 2; ++ai)
#pragma unroll
                for (int m = 0; m < 4; ++m) { f32x4 r[2], g[2];
#pragma unroll
                    for (int n = 0; n < 2; ++n)
#pragma unroll
                        for (int e = 0; e < 4; ++e) { const float ea = __builtin_amdgcn_exp2f(-1.4426950408889634f * acc[ai][0][m][n][e]), ec = __builtin_amdgcn_exp2f(-1.4426950408889634f * acc[ai][1][m][n][e]);
                            g[n][e] = __builtin_amdgcn_rcpf(1.0f + ec); r[n][e] = (1.0f + ec) * __builtin_amdgcn_rcpf(1.0f + ea); }
                    const size_t off = (size_t)(row0 + ai * HALF + m * 16) * 2048 + c0;
                    *(u32x4*)(R + off) = pack8(r[0], r[1]); *(u32x4*)(GC + off) = pack8(g[0], g[1]); }
        }
    }
};
struct Epi2 {
    static constexpr bool PERM = true, AFTER_DRAIN = false, MID = true;
    const bf16_t *R, *GC; bf16_t* O;
    __device__ __forceinline__ void mid(f32x4 (&acc)[2][2][4][2], const Unit& u, int wr, int wc, int fr, int fq) const {
        asm volatile("" : "+v"(fr), "+v"(fq));
        const int row0 = u.pm * BM + wr * 64 + fr, col0 = u.pn * BM + wc * 32 + 8 * fq;
#pragma unroll
        for (int ai = 0; ai < 2; ++ai)
#pragma unroll
            for (int m = 0; m < 4; ++m) { const bf16_t* rowp = R + (size_t)(row0 + ai * HALF + m * 16) * 2048 + col0;
#pragma unroll
                for (int bj = 0; bj < 2; ++bj) { const u32x4 w = *(const u32x4*)(rowp + bj * HALF); f32x4 s0, s1; unpack8(w, s0, s1); acc[ai][bj][m][0] *= s0; acc[ai][bj][m][1] *= s1; }
                if (m & 1) asm volatile("" ::: "memory"); }
    }
    __device__ __forceinline__ void operator()(const f32x4 (&acc)[2][2][4][2], const Unit& u, int wr, int wc, int fr, int fq) const {
        const int row0 = u.pm * BM + wr * 64 + fr, col0 = u.pn * BM + wc * 32 + 8 * fq;
#pragma unroll
        for (int ai = 0; ai < 2; ++ai)
#pragma unroll
            for (int m = 0; m < 4; ++m) { const size_t off = (size_t)(row0 + ai * HALF + m * 16) * 2048 + col0;
#pragma unroll
                for (int bj = 0; bj < 2; ++bj) { const u32x4 w = *(const u32x4*)(GC + off + bj * HALF); f32x4 s0, s1; unpack8(w, s0, s1);
                    *(u32x4*)(O + off + bj * HALF) = pack8(acc[ai][bj][m][0] * s0, acc[ai][bj][m][1] * s1); }
                if (m & 1) asm volatile("" ::: "memory"); }
    }
};
struct EpiRes {
    static constexpr bool PERM = false, AFTER_DRAIN = false, MID = false;
    const float* base; float* out; const float* gate;
    __device__ __forceinline__ void mid(f32x4 (&)[2][2][4][2], const Unit&, int, int, int, int) const {}
    __device__ __forceinline__ void operator()(const f32x4 (&acc)[2][2][4][2], const Unit& u, int wr, int wc, int fr, int fq) const {
        const int row0 = u.pm * BM + wr * 64 + fr, col0 = u.pn * BM + wc * 32 + 4 * fq;
        const float* gp = gate + (size_t)(u.pm >> 3) * 12288 + col0;
        f32x4 gv[2][2];
#pragma unroll
        for (int bj = 0; bj < 2; ++bj)
#pragma unroll
            for (int n = 0; n < 2; ++n) gv[bj][n] = *(const f32x4*)(gp + bj * HALF + n * 16);
#pragma unroll
        for (int ai = 0; ai < 2; ++ai)
#pragma unroll
            for (int m = 0; m < 4; ++m) { const size_t off = (size_t)(row0 + ai * HALF + m * 16) * 2048 + col0;
#pragma unroll
                for (int bj = 0; bj < 2; ++bj)
#pragma unroll
                    for (int n = 0; n < 2; ++n) { const f32x4 b = *(const f32x4*)(base + off + bj * HALF + n * 16); *(f32x4*)(out + off + bj * HALF + n * 16) = b + gv[bj][n] * acc[ai][bj][m][n]; } }
    }
};
struct Epi4 {
    static constexpr bool PERM = true, AFTER_DRAIN = false, MID = false;
    bf16_t* HF;
    __device__ __forceinline__ void mid(f32x4 (&)[2][2][4][2], const Unit&, int, int, int, int) const {}
    __device__ __forceinline__ void operator()(const f32x4 (&acc)[2][2][4][2], const Unit& u, int wr, int wc, int fr, int fq) const {
        const int row0 = u.pm * BM + wr * 64 + fr, c0 = u.pn * 128 + wc * 32 + 8 * fq;
#pragma unroll
        for (int ai = 0; ai < 2; ++ai)
#pragma unroll
            for (int m = 0; m < 4; ++m) { f32x4 o[2];
#pragma unroll
                for (int n = 0; n < 2; ++n)
#pragma unroll
                    for (int e = 0; e < 4; ++e) { const float g = acc[ai][0][m][n][e]; o[n][e] = g * sigm(g) * acc[ai][1][m][n][e]; }
                *(u32x4*)(HF + (size_t)(row0 + ai * HALF + m * 16) * 5632 + c0) = pack8(o[0], o[1]); }
    }
};

template <class Epi, class Sched, bool ALIGN_EPI = false, bool SP2 = false>
__device__ __forceinline__ void gemm_phase(PG8_LAS unsigned char* lds, const Gemm g, const Sched& S, const Epi& E) {
    const int tid = threadIdx.x, wid = __builtin_amdgcn_readfirstlane(tid >> 6), lane = tid & 63, wr = wid >> 2, wc = wid & 3, fr = lane & 15, fq = lane >> 4;
    const int K = g.K, nt = K / BK;
    unsigned voffA[2], voffB[2];
#pragma unroll
    for (int i = 0; i < 2; ++i) { int R, C; stage_rc(tid * 16 + i * 8192, R, C); const int Rb = Epi::PERM ? ((R & ~31) + perm32(R & 31)) : R;
        voffA[i] = (unsigned)(R * K + C) * 2u; voffB[i] = (unsigned)(Rb * K + C) * 2u; }
    const size_t kstep = (size_t)(BK * 2);
    const size_t hstep = (size_t)HALF * K * 2;
    const size_t tstep = 2 * hstep;
    const unsigned ldsw = (unsigned)wid * 1024u;
    const int aoff = lds_byte(wr * 64 + fr, fq * 8), boff = lds_byte(wc * 32 + fr, fq * 8);
#define PG8_SA(b, h) (((b) * 2 + (h)) * HTB)
#define PG8_SB(b, h) ((4 + (b) * 2 + (h)) * HTB)
#define PG8_STAGE(bufoff, gbase, voff) do { _Pragma("unroll") for (int _i = 0; _i < 2; ++_i) \
        __builtin_amdgcn_global_load_lds((const unsigned*)((const char*)(gbase) + (voff)[_i]), (PG8_LAS unsigned*)(lds + (bufoff) + ldsw + _i * 8192), 16, 0, 0); } while (0)
#define PG8_LDA(dst, b, h) do { _Pragma("unroll") for (int m = 0; m < 4; ++m) _Pragma("unroll") for (int k = 0; k < 2; ++k) dst[m][k] = *(const PG8_LAS bf16x8*)(lds + PG8_SA(b, h) + aoff + m * 2048 + k * 1024); } while (0)
#define PG8_LDB(dst, b, h) do { _Pragma("unroll") for (int n = 0; n < 2; ++n) _Pragma("unroll") for (int k = 0; k < 2; ++k) dst[n][k] = *(const PG8_LAS bf16x8*)(lds + PG8_SB(b, h) + boff + n * 2048 + k * 1024); } while (0)
#define PG8_MMA(ai, bj, At, Bt) do { __builtin_amdgcn_s_setprio(1); _Pragma("unroll") for (int m = 0; m < 4; ++m) _Pragma("unroll") for (int n = 0; n < 2; ++n) _Pragma("unroll") for (int k = 0; k < 2; ++k) \
        acc[ai][bj][m][n] = __builtin_amdgcn_mfma_f32_16x16x32_bf16(Bt[n][k], At[m][k], acc[ai][bj][m][n], 0, 0, 0); __builtin_amdgcn_s_setprio(0); } while (0)
#define PG8_WAIT_V(n) asm volatile("s_waitcnt vmcnt(" #n ")" ::: "memory")
#define PG8_WAIT_L(n) asm volatile("s_waitcnt lgkmcnt(" #n ")" ::: "memory")
#define PG8_BAR __builtin_amdgcn_s_barrier()
#define PG8_SCHED __builtin_amdgcn_sched_barrier(0)
    Unit cur, nxt; int ui = 0;
    if (!S.next(0, cur)) return;
    f32x4 acc[2][2][4][2];
#pragma unroll
    for (int a = 0; a < 2; ++a)
#pragma unroll
        for (int b = 0; b < 2; ++b)
#pragma unroll
            for (int m = 0; m < 4; ++m)
#pragma unroll
                for (int n = 0; n < 2; ++n) acc[a][b][m][n] = (f32x4){0.f, 0.f, 0.f, 0.f};
    bf16x8 At[4][2], B0[2][2], B1[2][2];
    const char* cA = (const char*)g.A + (size_t)cur.pm * tstep; const char* cB = (const char*)g.Bt + (size_t)cur.pn * tstep;
    S.a_ready(cur);
    if constexpr (SP2) {
        PG8_STAGE(PG8_SB(0, 0), cB, voffB); PG8_STAGE(PG8_SB(0, 1), cB + hstep, voffB); PG8_STAGE(PG8_SA(0, 0), cA, voffA); PG8_STAGE(PG8_SA(0, 1), cA + hstep, voffA);
        if (wr == 1) PG8_BAR;
        PG8_WAIT_V(2); PG8_BAR;
        PG8_STAGE(PG8_SB(1, 0), cB + kstep, voffB); PG8_STAGE(PG8_SA(1, 0), cA + kstep, voffA); PG8_STAGE(PG8_SB(1, 1), cB + hstep + kstep, voffB);
        PG8_WAIT_V(6); PG8_BAR;
    } else {
        PG8_STAGE(PG8_SB(0, 0), cB, voffB); PG8_STAGE(PG8_SA(0, 0), cA, voffA); PG8_STAGE(PG8_SB(0, 1), cB + hstep, voffB); PG8_STAGE(PG8_SA(0, 1), cA + hstep, voffA);
        if (wr == 1) PG8_BAR;
        PG8_WAIT_V(4); PG8_BAR;
        PG8_STAGE(PG8_SB(1, 0), cB + kstep, voffB); PG8_STAGE(PG8_SA(1, 0), cA + kstep, voffA); PG8_STAGE(PG8_SB(1, 1), cB + hstep + kstep, voffB);
        PG8_WAIT_V(6); PG8_BAR;
    }
    for (;;) {
        const bool has_next = S.next(ui + 1, nxt);
        const char* nA = has_next ? (const char*)g.A + (size_t)nxt.pm * tstep : cA; const char* nB = has_next ? (const char*)g.Bt + (size_t)nxt.pn * tstep : cB;
        for (int t = 0; t < nt; t += 2) {
            const bool last = (t == nt - 2);
            const char* a1 = cA + (size_t)(t + 1) * kstep;
            const char* a2 = last ? nA : cA + (size_t)(t + 2) * kstep; const char* b2 = last ? nB : cB + (size_t)(t + 2) * kstep;
            const char* a3 = a2 + kstep; const char* b3 = b2 + kstep;
            if (last && has_next) S.a_ready(nxt);
            if constexpr (Epi::MID) { if (t == (nt >> 1)) E.mid(acc, cur, wr, wc, fr, fq); }
            if constexpr (SP2) {
            PG8_LDB(B0, 0, 0); PG8_LDB(B1, 0, 1); PG8_SCHED; PG8_LDA(At, 0, 0); PG8_STAGE(PG8_SA(1, 1), a1 + hstep, voffA);
            PG8_WAIT_V(8); PG8_WAIT_L(0); PG8_BAR; PG8_MMA(0, 0, At, B0); PG8_MMA(0, 1, At, B1); PG8_BAR; PG8_SCHED;
            PG8_LDA(At, 0, 1); PG8_STAGE(PG8_SB(0, 0), b2, voffB); PG8_STAGE(PG8_SB(0, 1), b2 + hstep, voffB); PG8_STAGE(PG8_SA(0, 0), a2, voffA);
            PG8_WAIT_V(8); PG8_WAIT_L(0); PG8_BAR; PG8_MMA(1, 0, At, B0); PG8_MMA(1, 1, At, B1); PG8_BAR; PG8_SCHED;
            PG8_LDB(B0, 1, 0); PG8_LDB(B1, 1, 1); PG8_SCHED; PG8_LDA(At, 1, 0); PG8_STAGE(PG8_SA(0, 1), a2 + hstep, voffA);
            PG8_WAIT_V(8); PG8_WAIT_L(0); PG8_BAR; PG8_MMA(0, 0, At, B0); PG8_MMA(0, 1, At, B1); PG8_BAR; PG8_SCHED;
            PG8_LDA(At, 1, 1); PG8_STAGE(PG8_SB(1, 0), b3, voffB); PG8_STAGE(PG8_SB(1, 1), b3 + hstep, voffB); PG8_STAGE(PG8_SA(1, 0), a3, voffA);
            PG8_WAIT_V(8); PG8_WAIT_L(0); PG8_BAR; PG8_MMA(1, 0, At, B0); PG8_MMA(1, 1, At, B1); PG8_BAR; PG8_SCHED;
            } else {
            PG8_LDB(B0, 0, 0); PG8_SCHED; PG8_LDA(At, 0, 0); PG8_STAGE(PG8_SA(1, 1), a1 + hstep, voffA);
            PG8_WAIT_L(8); PG8_BAR; PG8_WAIT_L(0); PG8_MMA(0, 0, At, B0); PG8_BAR; PG8_SCHED;
            PG8_LDB(B1, 0, 1); PG8_STAGE(PG8_SB(0, 0), b2, voffB);
            PG8_BAR; PG8_WAIT_L(0); PG8_MMA(0, 1, At, B1); PG8_BAR;
            PG8_LDA(At, 0, 1); PG8_STAGE(PG8_SA(0, 0), a2, voffA);
            PG8_BAR; PG8_WAIT_L(0); PG8_MMA(1, 0, At, B0); PG8_BAR; PG8_SCHED;
            PG8_STAGE(PG8_SB(0, 1), b2 + hstep, voffB);
            PG8_WAIT_V(6); PG8_BAR; PG8_MMA(1, 1, At, B1); PG8_BAR;
            PG8_LDB(B0, 1, 0); PG8_SCHED; PG8_LDA(At, 1, 0); PG8_STAGE(PG8_SA(0, 1), a2 + hstep, voffA);
            PG8_WAIT_L(8); PG8_BAR; PG8_WAIT_L(0); PG8_MMA(0, 0, At, B0); PG8_BAR; PG8_SCHED;
            PG8_LDB(B1, 1, 1); PG8_STAGE(PG8_SB(1, 0), b3, voffB);
            PG8_BAR; PG8_WAIT_L(0); PG8_MMA(0, 1, At, B1); PG8_BAR;
            PG8_LDA(At, 1, 1); PG8_STAGE(PG8_SA(1, 0), a3, voffA);
            PG8_BAR; PG8_WAIT_L(0); PG8_MMA(1, 0, At, B0); PG8_BAR; PG8_SCHED;
            PG8_STAGE(PG8_SB(1, 1), b3 + hstep, voffB);
            PG8_WAIT_V(6); PG8_BAR; PG8_MMA(1, 1, At, B1); PG8_BAR;
            }
        }
        if constexpr (ALIGN_EPI) { if (wr == 0) PG8_BAR; }
        if constexpr (!Epi::AFTER_DRAIN) { E(acc, cur, wr, wc, fr, fq); S.done(cur); }
        if (!has_next) break;
#pragma unroll
        for (int a = 0; a < 2; ++a)
#pragma unroll
            for (int b = 0; b < 2; ++b)
#pragma unroll
                for (int m = 0; m < 4; ++m)
#pragma unroll
                    for (int n = 0; n < 2; ++n) acc[a][b][m][n] = (f32x4){0.f, 0.f, 0.f, 0.f};
        cur = nxt; cA = nA; cB = nB; ++ui;
        if constexpr (ALIGN_EPI) { if (wr == 1) PG8_BAR; }
    }
    PG8_WAIT_V(0);
    if constexpr (!ALIGN_EPI) { if (wr == 0) PG8_BAR; }
    PG8_BAR;
    if constexpr (Epi::AFTER_DRAIN) { E.fused(acc, cur, wr, wc, fr, fq, lds, wid, lane); S.done(cur); }
#undef PG8_SA
#undef PG8_SB
#undef PG8_STAGE
#undef PG8_LDA
#undef PG8_LDB
#undef PG8_MMA
#undef PG8_WAIT_V
#undef PG8_WAIT_L
#undef PG8_BAR
#undef PG8_SCHED
}
}


constexpr int NWAVES = 8;
constexpr int DM = 2048, BATCH = 4, SEQ = 2048, MT = BATCH * SEQ;
constexpr int NQ = 1024, NKVW = 256, CONVC = 1024, DFF = 5632, NMOD = 6 * DM;
constexpr int N1 = 7680, N4 = 2 * DFF;
constexpr float EPS = 1e-6f, LOG2E = 1.4426950408889634f;
constexpr int N_PHASES = 9;
constexpr int W4_P0 = 6784;

constexpr size_t MiB = 1u << 20;
constexpr size_t WS_CTL = 0, WS_MOD = 65536, CTL_ZERO_BYTES = 262144;
constexpr size_t WS_W1T = 1 * MiB, WS_W2T = 31 * MiB, WS_W3T = 39 * MiB, WS_W4T = 47 * MiB, WS_W5T = 91 * MiB;
constexpr size_t WS_H = 113 * MiB;
constexpr size_t WS_Q = 145 * MiB, WS_K = 161 * MiB, WS_V = 165 * MiB, WS_U = 169 * MiB, WS_R = 185 * MiB, WS_GC = 217 * MiB;
constexpr size_t WS_A2 = 249 * MiB, WS_MG = 281 * MiB, WS_END = 313 * MiB;
constexpr size_t WS_HF = 145 * MiB;
static_assert(WS_HF + (size_t)MT * DFF * 2 <= WS_A2, "HF overlay");
static_assert(WS_K - WS_Q == 2 * (size_t)8388608 && WS_V - WS_Q == 2 * (size_t)10485760, "Epi1 reaches K and V from Q by fixed element offsets");
constexpr int CW_BAR = 1024;

constexpr int RING_BYTES = 131072, LDSCTL_OFF = RING_BYTES, MISC_OFF = LDSCTL_OFF + 320, LDS_BYTES = 147456;

#define GAS __attribute__((address_space(1)))
#define LAS __attribute__((address_space(3)))
typedef unsigned short bf16;
typedef unsigned v4u __attribute__((ext_vector_type(4)));
typedef unsigned v2u __attribute__((ext_vector_type(2)));
typedef float f32x4 __attribute__((ext_vector_type(4)));
typedef float f32x2 __attribute__((ext_vector_type(2)));
typedef float f32x16 __attribute__((ext_vector_type(16)));
typedef short bf16x8 __attribute__((ext_vector_type(8)));
typedef short s16x4 __attribute__((ext_vector_type(4)));
typedef GAS unsigned gu32;
#define RLX_AGENT __ATOMIC_RELAXED, __HIP_MEMORY_SCOPE_AGENT
#define LDS_WAIT() asm volatile("s_waitcnt lgkmcnt(0)" ::: "memory")
__device__ __forceinline__ unsigned f2bf(float f) { unsigned u = __builtin_bit_cast(unsigned, f); return (u + 0x7fffu + ((u >> 16) & 1u)) >> 16; }
__device__ __forceinline__ unsigned pk2(float lo, float hi) { return f2bf(lo) | (f2bf(hi) << 16); }
__device__ __forceinline__ float bflo(unsigned w) { return __uint_as_float(w << 16); }
__device__ __forceinline__ float bfhi(unsigned w) { return __uint_as_float(w & 0xffff0000u); }
__device__ __forceinline__ float sigm(float x) { return __builtin_amdgcn_rcpf(1.0f + __builtin_amdgcn_exp2f(-LOG2E * x)); }
__device__ __forceinline__ float wave_sum(float v) {
#pragma unroll
    for (int o = 1; o < 64; o <<= 1) v += __shfl_xor(v, o);
    return v;
}

#define XB_TMO      128
#define XB_XCNT(j)  (256  + 64 * (j))
#define XB_XSUB(j)  (1280 + 64 * (j))
#define XB_XGEN(j)  (2304 + 64 * (j))
#define XB_TOP      3328
#define XB_TOPGEN   3392
#define XCD_BAR_WORDS 3456
#define XB_SPIN_CAP (1u << 18)

__device__ __forceinline__ unsigned xb_ld(unsigned* p)              { return __hip_atomic_load(p, __ATOMIC_RELAXED, __HIP_MEMORY_SCOPE_AGENT); }
__device__ __forceinline__ unsigned xb_add(unsigned* p, unsigned v) { return __hip_atomic_fetch_add(p, v, __ATOMIC_RELAXED, __HIP_MEMORY_SCOPE_AGENT); }
__device__ __forceinline__ unsigned xb_xcc_id() { return (unsigned)__builtin_amdgcn_s_getreg((3 << 11) | 20) & 0xFu; }
#define XB_SPIN(cond, bar) do { unsigned _sp = 0; while (cond) { __builtin_amdgcn_s_sleep(1); \
    if ((++_sp & 255u) == 0u) { if (xb_ld(&(bar)[XB_TMO])) break; if (_sp > XB_SPIN_CAP) { atomicAdd(&(bar)[XB_TMO], 1u); break; } } } } while (0)

struct XcdBarrier {
    unsigned* bar; unsigned x;
    volatile LAS unsigned* st;
};

__device__ __forceinline__ XcdBarrier xcd_barrier_post(unsigned* bar, volatile LAS unsigned* st) {
    XcdBarrier b; b.bar = bar; b.x = xb_xcc_id(); b.st = st;
    if (threadIdx.x == 0) (void)xb_add(&bar[XB_XCNT(b.x)], 1u);
    return b;
}
__device__ __forceinline__ void xcd_barrier_complete(unsigned* bar, unsigned x, unsigned& nloc, unsigned& nx) {
    const unsigned G = gridDim.x * gridDim.y * gridDim.z;
    unsigned sum, cnt, mine, sp = 0u;
    for (;;) {
        sum = 0u; cnt = 0u; mine = 0u;
#pragma unroll
        for (unsigned j = 0; j < 16; ++j) { const unsigned c = xb_ld(&bar[XB_XCNT(j)]); sum += c; cnt += (c > 0u) ? 1u : 0u; mine = (j == x) ? c : mine; }
        if (sum == G) break;
        __builtin_amdgcn_s_sleep(1);
        if ((++sp & 255u) == 0u) { if (xb_ld(&bar[XB_TMO])) break; if (sp > XB_SPIN_CAP) { atomicAdd(&bar[XB_TMO], 1u); break; } }
    }
    nloc = mine > 0u ? mine : 1u; nx = cnt > 0u ? cnt : 1u;
}

__device__ __forceinline__ void xcd_barrier(const XcdBarrier& b) {
    asm volatile("s_waitcnt vmcnt(0)" ::: "memory");
    __syncthreads();
    if (threadIdx.x == 0) {
        unsigned* bar = b.bar;
        __builtin_amdgcn_s_waitcnt(0);
        unsigned nloc = b.st[0], nx = b.st[1];
        if (nloc == 0u) { xcd_barrier_complete(bar, b.x, nloc, nx); b.st[0] = nloc; b.st[1] = nx; }
        const unsigned old = xb_add(&bar[XB_XSUB(b.x)], 1u);
        const unsigned gen = old / nloc;
        if (old + 1u == (gen + 1u) * nloc) {
            __builtin_amdgcn_fence(__ATOMIC_RELEASE, "agent");
            asm volatile("s_waitcnt vmcnt(0)" ::: "memory");
            const unsigned og = xb_add(&bar[XB_TOP], 1u);
            const unsigned tg = og / nx;
            if (og + 1u == (tg + 1u) * nx) xb_add(&bar[XB_TOPGEN], 1u);
            else XB_SPIN(xb_ld(&bar[XB_TOPGEN]) == tg, bar);
            __builtin_amdgcn_fence(__ATOMIC_ACQUIRE, "agent");
            xb_add(&bar[XB_XGEN(b.x)], 1u);
            asm volatile("s_waitcnt vmcnt(0)" ::: "memory");
        } else {
            XB_SPIN(xb_ld(&bar[XB_XGEN(b.x)]) == gen, bar);
            __builtin_amdgcn_fence(__ATOMIC_ACQUIRE, "agent");
            asm volatile("s_waitcnt vmcnt(0)" ::: "memory");
        }
    }
    __syncthreads();
}

__device__ __forceinline__ void p0_adaln(const float* c, const float* w_ada, const float* b_ada, float* MOD, LAS float* red, int tid, int lane, int wave) {
    const __amdgpu_buffer_rsrc_t wrsrc = __builtin_amdgcn_make_buffer_rsrc((void*)w_ada, 0, DM * NMOD * 4, 0x00020000);
    for (int it = blockIdx.x; it < 48 * 16; it += gridDim.x) {
        const int cgp = it % 48, kc = it / 48, k0 = kc * 128 + wave * 16, c0 = cgp * 256 + lane * 4;
        const float cv = c[(lane >> 4) * DM + k0 + (lane & 15)];
        const float sv = cv * sigm(cv);
        f32x4 acc[4], w4[16];
#pragma unroll
        for (int b = 0; b < 4; ++b) acc[b] = (f32x4){0.f, 0.f, 0.f, 0.f};
        const unsigned voff = (unsigned)(k0 * NMOD + c0) * 4u;
#pragma unroll
        for (int r = 0; r < 16; ++r) w4[r] = __builtin_bit_cast(f32x4, __builtin_amdgcn_raw_buffer_load_b128(wrsrc, voff, r * (NMOD * 4), 0));
#pragma unroll
        for (int r = 0; r < 16; ++r)
#pragma unroll
            for (int b = 0; b < 4; ++b) { const float sc = __uint_as_float(__builtin_amdgcn_readlane(__float_as_uint(sv), b * 16 + r)); acc[b] += w4[r] * sc; }
#pragma unroll
        for (int b = 0; b < 4; ++b) *(LAS f32x4*)(red + ((wave * 4 + b) * 256 + lane * 4)) = acc[b];
        __syncthreads();
#pragma unroll
        for (int e = 0; e < 2; ++e) { const int o = tid * 2 + e, b = o >> 8, col = o & 255; float s = 0.f;
#pragma unroll
            for (int w = 0; w < 8; ++w) s += red[(w * 4 + b) * 256 + col];
            if (kc == 0) s += b_ada[cgp * 256 + col];
            atomicAdd(MOD + b * NMOD + cgp * 256 + col, s); }
        __syncthreads();
    }
}
__device__ __forceinline__ int maprow(int mapid, int n0) {
    if (mapid == 1) {
        if (n0 < 1536) return n0;
        if (n0 < 2560) { const int t = n0 - 1536; return 1536 + ((t >> 7) << 8) + (t & 127); }
        if (n0 < 3584) { const int t = n0 - 2560; return 1536 + ((t >> 7) << 8) + 128 + (t & 127); }
        if (n0 < 5632) { const int t = n0 - 3584; return 3584 + ((t >> 7) << 8) + (t & 127); }
        const int t = n0 - 5632; return 3584 + ((t >> 7) << 8) + 128 + (t & 127);
    }
    if (mapid == 2) {
        if (n0 < DFF) return ((n0 >> 7) << 8) + (n0 & 127);
        const int t = n0 - DFF; return ((t >> 7) << 8) + 128 + (t & 127);
    }
    return n0;
}
__device__ __forceinline__ void transpose_write(const float (&v)[32], bf16* WT, int ldk, int kcol, int drow0, LAS float* scr, int lane) {
#pragma unroll
    for (int i = 0; i < 32; ++i) scr[(2 * i + (lane >> 5)) * 33 + (lane & 31)] = v[i];
    LDS_WAIT(); asm volatile("" ::: "memory");
    const int c = lane & 7;
#pragma unroll
    for (int j = 0; j < 4; ++j) { const int n = (lane >> 3) + 8 * j; const LAS float* s = scr + (8 * c) * 33 + n;
        v4u o; o.x = pk2(s[0 * 33], s[1 * 33]); o.y = pk2(s[2 * 33], s[3 * 33]); o.z = pk2(s[4 * 33], s[5 * 33]); o.w = pk2(s[6 * 33], s[7 * 33]);
        *(GAS v4u*)(WT + (size_t)(drow0 + n) * ldk + kcol + 8 * c) = o; }
    LDS_WAIT(); asm volatile("" ::: "memory");
}
template <int MAPID>
__device__ __forceinline__ void transpose_matrix(const float* W, int K, int N, bf16* WT, int ldk, int koff, int item_off, int it_lo, int it_hi, LAS float* scr, int gw, int NGW, int lane) {
    const int nblk = N / 32;
    const __amdgpu_buffer_rsrc_t rsrc = __builtin_amdgcn_make_buffer_rsrc((void*)W, 0, K * N * 4, 0x00020000);
    const unsigned lane_off = (unsigned)((lane >> 5) * N + (lane & 31)) * 4u, rowstep = (unsigned)N * 8u;
    int it = it_lo + (((gw - item_off - it_lo) % NGW) + NGW) % NGW;
#define TM_ISSUE(v, itx) do { const int it_ = (itx); if (it_ < it_hi) { const unsigned off_ = (unsigned)(64 * (it_ / nblk) * N + 32 * (it_ % nblk)) * 4u + lane_off; \
        _Pragma("unroll") for (int i = 0; i < 32; ++i) v[i] = __uint_as_float(__builtin_amdgcn_raw_buffer_load_b32(rsrc, off_, i * rowstep, 0)); } } while (0)
#define TM_FINISH(v, itx) do { const int it_ = (itx); if (it_ < it_hi) transpose_write(v, WT, ldk, koff + 64 * (it_ / nblk), maprow(MAPID, 32 * (it_ % nblk)), scr, lane); } while (0)
    float v0[32], v1[32], v2[32];
    TM_ISSUE(v0, it); TM_ISSUE(v1, it + NGW);
    for (; it < it_hi; it += 3 * NGW) {
        TM_ISSUE(v2, it + 2 * NGW); TM_FINISH(v0, it);
        TM_ISSUE(v0, it + 3 * NGW); TM_FINISH(v1, it + NGW);
        TM_ISSUE(v1, it + 4 * NGW); TM_FINISH(v2, it + 2 * NGW);
    }
#undef TM_ISSUE
#undef TM_FINISH
}
__device__ __forceinline__ void modnorm_phase(const float* X, const float* g, const float* MOD, int sh_off, int sc_off, bf16* H, int gw, int NGW, int lane) {
    for (int it = gw; it < MT / 4; it += NGW) {
        const int row0 = it * 4, b = row0 / SEQ;
        f32x4 A[8], Bv[8];
#pragma unroll
        for (int j = 0; j < 8; ++j) { const int col = 4 * (lane + 64 * j);
            const f32x4 gg = *(const f32x4*)(g + col), sc = *(const f32x4*)(MOD + (size_t)b * NMOD + sc_off + col);
            A[j] = gg * (1.0f + sc); Bv[j] = *(const f32x4*)(MOD + (size_t)b * NMOD + sh_off + col); }
        for (int r = 0; r < 4; ++r) {
            const float* xr = X + (size_t)(row0 + r) * DM;
            f32x4 v[8]; float ss = 0.f;
#pragma unroll
            for (int j = 0; j < 8; ++j) { v[j] = *(const f32x4*)(xr + 4 * (lane + 64 * j)); ss += (v[j].x * v[j].x + v[j].y * v[j].y) + (v[j].z * v[j].z + v[j].w * v[j].w); }
            const float rstd = 1.0f / sqrtf(wave_sum(ss) * (1.0f / DM) + EPS);
            bf16* hr = H + (size_t)(row0 + r) * DM;
#pragma unroll
            for (int j = 0; j < 8; ++j) { const f32x4 o = v[j] * rstd * A[j] + Bv[j]; v2u w; w.x = pk2(o.x, o.y); w.y = pk2(o.z, o.w); *(GAS v2u*)(hr + 4 * (lane + 64 * j)) = w; }
        }
    }
}
__device__ __forceinline__ int crow(int r, int hi) { return (r & 3) + 8 * (r >> 2) + 4 * hi; }
constexpr int AT_KS = 0, AT_VT = 36864, AT_BIAS = AT_VT + 33792, AT_LSCR = AT_BIAS + 4096, AT_OSTG = AT_LSCR + 1024, AT_END = AT_OSTG + 8 * 4608;
static_assert(AT_END <= RING_BYTES, "attention LDS");
__device__ __forceinline__ float sum8_dpp(float v) {
    v += __uint_as_float(__builtin_amdgcn_update_dpp(0u, __float_as_uint(v), 0x141, 0xf, 0xf, false));
    v += __uint_as_float(__builtin_amdgcn_update_dpp(0u, __float_as_uint(v), 0xB1, 0xf, 0xf, false));
    v += __uint_as_float(__builtin_amdgcn_update_dpp(0u, __float_as_uint(v), 0x4E, 0xf, 0xf, false));
    return v;
}
__device__ __forceinline__ void attn_unit(int unit, const bf16* Qb, const bf16* Kb, const bf16* Vb, bf16* A2, const float* qg, const float* kg, const float* sinks, const float* relb,
                                          LAS unsigned char* lds, int tid, int lane, int wave) {
    const int b = unit >> 6, kvh = (unit >> 4) & 3, nb = unit & 15;
    LAS bf16* Ks = (LAS bf16*)(lds + AT_KS);
    LAS bf16* Vt = (LAS bf16*)(lds + AT_VT);
    LAS float* biasT = (LAS float*)(lds + AT_BIAS);
    LAS float* lscr = (LAS float*)(lds + AT_LSCR) + wave * 32;
    LAS bf16* ostg = (LAS bf16*)(lds + AT_OSTG) + wave * 2304;
    const int tok0 = b * SEQ + nb * 128;
    const int q = lane & 31, hi = lane >> 5;
    v4u qn[4];
    { const int pi = wave * 2, g = pi >> 2, qblk = pi & 3;
        const bf16* qrow = Qb + (size_t)(tok0 + qblk * 32 + q) * 1024 + (kvh * 4 + g) * 64 + hi * 8;
#pragma unroll
        for (int ks = 0; ks < 4; ++ks) qn[ks] = *(const v4u*)(qrow + 16 * ks); }
    v4u kw[4], vw[4];
#pragma unroll
    for (int i = 0; i < 4; ++i) { const int c = tid + 512 * i, key = c >> 3, part = c & 7;
        const bool real = (nb > 0) || (key >= 128);
        const long tok = (long)tok0 - 128 + key;
        kw[i] = (v4u){0u, 0u, 0u, 0u}; vw[i] = (v4u){0u, 0u, 0u, 0u};
        if (real) { kw[i] = *(const v4u*)(Kb + tok * 256 + kvh * 64 + part * 8); vw[i] = *(const v4u*)(Vb + tok * 256 + kvh * 64 + part * 8); } }
#pragma unroll
    for (int e = 0; e < 2; ++e) { const int idx = tid + 512 * e, g = idx >> 8, dist = (idx & 255) - 48; int bucket = dist < 0 ? 0 : (dist > 127 ? 127 : dist);
      if (bucket >= 16) { const int l = 16 + (int)(logf((float)bucket * (1.0f / 16.0f)) / 2.0794415416798357f * 16.0f); bucket = l < 31 ? l : 31; }
      biasT[idx] = (dist >= 0 && dist < 128) ? relb[bucket * 16 + kvh * 4 + g] * LOG2E : -INFINITY; }
    { const int part = tid & 7; const f32x4 kg0 = *(const f32x4*)(kg + part * 8), kg1 = *(const f32x4*)(kg + part * 8 + 4);
#pragma unroll
    for (int i = 0; i < 4; ++i) { const int key = (tid + 512 * i) >> 3;
        const f32x4 k0 = (f32x4){bflo(kw[i].x), bfhi(kw[i].x), bflo(kw[i].y), bfhi(kw[i].y)}, k1 = (f32x4){bflo(kw[i].z), bfhi(kw[i].z), bflo(kw[i].w), bfhi(kw[i].w)};
        const float ss = sum8_dpp((k0.x * k0.x + k0.y * k0.y) + (k0.z * k0.z + k0.w * k0.w) + (k1.x * k1.x + k1.y * k1.y) + (k1.z * k1.z + k1.w * k1.w));
        const float rstd = __builtin_amdgcn_rsqf(ss * (1.0f / 64.0f) + EPS);
        const f32x4 g0 = kg0 * rstd, g1 = kg1 * rstd;
        v4u o; o.x = pk2(k0.x * g0.x, k0.y * g0.y); o.y = pk2(k0.z * g0.z, k0.w * g0.w); o.z = pk2(k1.x * g1.x, k1.y * g1.y); o.w = pk2(k1.z * g1.z, k1.w * g1.w);
        *(LAS v4u*)(Ks + key * 72 + part * 8) = o;
        LAS bf16* vt = Vt + (part * 8) * 264 + key;
        vt[0 * 264] = (bf16)(vw[i].x & 0xffffu); vt[1 * 264] = (bf16)(vw[i].x >> 16); vt[2 * 264] = (bf16)(vw[i].y & 0xffffu); vt[3 * 264] = (bf16)(vw[i].y >> 16);
        vt[4 * 264] = (bf16)(vw[i].z & 0xffffu); vt[5 * 264] = (bf16)(vw[i].z >> 16); vt[6 * 264] = (bf16)(vw[i].w & 0xffffu); vt[7 * 264] = (bf16)(vw[i].w >> 16); } }
    __syncthreads();
#pragma unroll 1
    for (int pass = 0; pass < 2; ++pass) {
        const int pi = wave * 2 + pass, g = pi >> 2, qblk = pi & 3, h = kvh * 4 + g, q0 = qblk * 32;
        v4u qw[4];
#pragma unroll
        for (int ks = 0; ks < 4; ++ks) qw[ks] = qn[ks];
        if (pass == 0) { const int pi1 = pi + 1, g1 = pi1 >> 2, qblk1 = pi1 & 3;
            const bf16* qrow = Qb + (size_t)(tok0 + qblk1 * 32 + q) * 1024 + (kvh * 4 + g1) * 64 + hi * 8;
#pragma unroll
            for (int ks = 0; ks < 4; ++ks) qn[ks] = *(const v4u*)(qrow + 16 * ks); }
        float ss = 0.f;
#pragma unroll
        for (int ks = 0; ks < 4; ++ks) { const v4u w = qw[ks];
            const float a0 = bflo(w.x), a1 = bfhi(w.x), a2 = bflo(w.y), a3 = bfhi(w.y), a4 = bflo(w.z), a5 = bfhi(w.z), a6 = bflo(w.w), a7 = bfhi(w.w);
            ss += (a0 * a0 + a1 * a1) + (a2 * a2 + a3 * a3) + (a4 * a4 + a5 * a5) + (a6 * a6 + a7 * a7); }
        ss += __shfl_xor(ss, 32);
        const float rs = __builtin_amdgcn_rsqf(ss * (1.0f / 64.0f) + EPS) * (0.125f * LOG2E);
        bf16x8 qf[4];
#pragma unroll
        for (int ks = 0; ks < 4; ++ks) { const v4u w = qw[ks]; const f32x4 g0 = *(const f32x4*)(qg + 16 * ks + 8 * hi) * rs, g1 = *(const f32x4*)(qg + 16 * ks + 8 * hi + 4) * rs;
            v4u o; o.x = pk2(bflo(w.x) * g0.x, bfhi(w.x) * g0.y); o.y = pk2(bflo(w.y) * g0.z, bfhi(w.y) * g0.w);
            o.z = pk2(bflo(w.z) * g1.x, bfhi(w.z) * g1.y); o.w = pk2(bflo(w.w) * g1.z, bfhi(w.w) * g1.w);
            qf[ks] = __builtin_bit_cast(bf16x8, o); }
        f32x16 s[5];
#pragma unroll
        for (int tt = 0; tt < 5; ++tt) {
            s[tt] = (f32x16){0.f, 0.f, 0.f, 0.f, 0.f, 0.f, 0.f, 0.f, 0.f, 0.f, 0.f, 0.f, 0.f, 0.f, 0.f, 0.f};
            const LAS bf16* kp = Ks + (32 * (qblk + tt) + q) * 72 + 8 * hi;
#pragma unroll
            for (int ks = 0; ks < 4; ++ks) { const bf16x8 a = *(const LAS bf16x8*)(kp + 16 * ks); s[tt] = __builtin_amdgcn_mfma_f32_32x32x16_bf16(a, qf[ks], s[tt], 0, 0, 0); }
        }
        const float sk = sinks[h] * LOG2E;
        float mx = sk;
        const LAS float* btl = biasT + g * 256 + 48 + q - 4 * hi;
#pragma unroll
        for (int tt = 0; tt < 5; ++tt)
#pragma unroll
            for (int r = 0; r < 16; ++r) { const bool dead = (nb == 0) && (qblk + tt < 4);
                float v = s[tt][r] + btl[128 - 32 * tt - (r & 3) - 8 * (r >> 2)]; v = dead ? -INFINITY : v; s[tt][r] = v; mx = fmaxf(mx, v); }
        mx = fmaxf(mx, __shfl_xor(mx, 32));
        float l = 0.f;
#pragma unroll
        for (int tt = 0; tt < 5; ++tt)
#pragma unroll
            for (int r = 0; r < 16; ++r) { const float p = __builtin_amdgcn_exp2f(s[tt][r] - mx); s[tt][r] = p; l += p; }
        l += __shfl_xor(l, 32); l += __builtin_amdgcn_exp2f(sk - mx);
        f32x16 o[2];
        o[0] = (f32x16){0.f, 0.f, 0.f, 0.f, 0.f, 0.f, 0.f, 0.f, 0.f, 0.f, 0.f, 0.f, 0.f, 0.f, 0.f, 0.f}; o[1] = o[0];
#pragma unroll
        for (int tt = 0; tt < 5; ++tt)
#pragma unroll
            for (int s2 = 0; s2 < 2; ++s2) {
                v4u pw; pw.x = pk2(s[tt][8 * s2 + 0], s[tt][8 * s2 + 1]); pw.y = pk2(s[tt][8 * s2 + 2], s[tt][8 * s2 + 3]); pw.z = pk2(s[tt][8 * s2 + 4], s[tt][8 * s2 + 5]); pw.w = pk2(s[tt][8 * s2 + 6], s[tt][8 * s2 + 7]);
                const bf16x8 pa = __builtin_bit_cast(bf16x8, pw);
#pragma unroll
                for (int dt = 0; dt < 2; ++dt) { const LAS bf16* vp = Vt + (32 * dt + q) * 264 + 32 * (qblk + tt) + 16 * s2 + 4 * hi;
                    const s16x4 lo = *(const LAS s16x4*)vp, hh = *(const LAS s16x4*)(vp + 8);
                    const bf16x8 vb = (bf16x8){lo[0], lo[1], lo[2], lo[3], hh[0], hh[1], hh[2], hh[3]};
                    o[dt] = __builtin_amdgcn_mfma_f32_32x32x16_bf16(pa, vb, o[dt], 0, 0, 0); }
            }
        if (hi == 0) lscr[q] = __builtin_amdgcn_rcpf(l);
        LDS_WAIT();
#pragma unroll
        for (int r = 0; r < 16; ++r) { const int cr = crow(r, hi); const float li = lscr[cr];
            ostg[cr * 72 + q] = (bf16)f2bf(o[0][r] * li); ostg[cr * 72 + 32 + q] = (bf16)f2bf(o[1][r] * li); }
        LDS_WAIT();
        bf16* orow = A2 + (size_t)(tok0 + q0) * 2048 + h * 64;
#pragma unroll
        for (int i = 0; i < 4; ++i) { const int row = i * 8 + (lane >> 3), ch = lane & 7; const v4u v = *(const LAS v4u*)(ostg + row * 72 + ch * 8); *(GAS v4u*)(orow + (size_t)row * 2048 + ch * 8) = v; }
        LDS_WAIT();
    }
}
constexpr int CV_RED = RING_BYTES + 1024;
__device__ __forceinline__ void conv_unit(int unit, const bf16* U, bf16* A2, const float* cw, const float* cb, const float* lg, const float* lb, LAS unsigned char* lds, int tid, int lane, int wave) {
    const int b = unit >> 6, t0 = (unit & 63) * 32;
    LAS unsigned* Us = (LAS unsigned*)lds;
    LAS float* red = (LAS float*)(lds + CV_RED);
    const __amdgpu_buffer_rsrc_t ursrc = __builtin_amdgcn_make_buffer_rsrc((void*)(U + (size_t)b * SEQ * 1024), 0, SEQ * 1024 * 2, 0x00020000);
    const __amdgpu_buffer_rsrc_t wrsrc = __builtin_amdgcn_make_buffer_rsrc((void*)cw, 0, 31 * 1024 * 4, 0x00020000);
    const int rr0 = tid >> 7, cc = tid & 127;
    v4u st[16];
#pragma unroll
    for (int i = 0; i < 16; ++i) { const int t = t0 - 30 + rr0 + 4 * i; const unsigned voff = t >= 0 ? (unsigned)(t * 2048 + cc * 16) : 0xfffffff0u;
        st[i] = __builtin_amdgcn_raw_buffer_load_b128(ursrc, voff, 0, 0); }
    f32x2 w2[31];
#pragma unroll
    for (int j = 0; j < 31; ++j) w2[j] = __builtin_bit_cast(f32x2, __builtin_amdgcn_raw_buffer_load_b64(wrsrc, tid * 8, j * 4096, 0));
    const f32x2 bb = *(const f32x2*)(cb + 2 * tid), gg = *(const f32x2*)(lg + 2 * tid), be = *(const f32x2*)(lb + 2 * tid);
    if (tid < 64) red[tid] = 0.f;
#pragma unroll
    for (int i = 0; i < 16; ++i) *(LAS v4u*)(Us + (rr0 + 4 * i) * 512 + cc * 4) = st[i];
    __syncthreads();
#pragma unroll 1
    for (int cq = 0; cq < 2; ++cq) {
        f32x2 a[16];
#pragma unroll
        for (int i = 0; i < 16; ++i) a[i] = bb;
        const LAS unsigned* up = Us + (16 * cq) * 512 + tid;
#pragma unroll
        for (int r = 0; r < 46; ++r) { const unsigned uu = up[r * 512]; const f32x2 u2 = (f32x2){bflo(uu), bfhi(uu)};
#pragma unroll
            for (int i = 0; i < 16; ++i) { const int j = r - i; if (j >= 0 && j <= 30) a[i] += u2 * w2[j]; } }
        float v[32];
#pragma unroll
        for (int i = 0; i < 16; ++i) { v[i] = a[i].x + a[i].y; v[16 + i] = a[i].x * a[i].x + a[i].y * a[i].y; }
#pragma unroll
        for (int j = 0; j < 16; ++j) { const bool up_ = (lane & 32) != 0; const float send = up_ ? v[j] : v[j + 16], keep = up_ ? v[j + 16] : v[j]; v[j] = keep + __shfl_xor(send, 32); }
#pragma unroll
        for (int j = 0; j < 8; ++j) { const bool up_ = (lane & 16) != 0; const float send = up_ ? v[j] : v[j + 8], keep = up_ ? v[j + 8] : v[j]; v[j] = keep + __shfl_xor(send, 16); }
#pragma unroll
        for (int j = 0; j < 4; ++j) { const bool up_ = (lane & 8) != 0; const float send = up_ ? v[j] : v[j + 4], keep = up_ ? v[j + 4] : v[j]; v[j] = keep + __shfl_xor(send, 8); }
#pragma unroll
        for (int j = 0; j < 2; ++j) { const bool up_ = (lane & 4) != 0; const float send = up_ ? v[j] : v[j + 2], keep = up_ ? v[j + 2] : v[j]; v[j] = keep + __shfl_xor(send, 4); }
        { const bool up_ = (lane & 2) != 0; const float send = up_ ? v[0] : v[1], keep = up_ ? v[1] : v[0]; v[0] = keep + __shfl_xor(send, 2); }
        v[0] += __shfl_xor(v[0], 1);
        if ((lane & 1) == 0) __hip_atomic_fetch_add(red + cq * 32 + ((lane >> 5) & 1) * 16 + ((lane >> 4) & 1) * 8 + ((lane >> 3) & 1) * 4 + ((lane >> 2) & 1) * 2 + ((lane >> 1) & 1), v[0], __ATOMIC_RELAXED, __HIP_MEMORY_SCOPE_WORKGROUP);
        __syncthreads();
        f32x4 tt[8];
#pragma unroll
        for (int i = 0; i < 8; ++i) tt[i] = *(const LAS f32x4*)(red + cq * 32 + 4 * i);
#pragma unroll
        for (int i = 0; i < 16; ++i) { const float mean = tt[i >> 2][i & 3] * (1.0f / 1024.0f), var = tt[4 + (i >> 2)][i & 3] * (1.0f / 1024.0f) - mean * mean, rstd = __builtin_amdgcn_rsqf(var + EPS);
            float y0 = (a[i].x - mean) * rstd * gg.x + be.x, y1 = (a[i].y - mean) * rstd * gg.y + be.y;
            y0 *= sigm(y0); y1 *= sigm(y1);
            *(GAS unsigned*)(A2 + (size_t)(b * SEQ + t0 + 16 * cq + i) * 2048 + 1024 + 2 * tid) = pk2(y0, y1); }
    }
}

struct Args { const float* in[20]; float* out; unsigned char* ws; int ph_lo, ph_hi; };
__global__ void __launch_bounds__(NWAVES * 64, 2) fwd_kernel(Args args) {
    extern __shared__ __attribute__((aligned(16))) unsigned char lds_raw[];
    LAS unsigned char* lds = (LAS unsigned char*)lds_raw;
    volatile LAS unsigned* MISC = (volatile LAS unsigned*)(lds + MISC_OFF);
    const int tid = threadIdx.x, lane = tid & 63, wave = __builtin_amdgcn_readfirstlane(tid >> 6);
    const int G = gridDim.x, bx = blockIdx.x;
    const int vcu = (G % 8 == 0) ? (bx % 8) * (G / 8) + bx / 8 : bx;
    const int gw = vcu * NWAVES + wave, NGW = G * NWAVES;
#define P_ws (args.ws)
#define P_x (args.in[0])
#define P_c_in (args.in[1])
#define P_w_ada (args.in[2])
#define P_b_ada (args.in[3])
#define P_norm_mix_g (args.in[4])
#define P_w_in (args.in[5])
#define P_q_norm_g (args.in[6])
#define P_k_norm_g (args.in[7])
#define P_attn_sinks (args.in[8])
#define P_rel_bias (args.in[9])
#define P_w_attn_out (args.in[10])
#define P_conv_w (args.in[11])
#define P_conv_b (args.in[12])
#define P_conv_ln_g (args.in[13])
#define P_conv_ln_b (args.in[14])
#define P_w_conv_out (args.in[15])
#define P_w_mix_out (args.in[16])
#define P_norm_ffn_g (args.in[17])
#define P_w_ffn_in (args.in[18])
#define P_w_ffn_out (args.in[19])
#define P_out (args.out)
#define P_MOD ((float*)(P_ws + WS_MOD))
#define P_W1T ((bf16*)(P_ws + WS_W1T))
#define P_W2T ((bf16*)(P_ws + WS_W2T))
#define P_W3T ((bf16*)(P_ws + WS_W3T))
#define P_W4T ((bf16*)(P_ws + WS_W4T))
#define P_W5T ((bf16*)(P_ws + WS_W5T))
#define P_H ((bf16*)(P_ws + WS_H))
#define P_Qb ((bf16*)(P_ws + WS_Q))
#define P_Kb ((bf16*)(P_ws + WS_K))
#define P_Vb ((bf16*)(P_ws + WS_V))
#define P_Ub ((bf16*)(P_ws + WS_U))
#define P_Rb ((bf16*)(P_ws + WS_R))
#define P_GCb ((bf16*)(P_ws + WS_GC))
#define P_A2 ((bf16*)(P_ws + WS_A2))
#define P_MG ((bf16*)(P_ws + WS_MG))
#define P_HF ((bf16*)(P_ws + WS_HF))

    for (int u = tid; u < (LDS_BYTES - LDSCTL_OFF) / 4; u += NWAVES * 64) ((LAS unsigned*)(lds + LDSCTL_OFF))[u] = 0u;
    __syncthreads();
    const int lo = args.ph_lo, hi = args.ph_hi;
#if !MK_CG_SYNC
    XcdBarrier bar; bar.bar = (unsigned*)(P_ws + WS_CTL) + CW_BAR; bar.x = 0; bar.st = nullptr;
    if (hi - lo > 1) bar = xcd_barrier_post((unsigned*)(P_ws + WS_CTL) + CW_BAR, MISC + 8);
    if (lo < 0) cg::this_grid().sync();
#else
    (void)MISC;
#endif
#ifdef PHASE_MASK
#define IN(k) (((PHASE_MASK >> (k)) & 1) && lo <= (k) && (k) < hi)
#else
#define IN(k) (lo <= (k) && (k) < hi)
#endif
#define BOTH(k) (IN(k) && IN((k) + 1))
#ifndef REPEAT_MASK
#define REPEAT_MASK 0
#endif
#if MK_CG_SYNC
#define GRID_BAR(k) do { if (BOTH(k)) cg::this_grid().sync(); } while (0)
#else
#define GRID_BAR(k) do { if (BOTH(k)) xcd_barrier(bar); } while (0)
#endif

    if (IN(0)) {
        p0_adaln(P_c_in, P_w_ada, P_b_ada, P_MOD, (LAS float*)lds, tid, lane, wave);
        LAS float* scr = (LAS float*)(lds + wave * 16384);
        transpose_matrix<1>(P_w_in, DM, N1, P_W1T, 2048, 0, 0, 0, 32 * 240, scr, gw, NGW, lane);
        transpose_matrix<2>(P_w_ffn_in, DM, N4, P_W4T, 2048, 0, 32 * 240, 0, W4_P0, scr, gw, NGW, lane);
#if REPEAT_MASK & 1
        transpose_matrix<1>(P_w_in, DM, N1, P_W1T, 2048, 0, 0, 0, 32 * 240, scr, gw, NGW, lane);
#endif
        GRID_BAR(0);
    }
#if (REPEAT_MASK >> 1) & 1
    if (IN(1)) { modnorm_phase(P_x, P_norm_mix_g, P_MOD, 0, DM, P_H, gw, NGW, lane); xcd_barrier(bar); }
#endif
    if (IN(1)) { modnorm_phase(P_x, P_norm_mix_g, P_MOD, 0, DM, P_H, gw, NGW, lane); GRID_BAR(1); }
    if (IN(2)) {
        pg8::Gemm g{P_H, P_W1T, MT, N1, DM}; pg8::StaticOrder S; S.init(MT, N1, G, bx);
        pg8::Epi1 E{P_Qb, P_Ub, P_Rb, P_GCb};
        pg8::gemm_phase<pg8::Epi1, pg8::StaticOrder, true, true>(lds, g, S, E);
        {
            const int nfull = (MT / 256) * (N1 / 256) - (((MT / 256) * (N1 / 256)) / G) * G;
            if (nfull > 0 ? bx >= nfull : true) {
                const int nconv = nfull > 0 ? G - nfull : G, cw_ = ((nfull > 0 ? bx - nfull : bx)) * NWAVES + wave, ncw = nconv * NWAVES;
                LAS float* scr = (LAS float*)(lds + wave * 16384);
                constexpr int J1 = 16 * 64, J2 = 16 * 64, J3 = 32 * 64;
                transpose_matrix<0>(P_w_attn_out, 1024, DM, P_W2T, 2048, 0, 0, 0, J1, scr, cw_, ncw, lane);
                transpose_matrix<0>(P_w_conv_out, 1024, DM, P_W2T, 2048, 1024, J1, 0, J2, scr, cw_, ncw, lane);
                transpose_matrix<0>(P_w_mix_out, DM, DM, P_W3T, 2048, 0, J1 + J2, 0, J3, scr, cw_, ncw, lane);
                transpose_matrix<2>(P_w_ffn_in, DM, N4, P_W4T, 2048, 0, J1 + J2 + J3 - W4_P0, W4_P0, 32 * 352, scr, cw_, ncw, lane);
            }
        }
        GRID_BAR(2);
    }
#if (REPEAT_MASK >> 2) & 1
    if (IN(2)) {
        pg8::Gemm g{P_H, P_W1T, MT, N1, DM}; pg8::StaticOrder S; S.init(MT, N1, G, bx);
        pg8::Epi1 E{P_Qb, P_Ub, P_Rb, P_GCb};
        pg8::gemm_phase<pg8::Epi1, pg8::StaticOrder, true, true>(lds, g, S, E);
        GRID_BAR(2);
    }
#endif
    if (IN(3)) {
#ifndef NO_ATTN
        for (int u = bx; u < 256; u += G) { attn_unit(u, P_Qb, P_Kb, P_Vb, P_A2, P_q_norm_g, P_k_norm_g, P_attn_sinks, P_rel_bias, lds, tid, lane, wave); __syncthreads(); }
#endif
#ifndef NO_CONV
        for (int u = bx; u < 256; u += G) { conv_unit(u, P_Ub, P_A2, P_conv_w, P_conv_b, P_conv_ln_g, P_conv_ln_b, lds, tid, lane, wave); __syncthreads(); }
#endif
        GRID_BAR(3);
    }
#if (REPEAT_MASK >> 3) & 1
    if (IN(3)) {
#ifndef NO_ATTN
        for (int u = bx; u < 256; u += G) { attn_unit(u, P_Qb, P_Kb, P_Vb, P_A2, P_q_norm_g, P_k_norm_g, P_attn_sinks, P_rel_bias, lds, tid, lane, wave); __syncthreads(); }
#endif
#ifndef NO_CONV
        for (int u = bx; u < 256; u += G) { conv_unit(u, P_Ub, P_A2, P_conv_w, P_conv_b, P_conv_ln_g, P_conv_ln_b, lds, tid, lane, wave); __syncthreads(); }
#endif
        GRID_BAR(3);
    }
#endif
    if (IN(4)) {
        pg8::Gemm g{P_A2, P_W2T, MT, DM, DM}; pg8::StaticOrder S; S.init(MT, DM, G, bx);
        pg8::Epi2 E{P_Rb, P_GCb, P_MG};
        pg8::gemm_phase<pg8::Epi2, pg8::StaticOrder, true, true>(lds, g, S, E);
        GRID_BAR(4);
    }
#if (REPEAT_MASK >> 4) & 1
    if (IN(4)) {
        pg8::Gemm g{P_A2, P_W2T, MT, DM, DM}; pg8::StaticOrder S; S.init(MT, DM, G, bx);
        pg8::Epi2 E{P_Rb, P_GCb, P_MG};
        pg8::gemm_phase<pg8::Epi2, pg8::StaticOrder, true, true>(lds, g, S, E);
        GRID_BAR(4);
    }
#endif
    if (IN(5)) {
        pg8::Gemm g{P_MG, P_W3T, MT, DM, DM}; pg8::StaticOrder S; S.init(MT, DM, G, bx);
        pg8::EpiRes E{P_x, P_out, P_MOD + 2 * DM};
        pg8::gemm_phase<pg8::EpiRes, pg8::StaticOrder, true, true>(lds, g, S, E);
        GRID_BAR(5);
    }
#if (REPEAT_MASK >> 5) & 1
    if (IN(5)) {
        pg8::Gemm g{P_MG, P_W3T, MT, DM, DM}; pg8::StaticOrder S; S.init(MT, DM, G, bx);
        pg8::EpiRes E{P_x, P_out, P_MOD + 2 * DM};
        pg8::gemm_phase<pg8::EpiRes, pg8::StaticOrder, true, true>(lds, g, S, E);
        GRID_BAR(5);
    }
#endif
#if (REPEAT_MASK >> 6) & 1
    if (IN(6)) { modnorm_phase(P_out, P_norm_ffn_g, P_MOD, 3 * DM, 4 * DM, P_H, gw, NGW, lane); xcd_barrier(bar); }
#endif
    if (IN(6)) { modnorm_phase(P_out, P_norm_ffn_g, P_MOD, 3 * DM, 4 * DM, P_H, gw, NGW, lane); GRID_BAR(6); }
    if (IN(7)) {
        pg8::Gemm g{P_H, P_W4T, MT, N4, DM}; pg8::StaticOrder S; S.init(MT, N4, G, bx);
        pg8::Epi4 E{P_HF};
        pg8::gemm_phase<pg8::Epi4, pg8::StaticOrder, true, true>(lds, g, S, E);
        {
            const int nfull = (MT / 256) * (N4 / 256) - (((MT / 256) * (N4 / 256)) / G) * G;
            if (nfull > 0 ? bx >= nfull : true) {
                const int nconv = nfull > 0 ? G - nfull : G, cw_ = ((nfull > 0 ? bx - nfull : bx)) * NWAVES + wave, ncw = nconv * NWAVES;
                LAS float* scr = (LAS float*)(lds + wave * 16384);
                transpose_matrix<0>(P_w_ffn_out, DFF, DM, P_W5T, DFF, 0, 0, 0, 88 * 64, scr, cw_, ncw, lane);
            }
        }
        GRID_BAR(7);
    }
#if (REPEAT_MASK >> 7) & 1
    if (IN(7)) {
        pg8::Gemm g{P_H, P_W4T, MT, N4, DM}; pg8::StaticOrder S; S.init(MT, N4, G, bx);
        pg8::Epi4 E{P_HF};
        pg8::gemm_phase<pg8::Epi4, pg8::StaticOrder, true, true>(lds, g, S, E);
        GRID_BAR(7);
    }
#endif
#if (REPEAT_MASK >> 8) & 1
    if (IN(8)) {
        pg8::Gemm g{P_HF, P_W5T, MT, DM, DFF}; pg8::StaticOrder S; S.init(MT, DM, G, bx);
        pg8::EpiRes E{P_out, (float*)(P_ws + WS_A2), P_MOD + 5 * DM};
        pg8::gemm_phase<pg8::EpiRes, pg8::StaticOrder, true, true>(lds, g, S, E);
        xcd_barrier(bar);
    }
#endif
    if (IN(8)) {
        pg8::Gemm g{P_HF, P_W5T, MT, DM, DFF}; pg8::StaticOrder S; S.init(MT, DM, G, bx);
        pg8::EpiRes E{P_out, P_out, P_MOD + 5 * DM};
        pg8::gemm_phase<pg8::EpiRes, pg8::StaticOrder, true, true>(lds, g, S, E);
    }
#undef IN
#undef BOTH
#undef GRID_BAR
}
#undef P_ws
#undef P_x
#undef P_c_in
#undef P_w_ada
#undef P_b_ada
#undef P_norm_mix_g
#undef P_w_in
#undef P_q_norm_g
#undef P_k_norm_g
#undef P_attn_sinks
#undef P_rel_bias
#undef P_w_attn_out
#undef P_conv_w
#undef P_conv_b
#undef P_conv_ln_g
#undef P_conv_ln_b
#undef P_w_conv_out
#undef P_w_mix_out
#undef P_norm_ffn_g
#undef P_w_ffn_in
#undef P_w_ffn_out
#undef P_out
#undef P_MOD
#undef P_W1T
#undef P_W2T
#undef P_W3T
#undef P_W4T
#undef P_W5T
#undef P_H
#undef P_Qb
#undef P_Kb
#undef P_Vb
#undef P_Ub
#undef P_Rb
#undef P_GCb
#undef P_A2
#undef P_MG
#undef P_HF

extern "C" void kernel_launch(void* const* d_in, const int* in_sizes, int n_in, void* d_out, int out_size, void* d_ws, size_t ws_size, hipStream_t stream) {
    static int grid = 0;
    if (grid == 0) {
        if (n_in != 20 || in_sizes[0] != MT * DM || out_size != MT * DM || ws_size < WS_END) {
            fprintf(stderr, "kernel_launch: shape/workspace mismatch (n_in %d, in0 %d, out %d, ws %zu, need %zu); nothing launched\n", n_in, n_in > 0 ? in_sizes[0] : -1, out_size, ws_size, (size_t)WS_END); grid = -1; return; }
        int dev = 0, cus = 0, per_cu = 0;
        if (hipGetDevice(&dev) != hipSuccess || hipDeviceGetAttribute(&cus, hipDeviceAttributeMultiprocessorCount, dev) != hipSuccess) { fprintf(stderr, "kernel_launch: device query failed\n"); grid = -1; return; }
        if (hipFuncSetAttribute((const void*)fwd_kernel, hipFuncAttributeMaxDynamicSharedMemorySize, LDS_BYTES) != hipSuccess) { fprintf(stderr, "kernel_launch: hipFuncSetAttribute failed\n"); grid = -1; return; }
        if (hipOccupancyMaxActiveBlocksPerMultiprocessor(&per_cu, (const void*)fwd_kernel, NWAVES * 64, LDS_BYTES) != hipSuccess || per_cu < 1) { fprintf(stderr, "kernel_launch: occupancy query says %d blocks per CU\n", per_cu); per_cu = 1; }
        (void)hipGetLastError();
        grid = cus * (per_cu < 1 ? 1 : 1);
        if (grid != 256) fprintf(stderr, "kernel_launch: note: grid = %d workgroups\n", grid);
    }
    if (grid < 0) return;
    if (hipMemsetAsync((char*)d_ws + WS_CTL, 0, CTL_ZERO_BYTES, stream) != hipSuccess) { fprintf(stderr, "kernel_launch: memset failed\n"); return; }
    Args a{};
    for (int i = 0; i < 20; ++i) a.in[i] = (const float*)d_in[i];
    a.out = (float*)d_out; a.ws = (unsigned char*)d_ws;
#if MK_PER_PHASE
    for (int ph = 0; ph < N_PHASES; ++ph) { a.ph_lo = ph; a.ph_hi = ph + 1; hipLaunchKernelGGL(fwd_kernel, dim3(grid), dim3(NWAVES * 64), LDS_BYTES, stream, a); }
#else
    a.ph_lo = 0; a.ph_hi = N_PHASES;
    void* kargs[] = {(void*)&a};
    const hipError_t e = hipLaunchCooperativeKernel((const void*)fwd_kernel, dim3(grid), dim3(NWAVES * 64), kargs, LDS_BYTES, stream);
    if (e != hipSuccess) fprintf(stderr, "kernel_launch: cooperative launch failed: %s (grid %d)\n", hipGetErrorString(e), grid);
#endif
}
```
